# Optimizing an MI355X kernel written in HIP

```python
import math
import jax, jax.numpy as jnp
from jax import lax
import numpy as np

D_MODEL = 1024
BATCH = 32
SEQ = 256
DEPTH = 4
DEC_BATCH = 4
DEC_SEQ = 2048
PAST_LEN = 512

GRID_W = 64
HEAD_DIM = 128
N_Q_HEADS = 8
N_KV_HEADS = 2
Q_PER_KV = N_Q_HEADS // N_KV_HEADS
ATTN_WIDTH = N_Q_HEADS * HEAD_DIM
KV_WIDTH = N_KV_HEADS * HEAD_DIM
WINDOW = 128
BLOCK = 128
SCALE = HEAD_DIM ** -0.5
ROPE_AXIS_DIM = HEAD_DIM // 2
ROPE_THETA = 10000.0
D_RNN = D_MODEL
N_RNN_BLOCKS = 8
RNN_BLOCK_W = D_RNN // N_RNN_BLOCKS
CONV_W = 4
CONV_LEFT = 2
LRU_C = 8.0
D_FF = 4 * D_MODEL
N_MOD = 6
EPS = 1e-6
NEG = -1e30
SPLIT_Q = ATTN_WIDTH
SPLIT_K = SPLIT_Q + KV_WIDTH
SPLIT_V = SPLIT_K + KV_WIDTH
SPLIT_XR = SPLIT_V + D_RNN
SPLIT_XG = SPLIT_XR + D_RNN
IN_WIDTH = SPLIT_XG + 2 * D_MODEL

kernel_name = "hybrid_swa_rglru_diffusion_step"


def rms_norm(x, w):
    xf = x.astype(jnp.float32)
    y = xf * lax.rsqrt(jnp.mean(xf * xf, axis=-1, keepdims=True) + EPS)
    return (y * w.astype(jnp.float32)).astype(x.dtype)


def modulate(x, norm_w, shift, scale):
    return rms_norm(x, norm_w) * (1 + scale) + shift


def adaln(cond, w, b):
    return jax.nn.silu(cond) @ w + b


def axial_rope(n_tokens):
    rows = n_tokens // GRID_W
    row = jnp.broadcast_to(jnp.arange(rows)[:, None], (rows, GRID_W)).reshape(-1).astype(jnp.float32)
    col = jnp.broadcast_to(jnp.arange(GRID_W)[None, :], (rows, GRID_W)).reshape(-1).astype(jnp.float32)
    freqs = ROPE_THETA ** (-jnp.arange(0, ROPE_AXIS_DIM, 2, dtype=jnp.float32) / ROPE_AXIS_DIM)
    ang_r = row[:, None] * freqs
    ang_c = col[:, None] * freqs
    return (jnp.cos(ang_r), jnp.sin(ang_r), jnp.cos(ang_c), jnp.sin(ang_c))


def rotate(x, cos, sin):
    x1, x2 = jnp.split(x, 2, axis=-1)
    cos = cos[:, None, :]
    sin = sin[:, None, :]
    return jnp.concatenate([x1 * cos - x2 * sin, x2 * cos + x1 * sin], axis=-1)


def apply_axial_rope(x, rope):
    cr, sr, cc, sc = rope
    x_row, x_col = jnp.split(x, 2, axis=-1)
    return jnp.concatenate([rotate(x_row, cr, sr), rotate(x_col, cc, sc)], axis=-1).astype(x.dtype)


def in_projection(h, p):
    z = h @ p["w_in"]
    q, k, v, xr, xg, gates = jnp.split(z, [SPLIT_Q, SPLIT_K, SPLIT_V, SPLIT_XR, SPLIT_XG], axis=-1)
    B, T = h.shape[:2]
    q = rms_norm(q.reshape(B, T, N_Q_HEADS, HEAD_DIM), p["q_norm_w"])
    k = rms_norm(k.reshape(B, T, N_KV_HEADS, HEAD_DIM), p["k_norm_w"])
    v = v.reshape(B, T, N_KV_HEADS, HEAD_DIM)
    return q, k, v, xr, xg, gates


def sink_softmax(s, sink):
    sk = sink.astype(jnp.float32)[None, :, :, None, None]
    m = jnp.maximum(jnp.max(s, axis=-1, keepdims=True), sk)
    e = jnp.exp(s - m)
    return e / (jnp.sum(e, axis=-1, keepdims=True) + jnp.exp(sk - m))


def context_attention(q, k, v, sink):
    B, S = q.shape[:2]
    nb = S // BLOCK
    qb = q.reshape(B, nb, BLOCK, N_KV_HEADS, Q_PER_KV, HEAD_DIM).swapaxes(0, 1)
    sk = sink.reshape(N_KV_HEADS, Q_PER_KV)

    def one(qblk):
        s = jnp.einsum("bqhgd,bkhd->bhgqk", qblk, k).astype(jnp.float32) * SCALE
        pr = sink_softmax(s, sk).astype(v.dtype)
        return jnp.einsum("bhgqk,bkhd->bqhgd", pr, v)

    o = lax.map(one, qb)
    return o.swapaxes(0, 1).reshape(B, S, ATTN_WIDTH)


def banded_attention(q, k, v, ctx_k, ctx_v, sink):
    B, T = q.shape[:2]
    nb = T // BLOCK
    P = ctx_k.shape[1]
    pad = ((0, 0), (BLOCK, BLOCK), (0, 0), (0, 0))
    kp = jnp.pad(k, pad).reshape(B, nb + 2, BLOCK, N_KV_HEADS, HEAD_DIM)
    vp = jnp.pad(v, pad).reshape(B, nb + 2, BLOCK, N_KV_HEADS, HEAD_DIM)
    kwin = jnp.concatenate([kp[:, :-2], kp[:, 1:-1], kp[:, 2:]], axis=2)
    vwin = jnp.concatenate([vp[:, :-2], vp[:, 1:-1], vp[:, 2:]], axis=2)
    qb = q.reshape(B, nb, BLOCK, N_KV_HEADS, Q_PER_KV, HEAD_DIM)
    qq = jnp.arange(BLOCK)[:, None]
    kk = jnp.arange(3 * BLOCK)[None, :]
    band = jnp.abs(kk - BLOCK - qq) <= WINDOW
    sk = sink.reshape(N_KV_HEADS, Q_PER_KV)

    def one(args):
        qblk, kblk, vblk, i = args
        kpos = i * BLOCK - BLOCK + kk
        mask = band & (kpos >= 0) & (kpos < T)
        s_loc = jnp.einsum("bqhgd,bkhd->bhgqk", qblk, kblk).astype(jnp.float32) * SCALE
        s_loc = jnp.where(mask, s_loc, NEG)
        s_ctx = jnp.einsum("bqhgd,bkhd->bhgqk", qblk, ctx_k).astype(jnp.float32) * SCALE
        pr = sink_softmax(jnp.concatenate([s_ctx, s_loc], axis=-1), sk).astype(v.dtype)
        return (jnp.einsum("bhgqk,bkhd->bqhgd", pr[..., :P], ctx_v)
                + jnp.einsum("bhgqk,bkhd->bqhgd", pr[..., P:], vblk))

    xs = (qb.swapaxes(0, 1), kwin.swapaxes(0, 1), vwin.swapaxes(0, 1), jnp.arange(nb))
    o = lax.map(one, xs)
    return o.swapaxes(0, 1).reshape(B, T, ATTN_WIDTH)


def centred_conv(x, w, b):
    T = x.shape[1]
    xp = jnp.pad(x, ((0, 0), (CONV_LEFT, CONV_W - 1 - CONV_LEFT), (0, 0)))
    y = w[0] * xp[:, 0:T]
    for tap in range(1, CONV_W):
        y = y + w[tap] * xp[:, tap:tap + T]
    return y + b


def block_diag(x, w, b):
    xb = x.reshape(*x.shape[:-1], N_RNN_BLOCKS, RNN_BLOCK_W)
    return jnp.einsum("btnc,ncd->btnd", xb, w).reshape(x.shape) + b


def lru_combine(e1, e2):
    a1, b1 = e1
    a2, b2 = e2
    return a1 * a2, a2 * b1 + b2


def rglru_direction(x, h0, lam, wa, ba, wi, bi, reverse):
    r = jax.nn.sigmoid(block_diag(x, wa, ba)).astype(jnp.float32)
    ig = jax.nn.sigmoid(block_diag(x, wi, bi)).astype(jnp.float32)
    log_a = -LRU_C * r * jax.nn.softplus(-lam.astype(jnp.float32))
    a = jnp.exp(log_a)
    bterm = jnp.sqrt(-jnp.expm1(2.0 * log_a)) * (ig * x.astype(jnp.float32))
    h0 = h0.astype(jnp.float32)
    if reverse:
        bterm = bterm.at[:, -1].add(a[:, -1] * h0)
    else:
        bterm = bterm.at[:, 0].add(a[:, 0] * h0)
    _, h = lax.associative_scan(lru_combine, (a, bterm), reverse=reverse, axis=1)
    final = h[:, 0] if reverse else h[:, -1]
    return h, final


def lru_branch(xr, xg, h0, p):
    xc = centred_conv(xr, p["conv_w"], p["conv_b"])
    hf, sf = rglru_direction(xc, h0[:, 0], p["lru_lambda"][0], p["lru_wa"][0], p["lru_ba"][0],
                             p["lru_wi"][0], p["lru_bi"][0], reverse=False)
    hb, sb = rglru_direction(xc, h0[:, 1], p["lru_lambda"][1], p["lru_wa"][1], p["lru_ba"][1],
                             p["lru_wi"][1], p["lru_bi"][1], reverse=True)
    y = (hf + hb).astype(xr.dtype) * jax.nn.gelu(xg)
    return y, jnp.stack([sf, sb], axis=1)


def merge_branches(attn, lru, gates, p):
    g_attn, g_lru = jnp.split(jax.nn.sigmoid(gates), 2, axis=-1)
    merged = g_attn * (attn @ p["w_attn_o"]) + g_lru * (lru @ p["w_lru_o"])
    return merged @ p["w_out"]


def context_mixer(h, p):
    q, k, v, xr, xg, gates = in_projection(h, p)
    attn = context_attention(q, k, v, p["attn_sink"])
    h0 = jnp.zeros((h.shape[0], 2, D_RNN), jnp.float32)
    lru, states = lru_branch(xr, xg, h0, p)
    return merge_branches(attn, lru, gates, p), k, v, states


def latent_mixer(h, p, ctx_k, ctx_v, ctx_state, rope):
    q, k, v, xr, xg, gates = in_projection(h, p)
    q = apply_axial_rope(q, rope)
    k = apply_axial_rope(k, rope)
    attn = banded_attention(q, k, v, ctx_k, ctx_v, p["attn_sink"])
    lru, _ = lru_branch(xr, xg, ctx_state, p)
    return merge_branches(attn, lru, gates, p)


def sq_relu_mlp(h, p):
    return jnp.square(jax.nn.relu(h @ p["mlp_w1"])) @ p["mlp_w2"]


def setup_inputs(seed: int = 0) -> dict:
    key = jax.random.key(seed)
    ks = jax.random.split(key, 32)
    f32 = jnp.float32

    def nrm(k, shape, scale):
        return jax.random.normal(k, shape, f32) * scale

    u = jax.random.uniform(ks[17], (DEPTH, 2, D_RNN), f32, 0.9, 0.999)
    return {
        "x_prompt": nrm(ks[0], (BATCH, SEQ, D_MODEL), 1.0),
        "x_sample": nrm(ks[1], (DEC_BATCH, DEC_SEQ, D_MODEL), 1.0),
        "cache_k": nrm(ks[2], (DEC_BATCH, DEPTH, PAST_LEN, N_KV_HEADS, HEAD_DIM), 1.0),
        "cache_v": nrm(ks[3], (DEC_BATCH, DEPTH, PAST_LEN, N_KV_HEADS, HEAD_DIM), 1.0),
        "state_lru": nrm(ks[4], (DEC_BATCH, DEPTH, 2, D_RNN), 0.5),
        "c": nrm(ks[5], (DEC_BATCH, D_MODEL), 1.0),
        "c_ctx": nrm(ks[6], (D_MODEL,), 1.0),
        "ada_w": nrm(ks[7], (DEPTH, D_MODEL, N_MOD * D_MODEL), 0.5 * D_MODEL ** -0.5),
        "ada_b": nrm(ks[8], (DEPTH, N_MOD * D_MODEL), 0.02),
        "norm1_w": 1.0 + nrm(ks[9], (DEPTH, D_MODEL), 0.05),
        "norm2_w": 1.0 + nrm(ks[10], (DEPTH, D_MODEL), 0.05),
        "w_in": nrm(ks[11], (DEPTH, D_MODEL, IN_WIDTH), D_MODEL ** -0.5),
        "q_norm_w": 1.0 + nrm(ks[12], (DEPTH, HEAD_DIM), 0.05),
        "k_norm_w": 1.0 + nrm(ks[13], (DEPTH, HEAD_DIM), 0.05),
        "attn_sink": nrm(ks[14], (DEPTH, N_Q_HEADS), 0.5),
        "conv_w": nrm(ks[15], (DEPTH, CONV_W, D_RNN), CONV_W ** -0.5),
        "conv_b": nrm(ks[16], (DEPTH, D_RNN), 0.02),
        "lru_lambda": jnp.log(u) - jnp.log1p(-u),
        "lru_wa": nrm(ks[18], (DEPTH, 2, N_RNN_BLOCKS, RNN_BLOCK_W, RNN_BLOCK_W), RNN_BLOCK_W ** -0.5),
        "lru_ba": nrm(ks[19], (DEPTH, 2, D_RNN), 0.02),
        "lru_wi": nrm(ks[20], (DEPTH, 2, N_RNN_BLOCKS, RNN_BLOCK_W, RNN_BLOCK_W), RNN_BLOCK_W ** -0.5),
        "lru_bi": nrm(ks[21], (DEPTH, 2, D_RNN), 0.02),
        "w_attn_o": nrm(ks[22], (DEPTH, ATTN_WIDTH, D_MODEL), ATTN_WIDTH ** -0.5),
        "w_lru_o": nrm(ks[23], (DEPTH, D_RNN, D_MODEL), D_RNN ** -0.5),
        "w_out": nrm(ks[24], (DEPTH, D_MODEL, D_MODEL), D_MODEL ** -0.5),
        "mlp_w1": nrm(ks[25], (DEPTH, D_MODEL, D_FF), D_MODEL ** -0.5),
        "mlp_w2": nrm(ks[26], (DEPTH, D_FF, D_MODEL), D_FF ** -0.5),
    }


def reference(x_prompt, x_sample, cache_k, cache_v, state_lru, c, c_ctx,
              ada_w, ada_b, norm1_w, norm2_w, w_in, q_norm_w, k_norm_w, attn_sink,
              conv_w, conv_b, lru_lambda, lru_wa, lru_ba, lru_wi, lru_bi,
              w_attn_o, w_lru_o, w_out, mlp_w1, mlp_w2):
    rope = axial_rope(x_sample.shape[1])
    xp = x_prompt
    xs = x_sample
    new_k, new_v, new_s = [], [], []
    for l in range(DEPTH):
        p = {
            "w_in": w_in[l], "q_norm_w": q_norm_w[l], "k_norm_w": k_norm_w[l],
            "attn_sink": attn_sink[l], "conv_w": conv_w[l], "conv_b": conv_b[l],
            "lru_lambda": lru_lambda[l], "lru_wa": lru_wa[l], "lru_ba": lru_ba[l],
            "lru_wi": lru_wi[l], "lru_bi": lru_bi[l], "w_attn_o": w_attn_o[l],
            "w_lru_o": w_lru_o[l], "w_out": w_out[l], "mlp_w1": mlp_w1[l], "mlp_w2": mlp_w2[l],
        }
        mod_c = adaln(c_ctx, ada_w[l], ada_b[l])[None, None, :]
        s1, sc1, g1, s2, sc2, g2 = jnp.split(mod_c, N_MOD, axis=-1)
        out, k_l, v_l, st_l = context_mixer(modulate(xp, norm1_w[l], s1, sc1), p)
        xp = xp + g1 * out
        xp = xp + g2 * sq_relu_mlp(modulate(xp, norm2_w[l], s2, sc2), p)
        new_k.append(k_l)
        new_v.append(v_l)
        new_s.append(st_l)
        mod_s = adaln(c, ada_w[l], ada_b[l])[:, None, :]
        s1, sc1, g1, s2, sc2, g2 = jnp.split(mod_s, N_MOD, axis=-1)
        out = latent_mixer(modulate(xs, norm1_w[l], s1, sc1), p,
                           cache_k[:, l], cache_v[:, l], state_lru[:, l], rope)
        xs = xs + g1 * out
        xs = xs + g2 * sq_relu_mlp(modulate(xs, norm2_w[l], s2, sc2), p)
    new_k_arr = jnp.stack(new_k, axis=1)
    new_v_arr = jnp.stack(new_v, axis=1)
    new_s_arr = jnp.stack(new_s, axis=1)
    return (xp, xs, new_k_arr, new_v_arr, new_s_arr)
```

```cpp
#include <hip/hip_runtime.h>
#include <hip/hip_cooperative_groups.h>
#include <hip/hip_bf16.h>
#include <cstdio>
#include <cstdint>
namespace cg = cooperative_groups;
namespace pg8 {
#define PG8_LAS __attribute__((address_space(3)))
typedef unsigned short bf16_t;
typedef short bf16x8 __attribute__((ext_vector_type(8)));
typedef float f32x4 __attribute__((ext_vector_type(4)));
typedef unsigned u32x4 __attribute__((ext_vector_type(4)));
constexpr int BM = 256, BK = 64, HALF = 128, HTB = HALF * BK * 2  , STAGE_BYTES = 8 * HTB, NXCD = 8, WGM = 8;

__host__ __device__ __forceinline__ int lds_byte(int r, int c) { const int st = (r >> 4) * 2 + (c >> 5), rr = r & 15, cc = c & 31, ob = rr * 64 + cc * 2; return st * 1024 + (ob ^ (((ob >> 9) & 1) << 5)); }
__host__ __device__ __forceinline__ void stage_rc(int b, int& R, int& C) { const int st = b / 1024, sb = b % 1024, swz = sb ^ (((sb >> 9) & 1) << 5); R = (st >> 1) * 16 + swz / 64; C = (st & 1) * 32 + (swz % 64) / 2; }
__host__ __device__ __forceinline__ int perm32(int rho) { const int n = rho >> 4, i = rho & 15; return 8 * (i >> 2) + 4 * n + (i & 3); }

struct Unit { int pm, pn; };
struct Gemm { const bf16_t* A; const bf16_t* Bt; int M, N, K; };

struct StaticOrder {
    int nM, nN, nwg, G, c;
    __host__ __device__ void init(int M, int N, int G_, int c_) { nM = M / BM; nN = N / BM; nwg = nM * nN; G = G_; c = c_; }
    __host__ __device__ bool next(int i, Unit& u) const {
        const long L = (long)i * G + c; if (L >= nwg) return false;
        int wgid = (int)L; { const int q = nwg / NXCD, r = nwg % NXCD, xcd = wgid % NXCD, off = wgid / NXCD; wgid = (xcd < r ? xcd * (q + 1) : r * (q + 1) + (xcd - r) * q) + off; }
        const int nig = WGM * nN, gid = wgid / nig, fm = gid * WGM, gsz = (nM - fm) < WGM ? (nM - fm) : WGM;
        u.pm = fm + ((wgid % nig) % gsz); u.pn = (wgid % nig) / gsz; return true;
    }
    __device__ __forceinline__ void a_ready(const Unit&) const {}
    __device__ __forceinline__ void done(const Unit&) const {}
};

typedef float f32x2c_t __attribute__((ext_vector_type(2))); typedef __bf16 bf16x2c_t __attribute__((ext_vector_type(2)));
__device__ __forceinline__ unsigned cvt_pk_bf16(float lo, float hi) { f32x2c_t v = {lo, hi}; bf16x2c_t b = __builtin_convertvector(v, bf16x2c_t); return __builtin_bit_cast(unsigned, b); }
typedef float f32x2 __attribute__((ext_vector_type(2)));
typedef unsigned u32x2 __attribute__((ext_vector_type(2)));
__device__ __forceinline__ float bf2f(unsigned short u) { return __uint_as_float(((unsigned)u) << 16); }
__device__ __forceinline__ float fsigmoid(float x) { return __builtin_amdgcn_rcpf(1.0f + __expf(-x)); }
__device__ __forceinline__ float gelu_tanh(float x) { const float u = 1.5957691216057308f * (x + 0.044715f * x * x * x); return x * __builtin_amdgcn_rcpf(1.0f + __expf(-u)); }
__device__ __forceinline__ u32x2 pack4(f32x4 v) { u32x2 w; w.x = cvt_pk_bf16(v[0], v[1]); w.y = cvt_pk_bf16(v[2], v[3]); return w; }
__host__ __device__ __forceinline__ int dim_of_pos(int p) { const int pi = p >> 1, wh = p & 1; return (pi >> 5) * 64 + wh * 32 + (pi & 31); }
__host__ __device__ __forceinline__ int pos_of_dim(int d) { const int ax = d >> 6, wh = (d >> 5) & 1, i = d & 31; return 2 * (ax * 32 + i) + wh; }

constexpr int NTOK = 16384, NCTX = 8192, DM = 1024;
constexpr float EPSN = 1e-6f;


template <bool PERMC>
__device__ __forceinline__ void prenorm_apply(f32x4 (&acc)[2][2][4][2], const Unit& u, int wr, int wc, int fr, int fq, const float* ssq, const float* sw, int ncols, PG8_LAS float* rs) {
    const int rowt = wr * 64 + fr, colw = u.pn * 256 + wc * 32 + (PERMC ? 8 : 4) * fq;
    const int cond = u.pm < 32 ? 0 : 1 + ((u.pm - 32) >> 3);
    const float* swp = sw + (size_t)cond * ncols + colw;
    const int t = (wr * 4 + wc) * 64 + fq * 16 + fr;
    const bool rebuild = ((const PG8_LAS int*)rs)[256] != u.pm;
    if (rebuild && t < 256) {
        const float* sp = ssq + (size_t)(u.pm * 256 + t) * 16;
        const f32x4 s0 = *(const f32x4*)sp, s1 = *(const f32x4*)(sp + 4), s2 = *(const f32x4*)(sp + 8), s3 = *(const f32x4*)(sp + 12);
        const f32x4 st = (s0 + s1) + (s2 + s3);
        rs[t] = __builtin_amdgcn_rsqf(((st[0] + st[1]) + (st[2] + st[3])) * (1.0f / 1024.0f) + EPSN);
    }
    f32x4 sv[2][2];
#pragma unroll
    for (int bj = 0; bj < 2; ++bj)
#pragma unroll
        for (int n = 0; n < 2; ++n) sv[bj][n] = *(const f32x4*)(swp + bj * 128 + (PERMC ? 4 : 16) * n);
    if (rebuild) {
        asm volatile("s_waitcnt lgkmcnt(0)" ::: "memory"); __builtin_amdgcn_s_barrier(); asm volatile("" ::: "memory");
        if (t == 0) ((PG8_LAS int*)rs)[256] = u.pm;
    }
#pragma unroll
    for (int ai = 0; ai < 2; ++ai)
#pragma unroll
        for (int m = 0; m < 4; ++m) {
            const float rstd = rs[ai * 128 + m * 16 + rowt];
#pragma unroll
            for (int bj = 0; bj < 2; ++bj)
#pragma unroll
                for (int n = 0; n < 2; ++n) acc[ai][bj][m][n] = acc[ai][bj][m][n] * rstd + sv[bj][n];
        }
}

struct EpiIn {
    static constexpr bool PERM = true, AFTER_DRAIN = false, HAS_MID = false;
    bf16_t *Q, *KB, *VB, *XR, *GXB, *G; float *outk, *outv; const float *qw, *kw, *rope; PG8_LAS float* red; int layer; const float *ssq, *sw;
    __device__ __forceinline__ void operator()(f32x4 (&acc)[2][2][4][2], const Unit& u, int wr, int wc, int fr, int fq) const {
        asm volatile("" : "+v"(fr), "+v"(fq));
        prenorm_apply<true>(acc, u, wr, wc, fr, fq, ssq, sw, 5632, red + 2048 + 64);
        const int pn = u.pn, pm = u.pm;
        const int rowt = wr * 64 + fr, colw = wc * 32 + 8 * fq;
        const bool latent = pm >= 32;
        if (pn < 5) {
#pragma unroll
            for (int ai = 0; ai < 2; ++ai)
#pragma unroll
                for (int m = 0; m < 4; ++m)
#pragma unroll
                    for (int bj = 0; bj < 2; ++bj) {
                        float s = 0.f;
#pragma unroll
                        for (int n = 0; n < 2; ++n) { const f32x4 x = acc[ai][bj][m][n]; s += (x[0] * x[0] + x[1] * x[1]) + (x[2] * x[2] + x[3] * x[3]); }
                        s += __shfl_xor(s, 16); s += __shfl_xor(s, 32);
                        if (fq == 0) red[((ai * 128 + m * 16 + rowt) * 2 + bj) * 4 + wc] = s;
                    }
            asm volatile("s_waitcnt lgkmcnt(0)" ::: "memory"); __builtin_amdgcn_s_barrier(); asm volatile("" ::: "memory");
            const float* nw = pn < 4 ? qw : kw;
            f32x4 wv[2];
#pragma unroll
            for (int n = 0; n < 2; ++n)
#pragma unroll
                for (int e = 0; e < 4; ++e) wv[n][e] = nw[dim_of_pos(colw + 4 * n + e)];
#pragma unroll
            for (int ai = 0; ai < 2; ++ai)
#pragma unroll
                for (int m = 0; m < 4; ++m) {
                    const int rl = ai * 128 + m * 16 + rowt, row = pm * 256 + rl;
#pragma unroll
                    for (int bj = 0; bj < 2; ++bj) {
                        const f32x4 pr = *(const PG8_LAS f32x4*)(red + (rl * 2 + bj) * 4);
                        const float rstd = __builtin_amdgcn_rsqf(((pr[0] + pr[1]) + (pr[2] + pr[3])) * (1.0f / 128.0f) + EPSN);
                        u32x2 pk[2]; float kx[2][2], ky[2][2];
#pragma unroll
                        for (int n = 0; n < 2; ++n) {
                            f32x4 v = acc[ai][bj][m][n] * rstd * wv[n];
                            const int p = colw + 4 * n;
                            if (!latent && pn == 4) { kx[n][0] = v[0]; kx[n][1] = v[2]; ky[n][0] = v[1]; ky[n][1] = v[3]; }
                            if (latent) {
                                const int t = (row - NCTX) & 2047;
                                const f32x4 cs = *(const f32x4*)(rope + ((size_t)t * 64 + (p >> 1)) * 2);
                                f32x4 o; o[0] = v[0] * cs[0] - v[1] * cs[1]; o[1] = v[1] * cs[0] + v[0] * cs[1]; o[2] = v[2] * cs[2] - v[3] * cs[3]; o[3] = v[3] * cs[2] + v[2] * cs[3];
                                v = o;
                            }
                            pk[n] = pack4(v);
                        }
                        if (!latent && pn == 4) {
                            float* o = outk + ((size_t)((pm * 4 + layer) * 256 + rl) * 2 + bj) * 128 + dim_of_pos(colw);
                            *(f32x4*)o = (f32x4){kx[0][0], kx[0][1], kx[1][0], kx[1][1]}; *(f32x4*)(o + 32) = (f32x4){ky[0][0], ky[0][1], ky[1][0], ky[1][1]};
                        }
                        bf16_t* dst = (pn < 4) ? Q + (size_t)row * 1024 + pn * 256 + bj * 128 + colw : KB + (size_t)row * 256 + bj * 128 + colw;
                        u32x4 w; w.x = pk[0].x; w.y = pk[0].y; w.z = pk[1].x; w.w = pk[1].y;
                        *(u32x4*)dst = w;
                    }
                }
        } else {
#pragma unroll
            for (int ai = 0; ai < 2; ++ai)
#pragma unroll
                for (int m = 0; m < 4; ++m) {
                    const int rl = ai * 128 + m * 16 + rowt, row = pm * 256 + rl;
#pragma unroll
                    for (int bj = 0; bj < 2; ++bj) {
                        f32x4 v0 = acc[ai][bj][m][0], v1 = acc[ai][bj][m][1];
                        const int c = bj * 128 + colw;
                        bf16_t* dst;
                        if (pn == 5) {
                            if (!latent) { float* o = outv + ((size_t)((pm * 4 + layer) * 256 + rl)) * 256 + c; *(f32x4*)o = v0; *(f32x4*)(o + 4) = v1; }
                            dst = VB + (size_t)row * 256 + c;
                        } else if (pn < 10) {
                            dst = XR + (size_t)row * 1024 + (pn - 6) * 256 + c;
                        } else if (pn < 14) {
#pragma unroll
                            for (int e = 0; e < 4; ++e) { v0[e] = gelu_tanh(v0[e]); v1[e] = gelu_tanh(v1[e]); }
                            dst = GXB + (size_t)row * 1024 + (pn - 10) * 256 + c;
                        } else {
#pragma unroll
                            for (int e = 0; e < 4; ++e) { v0[e] = fsigmoid(v0[e]); v1[e] = fsigmoid(v1[e]); }
                            dst = G + (size_t)row * 2048 + (pn - 14) * 256 + c;
                        }
                        const u32x2 p0 = pack4(v0), p1 = pack4(v1);
                        u32x4 w; w.x = p0.x; w.y = p0.y; w.z = p1.x; w.w = p1.y;
                        *(u32x4*)dst = w;
                    }
                }
        }
    }
};

struct EpiMerge {
    static constexpr bool PERM = true, AFTER_DRAIN = false, HAS_MID = true;
    const bf16_t* G; bf16_t* O;
    __device__ __forceinline__ static f32x4 lo4(u32x4 g) { f32x4 r; r[0] = __uint_as_float(g.x << 16); r[1] = __uint_as_float(g.x & 0xffff0000u); r[2] = __uint_as_float(g.y << 16); r[3] = __uint_as_float(g.y & 0xffff0000u); return r; }
    __device__ __forceinline__ static f32x4 hi4(u32x4 g) { f32x4 r; r[0] = __uint_as_float(g.z << 16); r[1] = __uint_as_float(g.z & 0xffff0000u); r[2] = __uint_as_float(g.w << 16); r[3] = __uint_as_float(g.w & 0xffff0000u); return r; }
    __device__ __forceinline__ static f32x4 rcp4(f32x4 x) { f32x4 r; r[0] = __builtin_amdgcn_rcpf(fmaxf(x[0], 1e-20f)); r[1] = __builtin_amdgcn_rcpf(fmaxf(x[1], 1e-20f)); r[2] = __builtin_amdgcn_rcpf(fmaxf(x[2], 1e-20f)); r[3] = __builtin_amdgcn_rcpf(fmaxf(x[3], 1e-20f)); return r; }
    __device__ __forceinline__ void mid(f32x4 (&acc)[2][2][4][2], const Unit& u, int wr, int wc, int fr, int fq) const {
        asm volatile("" : "+v"(fr), "+v"(fq));
        const int rowt = wr * 64 + fr, colw = u.pn * 256 + wc * 32 + 8 * fq;
#pragma unroll
        for (int ai = 0; ai < 2; ++ai)
#pragma unroll
            for (int m = 0; m < 4; ++m) {
                const bf16_t* gr = G + (size_t)(u.pm * 256 + ai * 128 + m * 16 + rowt) * 2048 + colw;
#pragma unroll
                for (int bj = 0; bj < 2; ++bj) {
                    const u32x4 a = *(const u32x4*)(gr + bj * 128), l = *(const u32x4*)(gr + 1024 + bj * 128);
                    acc[ai][bj][m][0] *= lo4(a) * rcp4(lo4(l));
                    acc[ai][bj][m][1] *= hi4(a) * rcp4(hi4(l));
                }
            }
    }
    __device__ __forceinline__ void operator()(f32x4 (&acc)[2][2][4][2], const Unit& u, int wr, int wc, int fr, int fq) const {
        asm volatile("" : "+v"(fr), "+v"(fq));
        const int rowt = wr * 64 + fr, colw = u.pn * 256 + wc * 32 + 8 * fq;
#pragma unroll
        for (int ai = 0; ai < 2; ++ai)
#pragma unroll
            for (int m = 0; m < 4; ++m) {
                const size_t row = (size_t)(u.pm * 256 + ai * 128 + m * 16 + rowt);
                const bf16_t* gr = G + row * 2048 + 1024 + colw;
#pragma unroll
                for (int bj = 0; bj < 2; ++bj) {
                    const u32x4 l = *(const u32x4*)(gr + bj * 128);
                    const u32x2 p0 = pack4(acc[ai][bj][m][0] * lo4(l)), p1 = pack4(acc[ai][bj][m][1] * hi4(l));
                    u32x4 w; w.x = p0.x; w.y = p0.y; w.z = p1.x; w.w = p1.y;
                    *(u32x4*)(O + row * 1024 + colw + bj * 128) = w;
                }
            }
    }
};

struct EpiRes {
    static constexpr bool PERM = false, AFTER_DRAIN = false, HAS_MID = false;
    const float* xin0; const float* xin1; const bf16_t* xs16; bf16_t* x16o; float* yout; const float* gate; bf16_t* Hn; const float* wmod; float* ssq;
    __device__ __forceinline__ void operator()(f32x4 (&acc)[2][2][4][2], const Unit& u, int wr, int wc, int fr, int fq) const {
        asm volatile("" : "+v"(fr), "+v"(fq));
        const int rowt = wr * 64 + fr, colw = u.pn * 256 + wc * 32 + 4 * fq;
        const int cond = u.pm < 32 ? 0 : 1 + ((u.pm - 32) >> 3);
        const float* xin = u.pm < 32 ? xin0 : xin1;
#pragma unroll
        for (int ai = 0; ai < 2; ++ai)
#pragma unroll
            for (int m = 0; m < 4; ++m) {
                const int row = u.pm * 256 + ai * 128 + m * 16 + rowt;
                const size_t off = (size_t)row * 1024 + colw;
                const float* gp = gate + cond * 6144 + colw;
                float sq = 0.f;
#pragma unroll
                for (int bj = 0; bj < 2; ++bj)
#pragma unroll
                    for (int n = 0; n < 2; ++n) {
                        f32x4 x;
                        if (xin0) x = *(const f32x4*)(xin + off + bj * 128 + 16 * n);
                        else { const u32x2 xb = *(const u32x2*)(xs16 + off + bj * 128 + 16 * n);
                            x[0] = __uint_as_float(xb.x << 16); x[1] = __uint_as_float(xb.x & 0xffff0000u); x[2] = __uint_as_float(xb.y << 16); x[3] = __uint_as_float(xb.y & 0xffff0000u); }
                        const f32x4 gvv = *(const f32x4*)(gp + bj * 128 + 16 * n);
                        const f32x4 xn = x + gvv * acc[ai][bj][m][n];
                        if (yout) *(f32x4*)(yout + off + bj * 128 + 16 * n) = xn;
                        else *(u32x2*)(x16o + off + bj * 128 + 16 * n) = pack4(xn);
                        if (Hn) { const f32x4 wm = *(const f32x4*)(wmod + cond * 1024 + colw + bj * 128 + 16 * n);
                            *(u32x2*)(Hn + off + bj * 128 + 16 * n) = pack4(xn * wm);
                            sq += (xn[0] * xn[0] + xn[1] * xn[1]) + (xn[2] * xn[2] + xn[3] * xn[3]); }
                    }
                if (Hn) { sq += __shfl_xor(sq, 16); sq += __shfl_xor(sq, 32); if (fq == 0) ssq[(size_t)row * 16 + u.pn * 4 + wc] = sq; }
            }
    }
};

struct EpiUp {
    static constexpr bool PERM = true, AFTER_DRAIN = false, HAS_MID = false;
    bf16_t* U; const float *ssq, *sw; PG8_LAS float* rs;
    __device__ __forceinline__ void operator()(f32x4 (&acc)[2][2][4][2], const Unit& u, int wr, int wc, int fr, int fq) const {
        asm volatile("" : "+v"(fr), "+v"(fq));
        prenorm_apply<true>(acc, u, wr, wc, fr, fq, ssq, sw, 4096, rs);
        const int rowt = wr * 64 + fr, colw = u.pn * 256 + wc * 32 + 8 * fq;
#pragma unroll
        for (int ai = 0; ai < 2; ++ai)
#pragma unroll
            for (int m = 0; m < 4; ++m) {
                bf16_t* rp = U + (size_t)(u.pm * 256 + ai * 128 + m * 16 + rowt) * 4096 + colw;
#pragma unroll
                for (int bj = 0; bj < 2; ++bj) {
                    f32x4 v0 = acc[ai][bj][m][0], v1 = acc[ai][bj][m][1];
#pragma unroll
                    for (int e = 0; e < 4; ++e) { const float r0 = fmaxf(v0[e], 0.f), r1 = fmaxf(v1[e], 0.f); v0[e] = r0 * r0; v1[e] = r1 * r1; }
                    const u32x2 p0 = pack4(v0), p1 = pack4(v1);
                    u32x4 w; w.x = p0.x; w.y = p0.y; w.z = p1.x; w.w = p1.y;
                    *(u32x4*)(rp + bj * 128) = w;
                }
            }
    }
};
template <class Epi, class Sched, bool ALIGN_EPI = false, bool SP2 = false>
__device__ __forceinline__ void gemm_phase(PG8_LAS unsigned char* lds, const Gemm g, const Sched& S, const Epi& E) {
    int tid_l = threadIdx.x; asm volatile("" : "+v"(tid_l));
    const int tid = tid_l, wid = __builtin_amdgcn_readfirstlane(tid >> 6), lane = tid & 63, wr = wid >> 2, wc = wid & 3, fr = lane & 15, fq = lane >> 4;
    const int K = g.K, nt = K / BK;
    unsigned voffA[2], voffB[2];
#pragma unroll
    for (int i = 0; i < 2; ++i) { int R, C; stage_rc(tid * 16 + i * 8192, R, C); const int Rb = Epi::PERM ? ((R & ~31) + perm32(R & 31)) : R;
        voffA[i] = (unsigned)(R * K + C) * 2u; voffB[i] = (unsigned)(Rb * K + C) * 2u; }
    const size_t kstep = (size_t)(BK * 2);
    const size_t hstep = (size_t)HALF * K * 2;
    const size_t tstep = 2 * hstep;
    const unsigned ldsw = (unsigned)wid * 1024u;
    const int aoff = lds_byte(wr * 64 + fr, fq * 8), boff = lds_byte(wc * 32 + fr, fq * 8);
#define PG8_SA(b, h) (((b) * 2 + (h)) * HTB)
#define PG8_SB(b, h) ((4 + (b) * 2 + (h)) * HTB)
#define PG8_STAGE(bufoff, gbase, voff) do { _Pragma("unroll") for (int _i = 0; _i < 2; ++_i) \
        __builtin_amdgcn_global_load_lds((const unsigned*)((const char*)(gbase) + (voff)[_i]), (PG8_LAS unsigned*)(lds + (bufoff) + ldsw + _i * 8192), 16, 0, 0); } while (0)
#define PG8_LDA(dst, b, h) do { _Pragma("unroll") for (int m = 0; m < 4; ++m) _Pragma("unroll") for (int k = 0; k < 2; ++k) dst[m][k] = *(const PG8_LAS bf16x8*)(lds + PG8_SA(b, h) + aoff + m * 2048 + k * 1024); } while (0)
#define PG8_LDB(dst, b, h) do { _Pragma("unroll") for (int n = 0; n < 2; ++n) _Pragma("unroll") for (int k = 0; k < 2; ++k) dst[n][k] = *(const PG8_LAS bf16x8*)(lds + PG8_SB(b, h) + boff + n * 2048 + k * 1024); } while (0)
#define PG8_MMA(ai, bj, At, Bt) do { __builtin_amdgcn_s_setprio(1); _Pragma("unroll") for (int m = 0; m < 4; ++m) _Pragma("unroll") for (int n = 0; n < 2; ++n) _Pragma("unroll") for (int k = 0; k < 2; ++k) \
        acc[ai][bj][m][n] = __builtin_amdgcn_mfma_f32_16x16x32_bf16(Bt[n][k], At[m][k], acc[ai][bj][m][n], 0, 0, 0); __builtin_amdgcn_s_setprio(0); } while (0)
#define PG8_WAIT_V(n) asm volatile("s_waitcnt vmcnt(" #n ")" ::: "memory")
#define PG8_WAIT_L(n) asm volatile("s_waitcnt lgkmcnt(" #n ")" ::: "memory")
#define PG8_BAR __builtin_amdgcn_s_barrier()
#define PG8_SCHED __builtin_amdgcn_sched_barrier(0)
    Unit cur, nxt; int ui = 0;
    if (!S.next(0, cur)) return;
    f32x4 acc[2][2][4][2];
#pragma unroll
    for (int a = 0; a < 2; ++a)
#pragma unroll
        for (int b = 0; b < 2; ++b)
#pragma unroll
            for (int m = 0; m < 4; ++m)
#pragma unroll
                for (int n = 0; n < 2; ++n) acc[a][b][m][n] = (f32x4){0.f, 0.f, 0.f, 0.f};
    bf16x8 At[4][2], B0[2][2], B1[2][2];
    const char* cA = (const char*)g.A + (size_t)cur.pm * tstep; const char* cB = (const char*)g.Bt + (size_t)cur.pn * tstep;
    S.a_ready(cur);
    if constexpr (SP2) {
        PG8_STAGE(PG8_SB(0, 0), cB, voffB); PG8_STAGE(PG8_SB(0, 1), cB + hstep, voffB); PG8_STAGE(PG8_SA(0, 0), cA, voffA); PG8_STAGE(PG8_SA(0, 1), cA + hstep, voffA);
        if (wr == 1) PG8_BAR;
        PG8_WAIT_V(2); PG8_BAR;
        PG8_STAGE(PG8_SB(1, 0), cB + kstep, voffB); PG8_STAGE(PG8_SA(1, 0), cA + kstep, voffA); PG8_STAGE(PG8_SB(1, 1), cB + hstep + kstep, voffB);
        PG8_WAIT_V(6); PG8_BAR;
    } else {
        PG8_STAGE(PG8_SB(0, 0), cB, voffB); PG8_STAGE(PG8_SA(0, 0), cA, voffA); PG8_STAGE(PG8_SB(0, 1), cB + hstep, voffB); PG8_STAGE(PG8_SA(0, 1), cA + hstep, voffA);
        if (wr == 1) PG8_BAR;
        PG8_WAIT_V(4); PG8_BAR;
        PG8_STAGE(PG8_SB(1, 0), cB + kstep, voffB); PG8_STAGE(PG8_SA(1, 0), cA + kstep, voffA); PG8_STAGE(PG8_SB(1, 1), cB + hstep + kstep, voffB);
        PG8_WAIT_V(6); PG8_BAR;
    }
    for (;;) {
        const bool has_next = S.next(ui + 1, nxt);
        const char* nA = has_next ? (const char*)g.A + (size_t)nxt.pm * tstep : cA; const char* nB = has_next ? (const char*)g.Bt + (size_t)nxt.pn * tstep : cB;
        for (int t = 0; t < nt; t += 2) {
            if constexpr (Epi::HAS_MID) { if (t == (nt >> 1)) E.mid(acc, cur, wr, wc, fr, fq); }
            const bool last = (t == nt - 2);
            const char* a1 = cA + (size_t)(t + 1) * kstep;
            const char* a2 = last ? nA : cA + (size_t)(t + 2) * kstep; const char* b2 = last ? nB : cB + (size_t)(t + 2) * kstep;
            const char* a3 = a2 + kstep; const char* b3 = b2 + kstep;
            if (last && has_next) S.a_ready(nxt);
            if constexpr (SP2) {
            PG8_LDB(B0, 0, 0); PG8_LDB(B1, 0, 1); PG8_SCHED; PG8_LDA(At, 0, 0); PG8_STAGE(PG8_SA(1, 1), a1 + hstep, voffA);
            PG8_WAIT_V(8); PG8_WAIT_L(0); PG8_BAR; PG8_MMA(0, 0, At, B0); PG8_MMA(0, 1, At, B1); PG8_BAR; PG8_SCHED;
            PG8_LDA(At, 0, 1); PG8_STAGE(PG8_SB(0, 0), b2, voffB); PG8_STAGE(PG8_SB(0, 1), b2 + hstep, voffB); PG8_STAGE(PG8_SA(0, 0), a2, voffA);
            PG8_WAIT_V(8); PG8_WAIT_L(0); PG8_BAR; PG8_MMA(1, 0, At, B0); PG8_MMA(1, 1, At, B1); PG8_BAR; PG8_SCHED;
            PG8_LDB(B0, 1, 0); PG8_LDB(B1, 1, 1); PG8_SCHED; PG8_LDA(At, 1, 0); PG8_STAGE(PG8_SA(0, 1), a2 + hstep, voffA);
            PG8_WAIT_V(8); PG8_WAIT_L(0); PG8_BAR; PG8_MMA(0, 0, At, B0); PG8_MMA(0, 1, At, B1); PG8_BAR; PG8_SCHED;
            PG8_LDA(At, 1, 1); PG8_STAGE(PG8_SB(1, 0), b3, voffB); PG8_STAGE(PG8_SB(1, 1), b3 + hstep, voffB); PG8_STAGE(PG8_SA(1, 0), a3, voffA);
            PG8_WAIT_V(8); PG8_WAIT_L(0); PG8_BAR; PG8_MMA(1, 0, At, B0); PG8_MMA(1, 1, At, B1); PG8_BAR; PG8_SCHED;
            } else {
            PG8_LDB(B0, 0, 0); PG8_SCHED; PG8_LDA(At, 0, 0); PG8_STAGE(PG8_SA(1, 1), a1 + hstep, voffA);
            PG8_WAIT_L(8); PG8_BAR; PG8_WAIT_L(0); PG8_MMA(0, 0, At, B0); PG8_BAR; PG8_SCHED;
            PG8_LDB(B1, 0, 1); PG8_STAGE(PG8_SB(0, 0), b2, voffB);
            PG8_BAR; PG8_WAIT_L(0); PG8_MMA(0, 1, At, B1); PG8_BAR;
            PG8_LDA(At, 0, 1); PG8_STAGE(PG8_SA(0, 0), a2, voffA);
            PG8_BAR; PG8_WAIT_L(0); PG8_MMA(1, 0, At, B0); PG8_BAR; PG8_SCHED;
            PG8_STAGE(PG8_SB(0, 1), b2 + hstep, voffB);
            PG8_WAIT_V(6); PG8_BAR; PG8_MMA(1, 1, At, B1); PG8_BAR;
            PG8_LDB(B0, 1, 0); PG8_SCHED; PG8_LDA(At, 1, 0); PG8_STAGE(PG8_SA(0, 1), a2 + hstep, voffA);
            PG8_WAIT_L(8); PG8_BAR; PG8_WAIT_L(0); PG8_MMA(0, 0, At, B0); PG8_BAR; PG8_SCHED;
            PG8_LDB(B1, 1, 1); PG8_STAGE(PG8_SB(1, 0), b3, voffB);
            PG8_BAR; PG8_WAIT_L(0); PG8_MMA(0, 1, At, B1); PG8_BAR;
            PG8_LDA(At, 1, 1); PG8_STAGE(PG8_SA(1, 0), a3, voffA);
            PG8_BAR; PG8_WAIT_L(0); PG8_MMA(1, 0, At, B0); PG8_BAR; PG8_SCHED;
            PG8_STAGE(PG8_SB(1, 1), b3 + hstep, voffB);
            PG8_WAIT_V(6); PG8_BAR; PG8_MMA(1, 1, At, B1); PG8_BAR;
            }
        }
        if constexpr (ALIGN_EPI) { if (wr == 0) PG8_BAR; }
        if constexpr (!Epi::AFTER_DRAIN) { E(acc, cur, wr, wc, fr, fq); S.done(cur); }
        if (!has_next) break;
#pragma unroll
        for (int a = 0; a < 2; ++a)
#pragma unroll
            for (int b = 0; b < 2; ++b)
#pragma unroll
                for (int m = 0; m < 4; ++m)
#pragma unroll
                    for (int n = 0; n < 2; ++n) acc[a][b][m][n] = (f32x4){0.f, 0.f, 0.f, 0.f};
        cur = nxt; cA = nA; cB = nB; ++ui;
        if constexpr (ALIGN_EPI) { if (wr == 1) PG8_BAR; }
    }
    PG8_WAIT_V(0);
    if constexpr (!ALIGN_EPI) { if (wr == 0) PG8_BAR; }
    PG8_BAR;
    if constexpr (Epi::AFTER_DRAIN) { E.fused(acc, cur, wr, wc, fr, fq, lds, wid, lane); S.done(cur); }
#undef PG8_SA
#undef PG8_SB
#undef PG8_STAGE
#undef PG8_LDA
#undef PG8_LDB
#undef PG8_MMA
#undef PG8_WAIT_V
#undef PG8_WAIT_L
#undef PG8_BAR
#undef PG8_SCHED
}
}

namespace att {
using bf16 = unsigned short;
using bf16x8 = __attribute__((ext_vector_type(8))) short;
using s16x4  = __attribute__((ext_vector_type(4))) short;
using f32x16 = __attribute__((ext_vector_type(16))) float;
using u32x4  = __attribute__((ext_vector_type(4))) unsigned;
constexpr int D = 128, NW = 8, QBLK = 32, KVBLK = 64;
constexpr float SCALE = 0.088388347648318440f;
constexpr float THR = 8.f;
constexpr int LDQ = 1024, LDK = 256, LDO = 2048;
constexpr size_t SHM_V = KVBLK * D * 2, SHM_K = KVBLK * D * 2, SHM_ATTN = 2 * SHM_V + 2 * SHM_K + NW * 64 * 4;
#define KSWZ(row, colB) ((row) * 256 + ((colB) ^ (((row) & 7) << 4)))
#define SBAR() __builtin_amdgcn_sched_barrier(0)
__device__ __forceinline__ int crow(int r, int hi) { return (r & 3) + 8 * (r >> 2) + 4 * hi; }
typedef float f32x2a_t __attribute__((ext_vector_type(2))); typedef __bf16 bf16x2a_t __attribute__((ext_vector_type(2)));
__device__ __forceinline__ unsigned cvtpk(float lo, float hi) { f32x2a_t v = {lo, hi}; bf16x2a_t b = __builtin_convertvector(v, bf16x2a_t); return __builtin_bit_cast(unsigned, b); }
__device__ __forceinline__ void partialSM(f32x16& p0, f32x16& p1, float& m_reg, float& mn, float& alpha) {
  constexpr float C = SCALE * 1.4426950408889634f;
  float pmax = p0[0]; for (int r = 1; r < 16; ++r) pmax = fmaxf(pmax, p0[r]); for (int r = 0; r < 16; ++r) pmax = fmaxf(pmax, p1[r]);
  { auto rr = __builtin_amdgcn_permlane32_swap(__float_as_uint(pmax), __float_as_uint(pmax), false, false);
    pmax = fmaxf(__uint_as_float(rr[0]), __uint_as_float(rr[1])); }
  if (__builtin_expect(__all(pmax - m_reg <= THR / SCALE), 1)) { mn = m_reg; alpha = 1.f; }
  else { mn = fmaxf(m_reg, pmax); alpha = __builtin_amdgcn_exp2f((m_reg - mn) * C); m_reg = mn; }
  float mnC = -mn * C;
  for (int r = 0; r < 16; ++r) p0[r] = fmaf(p0[r], C, mnC); for (int r = 0; r < 16; ++r) p1[r] = fmaf(p1[r], C, mnC);
  for (int r = 0; r < 16; ++r) p0[r] = __builtin_amdgcn_exp2f(p0[r]);
}
__device__ __forceinline__ void finishSM(f32x16& p0, f32x16& p1, float alpha, float& l_reg, bf16x8& pa0, bf16x8& pa1, bf16x8& pa2, bf16x8& pa3) {
  for (int r = 0; r < 16; ++r) p1[r] = __builtin_amdgcn_exp2f(p1[r]);
  float ps = 0; for (int r = 0; r < 16; ++r) ps += p0[r]; for (int r = 0; r < 16; ++r) ps += p1[r];
  { auto rr = __builtin_amdgcn_permlane32_swap(__float_as_uint(ps), __float_as_uint(ps), false, false);
    ps = __uint_as_float(rr[0]) + __uint_as_float(rr[1]); }
  l_reg = l_reg * alpha + ps;
#define PK4(P, BASE, OUT) do { unsigned a0 = cvtpk(P[BASE + 0], P[BASE + 1]), a1 = cvtpk(P[BASE + 2], P[BASE + 3]);   \
    unsigned b0 = cvtpk(P[BASE + 4], P[BASE + 5]), b1 = cvtpk(P[BASE + 6], P[BASE + 7]);                              \
    auto r0 = __builtin_amdgcn_permlane32_swap(a0, b0, false, false); auto r1 = __builtin_amdgcn_permlane32_swap(a1, b1, false, false); \
    u32x4 w = {r0[0], r1[0], r0[1], r1[1]}; OUT = *reinterpret_cast<bf16x8*>(&w); } while (0)
  PK4(p0, 0, pa0); PK4(p0, 8, pa1); PK4(p1, 0, pa2); PK4(p1, 8, pa3);
#undef PK4
}
__device__ __forceinline__ void qkt(f32x16& p0, f32x16& p1, const bf16* Ks, const bf16x8* qr, int r32, int hi) {
  p0 = f32x16{}; p1 = f32x16{};
  for (int d0 = 0; d0 < 8; ++d0) { int cb = (d0 * 16 + hi * 8) * 2;
    bf16x8 b0 = *reinterpret_cast<const bf16x8*>((const char*)Ks + KSWZ(r32, cb));
    bf16x8 b1 = *reinterpret_cast<const bf16x8*>((const char*)Ks + KSWZ(32 + r32, cb));
    p0 = __builtin_amdgcn_mfma_f32_32x32x16_bf16(b0, qr[d0], p0, 0, 0, 0);
    p1 = __builtin_amdgcn_mfma_f32_32x32x16_bf16(b1, qr[d0], p1, 0, 0, 0); }
}
__device__ __forceinline__ void bandmask(f32x16& p0, f32x16& p1, int dk0, int hi) {
#pragma unroll
  for (int r = 0; r < 16; ++r) { const int dk = dk0 + crow(r, hi);
    if (dk < -128 || dk > 128) p0[r] = -1e30f;
    if (dk + 32 < -128 || dk + 32 > 128) p1[r] = -1e30f; }
}
__device__ __forceinline__ int v_st(int k, int c) { const int kk = (k & ~0xC) | ((k & 4) << 1) | ((k & 8) >> 1); return ((kk >> 3) * 4 + (c >> 5)) * 512 + ((kk & 7) * 32 + (c & 31)) * 2; }
__device__ __forceinline__ int v_rd_base(int lane) { return ((lane & 3) << 3) | (((lane >> 2) & 3) << 6) | (((lane >> 4) & 1) << 5) | (((lane >> 5) & 1) << 8); }
constexpr int v_rd_off(int d0, int ks, int half) { return d0 * 512 + ks * 4096 + half * 2048; }
template <int OFF> __device__ __forceinline__ s16x4 tr_read(int vb) {
  s16x4 r; asm volatile("ds_read_b64_tr_b16 %0, %1 offset:%2" : "=&v"(r) : "v"(vb), "i"(OFF) : "memory"); return r;
}
template <int D0> __device__ __forceinline__ void pv_one(f32x16& od, int vb, bf16x8 pa0, bf16x8 pa1, bf16x8 pa2, bf16x8 pa3) {
  const s16x4 l0 = tr_read<v_rd_off(D0, 0, 0)>(vb), h0 = tr_read<v_rd_off(D0, 0, 1)>(vb), l1 = tr_read<v_rd_off(D0, 1, 0)>(vb), h1 = tr_read<v_rd_off(D0, 1, 1)>(vb);
  const s16x4 l2 = tr_read<v_rd_off(D0, 2, 0)>(vb), h2 = tr_read<v_rd_off(D0, 2, 1)>(vb), l3 = tr_read<v_rd_off(D0, 3, 0)>(vb), h3 = tr_read<v_rd_off(D0, 3, 1)>(vb);
  asm volatile("s_waitcnt lgkmcnt(0)" ::: "memory"); SBAR();
#define PK(L, H) (bf16x8){L[0], L[1], L[2], L[3], H[0], H[1], H[2], H[3]}
  od = __builtin_amdgcn_mfma_f32_32x32x16_bf16(pa0, PK(l0, h0), od, 0, 0, 0);
  od = __builtin_amdgcn_mfma_f32_32x32x16_bf16(pa1, PK(l1, h1), od, 0, 0, 0);
  od = __builtin_amdgcn_mfma_f32_32x32x16_bf16(pa2, PK(l2, h2), od, 0, 0, 0);
  od = __builtin_amdgcn_mfma_f32_32x32x16_bf16(pa3, PK(l3, h3), od, 0, 0, 0);
#undef PK
}
__device__ __forceinline__ void pv_d0(f32x16* o, int vb, bf16x8 pa0, bf16x8 pa1, bf16x8 pa2, bf16x8 pa3) {
  pv_one<0>(o[0], vb, pa0, pa1, pa2, pa3); pv_one<1>(o[1], vb, pa0, pa1, pa2, pa3); pv_one<2>(o[2], vb, pa0, pa1, pa2, pa3); pv_one<3>(o[3], vb, pa0, pa1, pa2, pa3);
}

__device__ __forceinline__ void attn_unit(const bf16* __restrict__ Qb, const bf16* __restrict__ K0, const bf16* __restrict__ V0, int n0,
                                          const bf16* __restrict__ K1, const bf16* __restrict__ V1, int n1, int dq0, float sinkl2,
                                          bf16* __restrict__ Ob, char* lds) {
  int tid_l = threadIdx.x; asm volatile("" : "+v"(tid_l));
  const int tid = tid_l, wid = tid >> 6, lane = tid & 63, r32 = lane & 31, hi = lane >> 5;
  bf16* V_lds = (bf16*)lds; bf16* K_lds = (bf16*)(lds + 2 * SHM_V);
  float* ws = (float*)(lds + 2 * SHM_V + 2 * SHM_K) + wid * 64; float* li_l = ws; float* al_l = ws + 32;
  float m_reg = -1e30f, l_reg = 0; f32x16 o[4] = {}; bf16x8 qr[8];
  const bf16* Qw = Qb + (long)(wid * QBLK + r32) * LDQ + hi * 8;
#pragma unroll
  for (int d0 = 0; d0 < 8; ++d0) qr[d0] = *reinterpret_cast<const bf16x8*>(Qw + d0 * 16);
  const int sr = tid >> 4, sc = (tid & 15) * 8, vst0 = v_st(sr, sc), vst1 = v_st(32 + sr, sc);
  const int vb0 = (int)(uintptr_t)V_lds + v_rd_base(lane);
  const int dql = dq0 - (wid * QBLK + r32);
  struct { bf16x8 vs0, vs1, ks0, ks1; } sr_[2];
#define SLOAD(i, j) do { const int j_ = (j); const bf16* kt_ = j_ < n0 ? K0 + (long)j_ * (KVBLK * LDK) : K1 + (long)(j_ - n0) * (KVBLK * LDK); \
    const bf16* vt_ = j_ < n0 ? V0 + (long)j_ * (KVBLK * LDK) : V1 + (long)(j_ - n0) * (KVBLK * LDK); \
    sr_[i].vs0 = *reinterpret_cast<const bf16x8*>(&vt_[(long)sr * LDK + sc]); sr_[i].vs1 = *reinterpret_cast<const bf16x8*>(&vt_[(long)(32 + sr) * LDK + sc]); \
    sr_[i].ks0 = *reinterpret_cast<const bf16x8*>(&kt_[(long)sr * LDK + sc]); sr_[i].ks1 = *reinterpret_cast<const bf16x8*>(&kt_[(long)(32 + sr) * LDK + sc]); } while (0)
#define SWRITE(b, i) do { *(bf16x8*)((char*)V_lds + (b) * SHM_V + vst0) = sr_[i].vs0;          \
    *(bf16x8*)((char*)V_lds + (b) * SHM_V + vst1) = sr_[i].vs1; int kc = sc * 2;               \
    *(bf16x8*)((char*)K_lds + (b) * SHM_K + KSWZ(sr, kc)) = sr_[i].ks0;                       \
    *(bf16x8*)((char*)K_lds + (b) * SHM_K + KSWZ(32 + sr, kc)) = sr_[i].ks1; } while (0)
#define SWAIT() asm volatile("s_waitcnt vmcnt(4)" ::: "memory")
#define RESC(a) do { if (__any((a) < 1.f)) { if (hi == 0) al_l[r32] = (a); asm volatile("s_waitcnt lgkmcnt(0)" ::: "memory"); \
    for (int d = 0; d < 4; ++d) for (int r = 0; r < 16; ++r) o[d][r] *= al_l[crow(r, hi)]; } } while (0)
#define MASK(P0, P1, j) do { if ((j) >= n0) bandmask(P0, P1, dql + 64 * ((j) - n0), hi); } while (0)
  f32x16 pA0, pA1, pB0, pB1; float mnA, mnB, alA, alB; bf16x8 pa0, pa1, pa2, pa3; const int NT = n0 + n1;
  constexpr int SE = 0, SO = 1;
  SLOAD(SE, 0); SLOAD(SO, 1);
  asm volatile("s_waitcnt vmcnt(4)" ::: "memory"); SWRITE(0, SE); __syncthreads();
  qkt(pA0, pA1, K_lds, qr, r32, hi); partialSM(pA0, pA1, m_reg, mnA, alA);
  if (2 < NT) SLOAD(SE, 2);
  SWAIT(); SWRITE(1, SO); __syncthreads();
  for (int j = 1; j + 1 < NT; j += 2) {
    SBAR(); qkt(pB0, pB1, (bf16*)((char*)K_lds + SHM_K), qr, r32, hi); MASK(pB0, pB1, j);
    finishSM(pA0, pA1, alA, l_reg, pa0, pa1, pa2, pa3); SBAR();
    SLOAD(SO, j + 2); SBAR();
    pv_d0(o, vb0, pa0, pa1, pa2, pa3); partialSM(pB0, pB1, m_reg, mnB, alB);
    __syncthreads(); SWAIT(); SWRITE(0, SE);
    RESC(alB); __syncthreads();
    SBAR(); qkt(pA0, pA1, K_lds, qr, r32, hi); MASK(pA0, pA1, j + 1);
    finishSM(pB0, pB1, alB, l_reg, pa0, pa1, pa2, pa3); SBAR();
    if (j + 3 < NT) SLOAD(SE, j + 3); SBAR();
    pv_d0(o, vb0 + (int)SHM_V, pa0, pa1, pa2, pa3); partialSM(pA0, pA1, m_reg, mnA, alA);
    __syncthreads(); SWAIT(); SWRITE(1, SO);
    RESC(alA); __syncthreads();
  }
  SBAR(); qkt(pB0, pB1, (bf16*)((char*)K_lds + SHM_K), qr, r32, hi); MASK(pB0, pB1, NT - 1);
  finishSM(pA0, pA1, alA, l_reg, pa0, pa1, pa2, pa3); SBAR();
  pv_d0(o, vb0, pa0, pa1, pa2, pa3); partialSM(pB0, pB1, m_reg, mnB, alB);
  __syncthreads(); RESC(alB);
  finishSM(pB0, pB1, alB, l_reg, pa0, pa1, pa2, pa3); SBAR();
  pv_d0(o, vb0 + (int)SHM_V, pa0, pa1, pa2, pa3);
  l_reg += __builtin_amdgcn_exp2f(sinkl2 - m_reg * (SCALE * 1.4426950408889634f));
  if (hi == 0) li_l[r32] = l_reg; asm volatile("s_waitcnt lgkmcnt(0)" ::: "memory");
  float rli[16];
#pragma unroll
  for (int r = 0; r < 16; ++r) rli[r] = __builtin_amdgcn_rcpf(li_l[crow(r, hi)]);
  asm volatile("" ::: "memory");
  { char* stg = lds + 69632 + wid * 8192;
#pragma unroll
    for (int r = 0; r < 16; ++r) { const int orow = crow(r, hi);
#pragma unroll
      for (int d0 = 0; d0 < 4; ++d0) { const float v = o[d0][r] * rli[r]; *(bf16*)(stg + orow * 256 + (d0 * 32 + r32) * 2) = (bf16)cvtpk(v, v); } }
    asm volatile("s_waitcnt lgkmcnt(0)" ::: "memory");
    bf16* Ow = Ob + (long)(wid * QBLK) * LDO;
#pragma unroll
    for (int i = 0; i < 8; ++i) { const int row = i * 4 + (lane >> 4), ch = lane & 15; const u32x4 v = *(const u32x4*)(stg + row * 256 + ch * 16); *(u32x4*)(Ow + (long)row * LDO + ch * 8) = v; } }
  __syncthreads();
#undef SLOAD
#undef SWRITE
#undef SWAIT
#undef RESC
#undef MASK
}
#undef KSWZ
#undef SBAR
}

#define LAS __attribute__((address_space(3)))
typedef unsigned short bf16_t;
typedef unsigned v4u __attribute__((ext_vector_type(4)));
typedef float f32x4 __attribute__((ext_vector_type(4)));
typedef float f32x16 __attribute__((ext_vector_type(16)));
typedef short bf16x8 __attribute__((ext_vector_type(8)));
using pg8::bf2f; using pg8::dim_of_pos; using pg8::pos_of_dim;

constexpr int NL = 4, NINW = 5632, DFF = 4096, NMOD6 = 6144;
constexpr int NTOK = 16384, NCTX = 8192;
constexpr size_t MiB = 1u << 20;
constexpr size_t WS_CTL = 0, WS_MOD = 1 * MiB, WS_ROPE = 2 * MiB, WS_WIN = 3 * MiB, WS_WCAT = 47 * MiB, WS_WOUT = 63 * MiB, WS_W1 = 71 * MiB, WS_W2 = 103 * MiB,
                 WS_CK = 135 * MiB, WS_CV = 139 * MiB, WS_H = 143 * MiB, WS_Q = 175 * MiB, WS_KB = 207 * MiB, WS_VB = 215 * MiB, WS_XR = 223 * MiB, WS_G = 255 * MiB,
                 WS_ACAT = 319 * MiB, WS_PF = 383 * MiB, WS_PB = 399 * MiB, WS_SSQ = 415 * MiB, WS_SWIN = 416 * MiB, WS_SWUP = 416 * MiB + 512 * 1024, WS_WMOD = 417 * MiB, WS_X16 = 418 * MiB, WS_WFR = 450 * MiB, WS_END = 454 * MiB, WS_TOT = 512 * 1024, WS_U = WS_Q, WS_MERGED = WS_Q;
constexpr size_t OUT_K = 16777216, OUT_V = 25165824, OUT_S = 33554432;
constexpr int RING_BYTES = 131072, RED_OFF = 131072, MISC_OFF = RED_OFF + 8192, LDS_BYTES = 147456;
constexpr int CW_DONE = 1024;
constexpr int CW_QUEUE = 64;

#define XB_TMO      128
#define XB_XCNT(j)  (256  + 64 * (j))
#define XB_XSUB(j)  (1280 + 64 * (j))
#define XB_XGEN(j)  (2304 + 64 * (j))
#define XB_TOP      3328
#define XB_TOPGEN   3392
#define XCD_BAR_WORDS 3456
#define XB_SPIN_CAP (1u << 18)

__device__ __forceinline__ unsigned xb_ld(unsigned* p)              { return __hip_atomic_load(p, __ATOMIC_RELAXED, __HIP_MEMORY_SCOPE_AGENT); }
__device__ __forceinline__ unsigned xb_add(unsigned* p, unsigned v) { return __hip_atomic_fetch_add(p, v, __ATOMIC_RELAXED, __HIP_MEMORY_SCOPE_AGENT); }
__device__ __forceinline__ unsigned xb_xcc_id() { return (unsigned)__builtin_amdgcn_s_getreg((3 << 11) | 20) & 0xFu; }
#define XB_SPIN(cond, bar) do { unsigned _sp = 0; while (cond) { __builtin_amdgcn_s_sleep(1); \
    if ((++_sp & 255u) == 0u) { if (xb_ld(&(bar)[XB_TMO])) break; if (_sp > XB_SPIN_CAP) { atomicAdd(&(bar)[XB_TMO], 1u); break; } } } } while (0)

struct XcdBarrier {
    unsigned* bar; unsigned x;
    volatile LAS unsigned* st;
};

__device__ __forceinline__ XcdBarrier xcd_barrier_post(unsigned* bar, volatile LAS unsigned* st) {
    XcdBarrier b; b.bar = bar; b.x = xb_xcc_id(); b.st = st;
    if (threadIdx.x == 0) (void)xb_add(&bar[XB_XCNT(b.x)], 1u);
    return b;
}
__device__ __forceinline__ void xcd_barrier_complete(unsigned* bar, unsigned x, unsigned& nloc, unsigned& nx) {
    const unsigned G = gridDim.x * gridDim.y * gridDim.z;
    unsigned sum, cnt, mine, sp = 0u;
    for (;;) {
        sum = 0u; cnt = 0u; mine = 0u;
#pragma unroll
        for (unsigned j = 0; j < 16; ++j) { const unsigned c = xb_ld(&bar[XB_XCNT(j)]); sum += c; cnt += (c > 0u) ? 1u : 0u; mine = (j == x) ? c : mine; }
        if (sum == G) break;
        __builtin_amdgcn_s_sleep(1);
        if ((++sp & 255u) == 0u) { if (xb_ld(&bar[XB_TMO])) break; if (sp > XB_SPIN_CAP) { atomicAdd(&bar[XB_TMO], 1u); break; } }
    }
    nloc = mine > 0u ? mine : 1u; nx = cnt > 0u ? cnt : 1u;
}

__device__ __forceinline__ void xcd_barrier(const XcdBarrier& b) {
    asm volatile("s_waitcnt vmcnt(0)" ::: "memory");
    __syncthreads();
    if (threadIdx.x == 0) {
        unsigned* bar = b.bar;
        __builtin_amdgcn_s_waitcnt(0);
        unsigned nloc = b.st[0], nx = b.st[1];
        if (nloc == 0u) { xcd_barrier_complete(bar, b.x, nloc, nx); b.st[0] = nloc; b.st[1] = nx; }
        const unsigned old = xb_add(&bar[XB_XSUB(b.x)], 1u);
        const unsigned gen = old / nloc;
        if (old + 1u == (gen + 1u) * nloc) {
            __builtin_amdgcn_fence(__ATOMIC_RELEASE, "agent");
            asm volatile("s_waitcnt vmcnt(0)" ::: "memory");
            const unsigned og = xb_add(&bar[XB_TOP], 1u);
            const unsigned tg = og / nx;
            if (og + 1u == (tg + 1u) * nx) xb_add(&bar[XB_TOPGEN], 1u);
            else XB_SPIN(xb_ld(&bar[XB_TOPGEN]) == tg, bar);
            __builtin_amdgcn_fence(__ATOMIC_ACQUIRE, "agent");
            xb_add(&bar[XB_XGEN(b.x)], 1u);
            asm volatile("s_waitcnt vmcnt(0)" ::: "memory");
        } else {
            XB_SPIN(xb_ld(&bar[XB_XGEN(b.x)]) == gen, bar);
            __builtin_amdgcn_fence(__ATOMIC_ACQUIRE, "agent");
            asm volatile("s_waitcnt vmcnt(0)" ::: "memory");
        }
    }
    __syncthreads();
}

constexpr int CW_BAR = 4096;

__device__ __forceinline__ int opaque_bid() { int b = blockIdx.x; asm volatile("" : "+s"(b)); return b; }
#ifndef XREP_MIX
#define XREP_MIX 1
#endif
struct OneUnit { int pm, pn;
    __device__ __forceinline__ bool next(int i, pg8::Unit& u) const { if (i != 0) return false; u.pm = pm; u.pn = pn; return true; }
    __device__ __forceinline__ void a_ready(const pg8::Unit&) const {}
    __device__ __forceinline__ void done(const pg8::Unit&) const {} };
struct Params { const float* in[27]; float* out; unsigned char* ws; int ph_lo, ph_hi; };

__device__ __forceinline__ unsigned f2bf(float f) { unsigned u = __builtin_bit_cast(unsigned, f); return (u + 0x7fffu + ((u >> 16) & 1u)) >> 16; }
__device__ __forceinline__ unsigned pk2(float lo, float hi) { return att::cvtpk(lo, hi); }
__device__ __forceinline__ unsigned short f2bfh(float x) { return (unsigned short)att::cvtpk(x, x); }
__device__ __forceinline__ float wave_sum(float v) {
#pragma unroll
    for (int o = 1; o < 64; o <<= 1) v += __shfl_xor(v, o);
    return v;
}

template <bool PERMQK>
__device__ __forceinline__ void tr_item(const float* W, int K, int N, bf16_t* WT, int ldk, int koff, LAS float* scr, int item, int lane) {
    const int nblk = N / 32, kb = item / nblk, nb = item % nblk, k0 = 64 * kb, n0 = 32 * nb;
    float tv[32];
#pragma unroll
    for (int i = 0; i < 32; ++i) { const int kk = 2 * i + (lane >> 5); tv[i] = __builtin_nontemporal_load(&W[(size_t)(k0 + kk) * N + n0 + (lane & 31)]); }
#pragma unroll
    for (int i = 0; i < 32; ++i) { const int kk = 2 * i + (lane >> 5); scr[kk * 33 + (lane & 31)] = tv[i]; }
    asm volatile("s_waitcnt lgkmcnt(0)" ::: "memory");
    const int c = lane & 7;
#pragma unroll
    for (int j = 0; j < 4; ++j) { const int n = (lane >> 3) + 8 * j; const LAS float* s = scr + (8 * c) * 33 + n;
        v4u o; o.x = pk2(s[0 * 33], s[1 * 33]); o.y = pk2(s[2 * 33], s[3 * 33]); o.z = pk2(s[4 * 33], s[5 * 33]); o.w = pk2(s[6 * 33], s[7 * 33]);
        int nn = n0 + n; if (PERMQK && nn < 1280) nn = (nn & ~127) | pos_of_dim(nn & 127);
        *(v4u*)(WT + (size_t)nn * ldk + koff + k0 + 8 * c) = o; }
    asm volatile("s_waitcnt lgkmcnt(0)" ::: "memory");
}

__device__ __forceinline__ void norm_row(const float* xrow, const float* nw, const float* sh, const float* sc, bf16_t* orow, int lane) {
    const f32x4* xr = (const f32x4*)xrow + lane;
    f32x4 v[4]; float s = 0.f;
#pragma unroll
    for (int j = 0; j < 4; ++j) { v[j] = xr[64 * j]; s += (v[j][0] * v[j][0] + v[j][1] * v[j][1]) + (v[j][2] * v[j][2] + v[j][3] * v[j][3]); }
    const float rstd = __builtin_amdgcn_rsqf(wave_sum(s) * (1.f / 1024.f) + 1e-6f);
    unsigned long long* o8 = (unsigned long long*)orow + lane;
#pragma unroll
    for (int j = 0; j < 4; ++j) { const f32x4 w = ((const f32x4*)nw)[lane + 64 * j], a = ((const f32x4*)sc)[lane + 64 * j], b = ((const f32x4*)sh)[lane + 64 * j];
        const f32x4 y = v[j] * rstd * w * (1.0f + a) + b;
        o8[64 * j] = (unsigned long long)pk2(y[0], y[1]) | ((unsigned long long)pk2(y[2], y[3]) << 32); }
}
__device__ __forceinline__ void norm_phase(const Params& P, int layer, int which  , bool first) {
    int tid_l = threadIdx.x; asm volatile("" : "+v"(tid_l));
    const int lane = tid_l & 63, wave = tid_l >> 6, gw = blockIdx.x * 8 + wave, NGW = gridDim.x * 8;
    const float* mod = (const float*)(P.ws + WS_MOD) + (size_t)layer * 5 * NMOD6 + which * 3072;
    const float* nw = P.in[which ? 10 : 9] + layer * 1024;
#define RS_RESET() do { __syncthreads(); if (threadIdx.x == 0) ((LAS int*)(lds + RED_OFF))[2048 + 64 + 256] = -1; __syncthreads(); } while (0)
    bf16_t* H = (bf16_t*)(P.ws + WS_H);
    for (int row = gw; row < NTOK; row += NGW) {
        const int cond = row < NCTX ? 0 : 1 + ((row - NCTX) >> 11);
        const float* x = first ? (row < NCTX ? P.in[0] + (size_t)row * 1024 : P.in[1] + (size_t)(row - NCTX) * 1024) : P.out + (size_t)row * 1024;
        norm_row(x, nw, mod + cond * NMOD6, mod + cond * NMOD6 + 1024, H + (size_t)row * 1024, lane);
    }
}

__device__ __forceinline__ void prep_phase(const Params& P, LAS unsigned char* lds) {
    int tid_l = threadIdx.x; asm volatile("" : "+v"(tid_l));
    const int tid = tid_l, lane = tid & 63, wave = tid >> 6, G = gridDim.x, gw = blockIdx.x * 8 + wave, NGW = G * 8;
    const float* MOD = (const float*)(P.ws + WS_MOD);
    for (int i = blockIdx.x * 512 + tid; i < NL * 2 * 5 * 1024; i += G * 512) {
        const int c = i & 1023, cond = (i >> 10) % 5, w = ((i >> 10) / 5) & 1, l = (i >> 10) / 10;
        ((float*)(P.ws + WS_WMOD))[i] = P.in[w ? 10 : 9][l * 1024 + c] * (1.0f + MOD[(size_t)(l * 5 + cond) * NMOD6 + (w ? 4 : 1) * 1024 + c]);
    }
    {
        const int r32 = lane & 31, hi = lane >> 5;
        constexpr int T_IN = NINW / 32, T_UP = DFF / 32, T_L = T_IN + T_UP;
        for (int tix = gw; tix < NL * T_L; tix += NGW) {
            const int l = tix / T_L, r = tix % T_L, w = r >= T_IN, n0 = 32 * (w ? r - T_IN : r), N = w ? DFF : NINW;
            const bf16_t* Wt = (w ? (const bf16_t*)(P.ws + WS_W1) + (size_t)l * DFF * 1024 : (const bf16_t*)(P.ws + WS_WIN) + (size_t)l * NINW * 1024) + (size_t)(n0 + r32) * 1024 + 8 * hi;
            const float* shp = MOD + (size_t)(l * 5 + (r32 < 5 ? r32 : 0)) * NMOD6 + (w ? 3 : 0) * 1024 + 8 * hi;
            f32x16 acc = {};
#pragma unroll 8
            for (int ks = 0; ks < 64; ++ks) {
                const bf16x8 bfr = *(const bf16x8*)(Wt + 16 * ks);
                bf16x8 afr = {0, 0, 0, 0, 0, 0, 0, 0};
                if (r32 < 5) { const f32x4 s0 = *(const f32x4*)(shp + 16 * ks), s1 = *(const f32x4*)(shp + 16 * ks + 4);
                    v4u t; t.x = pk2(s0[0], s0[1]); t.y = pk2(s0[2], s0[3]); t.z = pk2(s1[0], s1[1]); t.w = pk2(s1[2], s1[3]); afr = __builtin_bit_cast(bf16x8, t); }
                acc = __builtin_amdgcn_mfma_f32_32x32x16_bf16(afr, bfr, acc, 0, 0, 0);
            }
            float* SW = w ? (float*)(P.ws + WS_SWUP) + (size_t)l * 5 * DFF : (float*)(P.ws + WS_SWIN) + (size_t)l * 5 * NINW;
            if (hi == 0) { SW[(size_t)0 * N + n0 + r32] = acc[0]; SW[(size_t)1 * N + n0 + r32] = acc[1]; SW[(size_t)2 * N + n0 + r32] = acc[2]; SW[(size_t)3 * N + n0 + r32] = acc[3]; }
            else SW[(size_t)4 * N + n0 + r32] = acc[0];
        }
    }
    bf16_t* H = (bf16_t*)(P.ws + WS_H); float* SSQ = (float*)(P.ws + WS_SSQ);
    for (int row0 = gw; row0 < NTOK; row0 += 2 * NGW) {
        f32x4 v[2][4];
#pragma unroll
        for (int u = 0; u < 2; ++u) { const int row = row0 + u * NGW;
            const float* x = row < NCTX ? P.in[0] + (size_t)row * 1024 : P.in[1] + (size_t)(row - NCTX) * 1024;
#pragma unroll
            for (int j = 0; j < 4; ++j) v[u][j] = ((const f32x4*)x + lane)[64 * j]; }
#pragma unroll
        for (int u = 0; u < 2; ++u) { const int row = row0 + u * NGW;
            const int cond = row < NCTX ? 0 : 1 + ((row - NCTX) >> 11);
            const f32x4* nw = (const f32x4*)P.in[9] + lane; const f32x4* sc = (const f32x4*)(MOD + (size_t)cond * NMOD6 + 1024) + lane;
            unsigned long long* o8 = (unsigned long long*)(H + (size_t)row * 1024) + lane;
            float s = 0.f;
#pragma unroll
            for (int j = 0; j < 4; ++j) { const f32x4 vv = v[u][j]; s += (vv[0] * vv[0] + vv[1] * vv[1]) + (vv[2] * vv[2] + vv[3] * vv[3]);
                const f32x4 y = vv * nw[64 * j] * (1.0f + sc[64 * j]);
                o8[64 * j] = (unsigned long long)pk2(y[0], y[1]) | ((unsigned long long)pk2(y[2], y[3]) << 32); }
            s = wave_sum(s);
            if (lane < 16) SSQ[(size_t)row * 16 + lane] = lane == 0 ? s : 0.f; }
    }
}

__device__ __forceinline__ void prologue(const Params& P, LAS unsigned char* lds) {
    int tid_l = threadIdx.x; asm volatile("" : "+v"(tid_l));
    const int tid = tid_l, lane = tid & 63, wave = tid >> 6, G = gridDim.x;
    const int gw = blockIdx.x * 8 + wave, NGW = G * 8;
    LAS float* scr = (LAS float*)(lds + wave * 16384);
    constexpr int I_IN = 16 * 176, I_O = 16 * 32, I_1 = 16 * 128, I_2 = 64 * 32, I_L = I_IN + 3 * I_O + I_1 + I_2;
    for (int it = gw; it < NL * I_L; it += NGW) {
        const int l = it / I_L; int r = it % I_L;
        if (r < I_IN) { tr_item<true>(P.in[11] + (size_t)l * 1024 * NINW, 1024, NINW, (bf16_t*)(P.ws + WS_WIN) + (size_t)l * NINW * 1024, 1024, 0, scr, r, lane); continue; } r -= I_IN;
        if (r < I_O) { tr_item<false>(P.in[22] + (size_t)l * 1024 * 1024, 1024, 1024, (bf16_t*)(P.ws + WS_WCAT) + (size_t)l * 1024 * 2048, 2048, 0, scr, r, lane); continue; } r -= I_O;
        if (r < I_O) { tr_item<false>(P.in[23] + (size_t)l * 1024 * 1024, 1024, 1024, (bf16_t*)(P.ws + WS_WCAT) + (size_t)l * 1024 * 2048, 2048, 1024, scr, r, lane); continue; } r -= I_O;
        if (r < I_O) { tr_item<false>(P.in[24] + (size_t)l * 1024 * 1024, 1024, 1024, (bf16_t*)(P.ws + WS_WOUT) + (size_t)l * 1024 * 1024, 1024, 0, scr, r, lane); continue; } r -= I_O;
        if (r < I_1) { tr_item<false>(P.in[25] + (size_t)l * 1024 * DFF, 1024, DFF, (bf16_t*)(P.ws + WS_W1) + (size_t)l * DFF * 1024, 1024, 0, scr, r, lane); continue; } r -= I_1;
        tr_item<false>(P.in[26] + (size_t)l * DFF * 1024, DFF, 1024, (bf16_t*)(P.ws + WS_W2) + (size_t)l * 1024 * DFF, DFF, 0, scr, r, lane);
    }
    __syncthreads();
    {
        LAS float* sv = (LAS float*)lds; LAS float* rb = (LAS float*)(lds + 20480);
        for (int i = tid; i < 5120; i += 512) { const int cond = i >> 10, k = i & 1023; const float x = cond == 0 ? P.in[6][k] : P.in[5][(cond - 1) * 1024 + k]; sv[i] = x * __builtin_amdgcn_rcpf(1.0f + __expf(-x)); }
        __syncthreads();
        for (int it = blockIdx.x; it < NL * 192; it += G) {
            const int l = it / 192, cg_ = it % 192, col = lane & 31, kh = lane >> 5;
            const float* W = P.in[7] + ((size_t)l * 1024 + wave * 128 + kh * 64) * NMOD6 + cg_ * 32 + col;
            float a0 = 0.f, a1 = 0.f, a2 = 0.f, a3 = 0.f, a4 = 0.f;
#pragma unroll 16
            for (int k = 0; k < 64; ++k) { const float w = __builtin_nontemporal_load(&W[(size_t)k * NMOD6]); const int kk = wave * 128 + kh * 64 + k;
                a0 += sv[kk] * w; a1 += sv[1024 + kk] * w; a2 += sv[2048 + kk] * w; a3 += sv[3072 + kk] * w; a4 += sv[4096 + kk] * w; }
            const int sl = (wave * 2 + kh) * 5;
            rb[(sl + 0) * 32 + col] = a0; rb[(sl + 1) * 32 + col] = a1; rb[(sl + 2) * 32 + col] = a2; rb[(sl + 3) * 32 + col] = a3; rb[(sl + 4) * 32 + col] = a4;
            __syncthreads();
            if (tid < 160) { const int cond = tid >> 5, cl = tid & 31; float s = 0.f;
#pragma unroll
                for (int w = 0; w < 16; ++w) s += rb[(w * 5 + cond) * 32 + cl];
                s += P.in[8][l * NMOD6 + cg_ * 32 + cl];
                ((float*)(P.ws + WS_MOD))[(size_t)(l * 5 + cond) * NMOD6 + cg_ * 32 + cl] = s; }
            __syncthreads();
        }
    }
    const int gt = blockIdx.x * 512 + tid, NGT = G * 512;
#ifdef NANFILL
    { v4u nanv = {0x7FC07FC0u, 0x7FC07FC0u, 0x7FC07FC0u, 0x7FC07FC0u};
      v4u* a = (v4u*)(P.ws + WS_H); const size_t na = (WS_END - WS_H) / 16;
      for (size_t i = gt; i < na; i += NGT) a[i] = nanv;
      v4u* o = (v4u*)P.out; const size_t no = (size_t)(33554432 + 262144) / 4;
      for (size_t i = gt; i < no; i += NGT) o[i] = nanv; }
#endif
    for (int i = gt; i < 4 * 4 * 512 * 256 / 2; i += NGT) {
        const int e = 2 * i, p = e & 127, base = e & ~127;
        const float* ck = P.in[2] + base;
        ((unsigned*)(P.ws + WS_CK))[i] = pk2(ck[dim_of_pos(p)], ck[dim_of_pos(p + 1)]);
        ((unsigned*)(P.ws + WS_CV))[i] = pk2(P.in[3][e], P.in[3][e + 1]);
    }
    for (int i = gt; i < NL * 2 * 8 * 2 * 4 * 8 * 64; i += NGT) {
        const int ln = i & 63, ks = (i >> 6) & 7, w4 = (i >> 9) & 3, gate = (i >> 11) & 1, nb = (i >> 12) & 7, dr = (i >> 15) & 1, l = i >> 16;
        const float* W = (gate ? P.in[20] : P.in[18]) + ((size_t)((l * 2 + dr) * 8 + nb) * 128) * 128 + w4 * 32 + (ln & 31);
        float v[8];
#pragma unroll
        for (int j = 0; j < 8; ++j) v[j] = W[(16 * ks + 8 * (ln >> 5) + j) * 128];
        v4u o; o.x = pk2(v[0], v[1]); o.y = pk2(v[2], v[3]); o.z = pk2(v[4], v[5]); o.w = pk2(v[6], v[7]);
        ((v4u*)(P.ws + WS_WFR))[i] = o;
    }
    for (int i = gt; i < 2048 * 64; i += NGT) {
        const int t = i >> 6, pi = i & 63, ax = pi >> 5, fi = pi & 31;
        const float freq = powf(10000.0f, -(float)(2 * fi) / 64.0f);
        const float ang = (float)(ax == 0 ? (t >> 6) : (t & 63)) * freq;
        float* o = (float*)(P.ws + WS_ROPE) + (size_t)i * 2; o[0] = cosf(ang); o[1] = sinf(ang);
    }
}

__device__ __forceinline__ int crow16(int r, int hi) { return (r & 3) + 8 * (r >> 2) + 4 * hi; }
__device__ __forceinline__ float partner32(float x, int hi) { auto rr = __builtin_amdgcn_permlane32_swap(__float_as_uint(x), __float_as_uint(x), false, false); return __uint_as_float(hi ? rr[0] : rr[1]); }
__device__ __forceinline__ void lru_unit(const Params& P, int layer, int latent, int b, int seg, int nblk, LAS unsigned char* lds) {
    int tid_l = threadIdx.x; asm volatile("" : "+v"(tid_l));
    const int tid = tid_l, lane = tid & 63, r32 = lane & 31, hi = lane >> 5;
    const int wid = __builtin_amdgcn_readfirstlane(tid >> 6), dir = wid >> 2, w4 = wid & 3, gt = tid & 255;
    constexpr int nch = 8;
    const int Tseq = latent ? 2048 : 256, t0seg = seg * 256;
    const int rowseq = latent ? NCTX + b * 2048 : b * 256, rowbase = rowseq + t0seg;
    const int chl = w4 * 32 + r32, ch = nblk * 128 + chl;
    constexpr int TILEB = 32 * 272;
    LAS unsigned char* tiles = lds;
    LAS float* cw = (LAS float*)(lds + 8 * TILEB);
    const bf16_t* XR = (const bf16_t*)(P.ws + WS_XR);
    bf16_t* HT = ((bf16_t*)P.out + (size_t)16777216);
    bf16_t* ACAT = (bf16_t*)(P.ws + WS_ACAT);
    bf16_t* PD = (bf16_t*)(P.ws + (dir ? WS_PB : WS_PF));
    for (int i = tid; i < 640; i += 512) cw[i] = (i < 512) ? P.in[15][((size_t)layer * 4 + (i >> 7)) * 1024 + nblk * 128 + (i & 127)] : P.in[16][layer * 1024 + nblk * 128 + (i & 127)];
    bf16x8 bR[8], bI0;
    LAS unsigned char* wib = lds + 72704 + wid * 7168 + lane * 16;
    {
        const v4u* fr = (const v4u*)(P.ws + WS_WFR) + ((size_t)(((layer * 2 + dir) * 8 + nblk) * 2) * 4 + w4) * 512 + lane;
#pragma unroll
        for (int ks = 0; ks < 8; ++ks) { const v4u a = fr[ks * 64], g = fr[2048 + ks * 64];
            bR[ks] = __builtin_bit_cast(bf16x8, a); if (ks == 0) bI0 = __builtin_bit_cast(bf16x8, g); else *(LAS v4u*)(wib + (ks - 1) * 1024) = g; }
    }
    const float ba = P.in[19][(layer * 2 + dir) * 1024 + ch], bi = P.in[21][(layer * 2 + dir) * 1024 + ch];
    const float lam = P.in[17][(layer * 2 + dir) * 1024 + ch];
    const float clam = -8.0f * 1.4426950408889634f * log1pf(__expf(-lam));
    float h = 0.f, p = 1.f;
    const int st = 2 * (gt >> 4), c8 = (gt & 15) * 8;
    const int strow = 8 * ((st & 15) >> 2) + 4 * (st >> 4) + (st & 3);
    v4u pre[5];
#define LRU_LOAD(ck_) do { const int ck__ = (ck_); _Pragma("unroll") for (int i = 0; i < 5; ++i) { \
        const int tt = t0seg + ck__ * 32 + st + i - 2; \
        pre[i] = (tt >= 0 && tt < Tseq) ? *(const v4u*)(XR + (size_t)(rowseq + tt) * 1024 + nblk * 128 + c8) : (v4u){0u, 0u, 0u, 0u}; } } while (0)
#define LRU_CONV(buf_) do { float y0[8], y1[8]; { const f32x4 b0 = *(const LAS f32x4*)(cw + 512 + c8), b1 = *(const LAS f32x4*)(cw + 512 + c8 + 4); \
            _Pragma("unroll") for (int j = 0; j < 4; ++j) { y0[j] = b0[j]; y0[4 + j] = b1[j]; y1[j] = b0[j]; y1[4 + j] = b1[j]; } } \
        _Pragma("unroll") for (int k = 0; k < 4; ++k) { const f32x4 w0 = *(const LAS f32x4*)(cw + k * 128 + c8), w1 = *(const LAS f32x4*)(cw + k * 128 + c8 + 4); \
            const v4u xa = pre[k], xb = pre[k + 1]; \
            _Pragma("unroll") for (int q = 0; q < 4; ++q) { const float wlo = q < 2 ? w0[2 * q] : w1[2 * q - 4], whi = q < 2 ? w0[2 * q + 1] : w1[2 * q - 3]; \
                y0[2 * q] += wlo * __uint_as_float(xa[q] << 16); y0[2 * q + 1] += whi * __uint_as_float(xa[q] & 0xffff0000u); \
                y1[2 * q] += wlo * __uint_as_float(xb[q] << 16); y1[2 * q + 1] += whi * __uint_as_float(xb[q] & 0xffff0000u); } } \
        v4u o; o.x = pk2(y0[0], y0[1]); o.y = pk2(y0[2], y0[3]); o.z = pk2(y0[4], y0[5]); o.w = pk2(y0[6], y0[7]); \
        *(LAS v4u*)(tiles + (buf_) * TILEB + strow * 272 + c8 * 2) = o; \
        o.x = pk2(y1[0], y1[1]); o.y = pk2(y1[2], y1[3]); o.z = pk2(y1[4], y1[5]); o.w = pk2(y1[6], y1[7]); \
        *(LAS v4u*)(tiles + (buf_) * TILEB + (strow + 1) * 272 + c8 * 2) = o; } while (0)
    LRU_LOAD(dir ? nch - 1 : 0);
    __syncthreads();
    LRU_CONV(dir ? nch - 1 : 0);
    __syncthreads();
    for (int k = 0; k < nch; ++k) {
        const int ck = dir ? nch - 1 - k : k;
        const LAS unsigned char* tile = tiles + ck * TILEB;
        f32x16 aR = {}, aI = {};
#pragma unroll
        for (int ks = 0; ks < 8; ++ks) { const bf16x8 af = *(const LAS bf16x8*)(tile + r32 * 272 + (16 * ks + 8 * hi) * 2);
            aR = __builtin_amdgcn_mfma_f32_32x32x16_bf16(af, bR[ks], aR, 0, 0, 0);
            aI = __builtin_amdgcn_mfma_f32_32x32x16_bf16(af, ks == 0 ? bI0 : *(const LAS bf16x8*)(wib + (ks - 1) * 1024), aI, 0, 0, 0); }
        float av[16], bv[16];
#pragma unroll
        for (int r = 0; r < 16; ++r) { const int t = crow16(r, hi);
            const float x = bf2f(*(const LAS unsigned short*)(tile + t * 272 + chl * 2));
            const float eu = 1.0f + __builtin_amdgcn_exp2f(-1.4426950408889634f * (aR[r] + ba)), ev = 1.0f + __builtin_amdgcn_exp2f(-1.4426950408889634f * (aI[r] + bi));
            const float inv = __builtin_amdgcn_rcpf(eu * ev);
            const float rr = ev * inv, ii = eu * inv;
            const float a = __builtin_amdgcn_exp2f(clam * rr);
            av[r] = a; bv[r] = __builtin_amdgcn_sqrtf(fmaxf(fmaf(-a, a, 1.0f), 0.f)) * (ii * x); }
        if (k < 3) LRU_LOAD(dir ? nch - 2 - k : k + 1);
        if (dir == 0) {
#pragma unroll
            for (int r = 1; r < 16; ++r) { bv[r] = fmaf(av[r], bv[r - 1], bv[r]); av[r] *= av[r - 1]; }
            const float ho = fmaf(av[15], h, bv[15]), po = av[15] * p;
            const float nh = partner32(ho, hi), np = partner32(po, hi);
            const float hin = hi ? nh : h, pin = hi ? np : p;
#pragma unroll
            for (int r = 0; r < 16; ++r) { bv[r] = fmaf(av[r], hin, bv[r]); av[r] *= pin; }
            const float eh = partner32(bv[15], hi), ep = partner32(av[15], hi);
            h = hi ? bv[15] : eh; p = hi ? av[15] : ep;
        } else {
#pragma unroll
            for (int r = 14; r >= 0; --r) { bv[r] = fmaf(av[r], bv[r + 1], bv[r]); av[r] *= av[r + 1]; }
            const float ho = fmaf(av[0], h, bv[0]), po = av[0] * p;
            const float nh = partner32(ho, hi), np = partner32(po, hi);
            const float hin = hi ? h : nh, pin = hi ? p : np;
#pragma unroll
            for (int r = 0; r < 16; ++r) { bv[r] = fmaf(av[r], hin, bv[r]); av[r] *= pin; }
            const float eh = partner32(bv[0], hi), ep = partner32(av[0], hi);
            h = hi ? eh : bv[0]; p = hi ? ep : av[0];
        }
        {
            char* hb_ = dir ? (char*)ACAT + (size_t)(rowbase + ck * 32) * 4096 + 2048 : (char*)HT + (size_t)(rowbase + ck * 32) * 2048;
            const unsigned rs_ = dir ? 4096u : 2048u;
            const unsigned lo1 = (unsigned)(16 * hi) * rs_ + (unsigned)(ch * 2);
#pragma unroll
            for (int r = 0; r < 16; ++r) *(bf16_t*)(hb_ + (lo1 + (unsigned)r * rs_)) = f2bfh(bv[r]);
            if (latent) {
                char* pdb = (char*)PD + (size_t)(rowbase - NCTX + ck * 32) * 2048;
                const unsigned lo2 = (unsigned)((16 * hi) * 2048 + ch * 2);
#pragma unroll
                for (int r = 0; r < 16; ++r) *(bf16_t*)(pdb + (lo2 + (unsigned)(r * 2048))) = f2bfh(av[r]);
            }
        }
        if (k < 3) LRU_CONV(dir ? nch - 2 - k : k + 1);
        asm volatile("s_waitcnt lgkmcnt(0)\n\ts_barrier" ::: "memory");
    }
    if (hi == 0) {
        if (latent) { float* tot = (float*)(P.ws + WS_TOT) + ((size_t)(((b * 8 + nblk) * 8 + seg) * 2 + dir) * 2) * 128 + chl; tot[0] = p; tot[128] = h; }
        else P.out[OUT_S + ((size_t)(b * 4 + layer) * 2 + dir) * 1024 + ch] = h;
    }
    asm volatile("s_waitcnt vmcnt(0)" ::: "memory"); __syncthreads();
    if (!latent) {
        const bf16_t* GXB = ((const bf16_t*)P.out);
#pragma unroll
        for (int hb4 = 0; hb4 < 2; ++hb4) {
            v4u hf[4], hb[4], gx[4];
#pragma unroll
            for (int i = 0; i < 4; ++i) { const int it = tid + (hb4 * 4 + i) * 512; const size_t row = (size_t)rowbase + (it >> 4); const int col = nblk * 128 + (it & 15) * 8;
                hf[i] = *(const v4u*)(HT + row * 1024 + col); hb[i] = *(const v4u*)(ACAT + row * 2048 + 1024 + col); gx[i] = *(const v4u*)(GXB + row * 1024 + col); }
#pragma unroll
            for (int i = 0; i < 4; ++i) { const int it = tid + (hb4 * 4 + i) * 512; const size_t row = (size_t)rowbase + (it >> 4); const int col = nblk * 128 + (it & 15) * 8;
                v4u o;
#pragma unroll
                for (int q = 0; q < 4; ++q) {
                    const float ylo = (__uint_as_float(hf[i][q] << 16) + __uint_as_float(hb[i][q] << 16)) * __uint_as_float(gx[i][q] << 16);
                    const float yhi = (__uint_as_float(hf[i][q] & 0xffff0000u) + __uint_as_float(hb[i][q] & 0xffff0000u)) * __uint_as_float(gx[i][q] & 0xffff0000u);
                    o[q] = pk2(ylo, yhi); }
                *(v4u*)(ACAT + row * 2048 + 1024 + col) = o; }
        }
    }
    if (latent) {
        if (tid == 0) { __builtin_amdgcn_fence(__ATOMIC_RELEASE, "agent"); asm volatile("s_waitcnt vmcnt(0)" ::: "memory");
            __hip_atomic_fetch_add((unsigned*)(P.ws + WS_CTL) + CW_DONE + ((layer * 4 + b) * 8 + nblk) * 16, 1u, __ATOMIC_RELAXED, __HIP_MEMORY_SCOPE_AGENT); }
    }
#undef LRU_LOAD
#undef LRU_CONV
}

__device__ __forceinline__ void lru_fix_unit(const Params& P, int layer, int u, LAS unsigned char* lds) {
    int tid_l = threadIdx.x; asm volatile("" : "+v"(tid_l));
    const int tid = tid_l;
    LAS float* carr = (LAS float*)lds;
    const bf16_t* HT = ((const bf16_t*)P.out + (size_t)16777216); const bf16_t* PF = (const bf16_t*)(P.ws + WS_PF); const bf16_t* PB = (const bf16_t*)(P.ws + WS_PB);
    bf16_t* ACAT = (bf16_t*)(P.ws + WS_ACAT);
    {
        const int b = u >> 6, n = (u >> 3) & 7, seg = u & 7;
        if (tid == 0) {
            unsigned* dn = (unsigned*)(P.ws + WS_CTL) + CW_DONE + ((layer * 4 + b) * 8 + n) * 16; unsigned spins = 0;
            while (__hip_atomic_load(dn, __ATOMIC_RELAXED, __HIP_MEMORY_SCOPE_AGENT) < 8u && ++spins < (1u << 22)) __builtin_amdgcn_s_sleep(4);
            __builtin_amdgcn_fence(__ATOMIC_ACQUIRE, "agent"); asm volatile("s_waitcnt vmcnt(0)" ::: "memory");
        }
        __syncthreads();
        if (tid < 256) {
            const int dir = tid >> 7, c = tid & 127;
            float cy = P.in[4][((size_t)(b * 4 + layer) * 2 + dir) * 1024 + n * 128 + c];
            const float* tot = (const float*)(P.ws + WS_TOT) + ((size_t)((b * 8 + n) * 8) * 2 + dir) * 2 * 128 + c;
            float tp[8], th[8];
#pragma unroll
            for (int j = 0; j < 8; ++j) { tp[j] = tot[j * 512]; th[j] = tot[j * 512 + 128]; }
            if (dir == 0) {
#pragma unroll
                for (int j = 0; j < 7; ++j) if (j < seg) cy = fmaf(tp[j], cy, th[j]);
            } else {
#pragma unroll
                for (int j = 7; j > 0; --j) if (j > seg) cy = fmaf(tp[j], cy, th[j]);
            }
            carr[tid] = cy;
        }
        __syncthreads();
        const size_t row0 = (size_t)NCTX + b * 2048 + seg * 256;
#pragma unroll
        for (int hb4 = 0; hb4 < 2; ++hb4) {
            v4u s[4], s2[4], pf[4], pb[4], gx[4];
#pragma unroll
            for (int i = 0; i < 4; ++i) { const int it = tid + (hb4 * 4 + i) * 512; const size_t row = row0 + (it >> 4); const int col = n * 128 + (it & 15) * 8;
                s[i] = *(const v4u*)(HT + row * 1024 + col); s2[i] = *(const v4u*)(ACAT + row * 2048 + 1024 + col);
                pf[i] = *(const v4u*)(PF + (row - NCTX) * 1024 + col); pb[i] = *(const v4u*)(PB + (row - NCTX) * 1024 + col);
                gx[i] = *(const v4u*)((const bf16_t*)P.out + row * 1024 + col); }
#pragma unroll
            for (int i = 0; i < 4; ++i) { const int it = tid + (hb4 * 4 + i) * 512; const size_t row = row0 + (it >> 4); const int c8 = (it & 15) * 8, col = n * 128 + c8;
                const f32x4 cf0 = *(const LAS f32x4*)(carr + c8), cf1 = *(const LAS f32x4*)(carr + c8 + 4), cb0 = *(const LAS f32x4*)(carr + 128 + c8), cb1 = *(const LAS f32x4*)(carr + 128 + c8 + 4);
                v4u o;
#pragma unroll
                for (int q = 0; q < 4; ++q) { const float cfl = q < 2 ? cf0[2 * q] : cf1[2 * q - 4], cfh = q < 2 ? cf0[2 * q + 1] : cf1[2 * q - 3], cbl = q < 2 ? cb0[2 * q] : cb1[2 * q - 4], cbh = q < 2 ? cb0[2 * q + 1] : cb1[2 * q - 3];
                    const float ylo = (__uint_as_float(s[i][q] << 16) + __uint_as_float(s2[i][q] << 16) + __uint_as_float(pf[i][q] << 16) * cfl + __uint_as_float(pb[i][q] << 16) * cbl) * __uint_as_float(gx[i][q] << 16);
                    const float yhi = (__uint_as_float(s[i][q] & 0xffff0000u) + __uint_as_float(s2[i][q] & 0xffff0000u) + __uint_as_float(pf[i][q] & 0xffff0000u) * cfh + __uint_as_float(pb[i][q] & 0xffff0000u) * cbh) * __uint_as_float(gx[i][q] & 0xffff0000u);
                    o[q] = pk2(ylo, yhi); }
                *(v4u*)(ACAT + row * 2048 + 1024 + col) = o; }
        }
        __syncthreads();
    }
}

__device__ __forceinline__ void mixer_phase(const Params& P, int layer, unsigned char* lds_generic, LAS unsigned char* lds, int rep, const pg8::EpiIn& EI) {
    unsigned* ctr = (unsigned*)(P.ws + WS_CTL) + CW_QUEUE + 64 * (layer + 4 * rep);
    volatile LAS unsigned* misc = (volatile LAS unsigned*)(lds + MISC_OFF);
    const bf16_t* Q = (const bf16_t*)(P.ws + WS_Q); const bf16_t* KB = (const bf16_t*)(P.ws + WS_KB); const bf16_t* VB = (const bf16_t*)(P.ws + WS_VB);
    const bf16_t* CK = (const bf16_t*)(P.ws + WS_CK); const bf16_t* CV = (const bf16_t*)(P.ws + WS_CV);
    bf16_t* ACAT = (bf16_t*)(P.ws + WS_ACAT);
    if (threadIdx.x == 0) misc[0] = __hip_atomic_fetch_add(ctr, 1u, __ATOMIC_RELAXED, __HIP_MEMORY_SCOPE_AGENT);
    for (int it = 0;; ++it) {
        __syncthreads();
        unsigned nxt = 0u;
        if (threadIdx.x == 0) nxt = __hip_atomic_fetch_add(ctr, 1u, __ATOMIC_RELAXED, __HIP_MEMORY_SCOPE_AGENT);
        const int tk = __builtin_amdgcn_readfirstlane((int)misc[it & 1]);
        if (tk >= 1408) break;
        const int idx = tk < 768 ? tk : (tk < 896 ? tk - 896 : tk - 128);
        if (idx < 0) {
            const int u = idx + 128;
            pg8::Gemm g{(const bf16_t*)(P.ws + WS_H), (const bf16_t*)(P.ws + WS_WIN) + (size_t)layer * NINW * 1024, NTOK, NINW, 1024};
            if (threadIdx.x == 0) ((LAS int*)(lds + RED_OFF))[2048 + 64 + 256] = -1;
            __syncthreads();
            OneUnit S1{u & 63, 20 + (u >> 6)};
            pg8::gemm_phase<pg8::EpiIn, OneUnit, true, true>(lds, g, S1, EI);
        }
        else if (idx >= 1024) { lru_fix_unit(P, layer, idx - 1024, lds); }
        else if (idx >= 256 && idx < 768) {
#ifndef NO_LRU
            const int j = idx - 256, latent = j < 256, jj = j & 255;
            lru_unit(P, layer, latent, latent ? (jj >> 6) : (jj >> 3), latent ? ((jj >> 3) & 7) : 0, jj & 7, lds);
#endif
        } else {
#ifndef NO_ATT
            const bool latent = idx < 256;
            const int j = latent ? idx : idx - 768;
            const int b = latent ? (j >> 6) : (j >> 3), hh = latent ? ((j >> 3) & 7) : (j & 7), qb = latent ? (j & 7) : 0, kvh = hh >> 2;
            const int q0 = qb * 256, ks = q0 - 128 < 0 ? 0 : q0 - 128, ke = q0 + 384 > 2048 ? 2048 : q0 + 384;
            const size_t rq = latent ? (size_t)NCTX + b * 2048 + q0 : (size_t)b * 256;
            const size_t rk = (size_t)NCTX + b * 2048 + ks, ck0 = (size_t)(b * 4 + layer) * 512;
            const bf16_t* K0 = latent ? CK + ck0 * 256 + kvh * 128 : KB + rq * 256 + kvh * 128;
            const bf16_t* V0 = latent ? CV + ck0 * 256 + kvh * 128 : VB + rq * 256 + kvh * 128;
            att::attn_unit(Q + rq * 1024 + hh * 128, K0, V0, latent ? 8 : 4,
                           KB + rk * 256 + kvh * 128, VB + rk * 256 + kvh * 128, latent ? (ke - ks) / 64 : 0, ks - q0,
                           P.in[14][layer * 8 + hh] * 1.4426950408889634f, ACAT + rq * 2048 + hh * 128, (char*)lds_generic);
#endif
        }
        if (threadIdx.x == 0) misc[(it + 1) & 1] = nxt;
    }
}

__global__ void __launch_bounds__(512, 2) fwd_megakernel(Params P) {
    extern __shared__ __attribute__((aligned(16))) unsigned char lds_raw[];
    LAS unsigned char* lds = (LAS unsigned char*)lds_raw;
    cg::grid_group grid = cg::this_grid();
    const int lo = P.ph_lo, hi = P.ph_hi, G = gridDim.x;
    int ph = 0;
    { volatile LAS unsigned* m = (volatile LAS unsigned*)(lds + MISC_OFF); if (threadIdx.x < 16) m[threadIdx.x] = 0u; }
    __syncthreads();
    XcdBarrier bar = xcd_barrier_post((unsigned*)(P.ws + WS_CTL) + CW_BAR, (volatile LAS unsigned*)(lds + MISC_OFF) + 8);
#define PHASE(...) do { if (ph >= lo && ph < hi) { __VA_ARGS__; if (ph + 1 < hi) { if (lo < 0) grid.sync(); else xcd_barrier(bar); } } ++ph; } while (0)
    bf16_t* H = (bf16_t*)(P.ws + WS_H);
#ifndef NO_PRO
    PHASE(prologue(P, lds));
#endif
    PHASE(prep_phase(P, lds));
#ifdef XSYNC
    if (hi > 1) { for (int i = 0; i < XSYNC; ++i) grid.sync(); }
#endif
    for (int l = 0; l < NL; ++l) {
        const float* mod = (const float*)(P.ws + WS_MOD) + (size_t)l * 5 * NMOD6;
        const pg8::EpiIn EI{(bf16_t*)(P.ws + WS_Q), (bf16_t*)(P.ws + WS_KB), (bf16_t*)(P.ws + WS_VB), (bf16_t*)(P.ws + WS_XR), ((bf16_t*)P.out), (bf16_t*)(P.ws + WS_G),
                         P.out + OUT_K, P.out + OUT_V, P.in[12] + l * 128, P.in[13] + l * 128, (const float*)(P.ws + WS_ROPE), (LAS float*)(lds + RED_OFF), l,
                         (const float*)(P.ws + WS_SSQ), (const float*)(P.ws + WS_SWIN) + (size_t)l * 5 * NINW};
        PHASE({ RS_RESET(); pg8::Gemm g{H, (const bf16_t*)(P.ws + WS_WIN) + (size_t)l * NINW * 1024, NTOK, NINW, 1024}; pg8::StaticOrder S; S.init(NTOK, 5120, G, opaque_bid());
            pg8::gemm_phase<pg8::EpiIn, pg8::StaticOrder, true, true>(lds, g, S, EI); });
        PHASE({ _Pragma("nounroll") for (int rep = 0; rep < XREP_MIX; ++rep) { mixer_phase(P, l, lds_raw, lds, rep, EI); if (rep + 1 < XREP_MIX) xcd_barrier(bar); } });
        PHASE({ pg8::Gemm g{(const bf16_t*)(P.ws + WS_ACAT), (const bf16_t*)(P.ws + WS_WCAT) + (size_t)l * 1024 * 2048, NTOK, 1024, 2048}; pg8::StaticOrder S; S.init(NTOK, 1024, G, opaque_bid());
            pg8::EpiMerge E{(const bf16_t*)(P.ws + WS_G), (bf16_t*)(P.ws + WS_MERGED)};

#ifndef NO_G2
 pg8::gemm_phase<pg8::EpiMerge, pg8::StaticOrder, true, true>(lds, g, S, E);
#endif
 });
        PHASE({ pg8::Gemm g{(const bf16_t*)(P.ws + WS_MERGED), (const bf16_t*)(P.ws + WS_WOUT) + (size_t)l * 1024 * 1024, NTOK, 1024, 1024}; pg8::StaticOrder S; S.init(NTOK, 1024, G, opaque_bid());
            pg8::EpiRes E{l == 0 ? P.in[0] : (const float*)nullptr, P.in[1] - (size_t)NCTX * 1024, (const bf16_t*)(P.ws + WS_X16), (bf16_t*)(P.ws + WS_X16), (float*)nullptr, mod + 2048, H, (const float*)(P.ws + WS_WMOD) + (size_t)(l * 2 + 1) * 5 * 1024, (float*)(P.ws + WS_SSQ)};

#ifndef NO_G3
 pg8::gemm_phase<pg8::EpiRes, pg8::StaticOrder, true, true>(lds, g, S, E);
#endif
 });
        PHASE({ RS_RESET(); pg8::Gemm g{H, (const bf16_t*)(P.ws + WS_W1) + (size_t)l * DFF * 1024, NTOK, DFF, 1024}; pg8::StaticOrder S; S.init(NTOK, DFF, G, opaque_bid());
            pg8::EpiUp E{(bf16_t*)(P.ws + WS_U), (const float*)(P.ws + WS_SSQ), (const float*)(P.ws + WS_SWUP) + (size_t)l * 5 * DFF, (LAS float*)(lds + RED_OFF) + 2048 + 64};

#ifndef NO_G4
 pg8::gemm_phase<pg8::EpiUp, pg8::StaticOrder, true, true>(lds, g, S, E);
#endif
 });
        PHASE({ pg8::Gemm g{(const bf16_t*)(P.ws + WS_U), (const bf16_t*)(P.ws + WS_W2) + (size_t)l * 1024 * DFF, NTOK, 1024, DFF}; pg8::StaticOrder S; S.init(NTOK, 1024, G, opaque_bid());
            pg8::EpiRes E{(const float*)nullptr, (const float*)nullptr, (const bf16_t*)(P.ws + WS_X16), (bf16_t*)(P.ws + WS_X16), l + 1 < NL ? (float*)nullptr : P.out, mod + 5 * 1024, l + 1 < NL ? H : (bf16_t*)nullptr, (const float*)(P.ws + WS_WMOD) + (size_t)((l + 1) * 2) * 5 * 1024, (float*)(P.ws + WS_SSQ)};

#ifndef NO_G3
 pg8::gemm_phase<pg8::EpiRes, pg8::StaticOrder, true, true>(lds, g, S, E);
#endif
 });
    }
#undef PHASE
#ifdef DUMP_PH
    grid.sync();
    { const v4u* src = (const v4u*)(P.ws + (size_t)DUMP_OFF * MiB); v4u* dst = (v4u*)P.out; const size_t n = (size_t)(33554432 + 262144) / 4;
      const size_t nl = (size_t)DUMP_LEN * MiB / 16; const v4u z = {0u, 0u, 0u, 0u};
      for (size_t i = (size_t)blockIdx.x * 512 + threadIdx.x; i < n; i += (size_t)gridDim.x * 512) dst[i] = i < nl ? src[i] : z; }
#endif
}

extern "C" void kernel_launch(void* const* d_in, const int* in_sizes, int n_in, void* d_out, int out_size, void* d_ws, size_t ws_size, hipStream_t stream) {
    static int grid = 0;
    if (grid == 0) {
        if (n_in != 27 || ws_size < WS_END) { fprintf(stderr, "kernel_launch: unexpected n_in %d / ws_size %zu (need %zu)\n", n_in, ws_size, (size_t)WS_END); grid = -1; return; }
        int dev = 0, cus = 0, per_cu = 0;
        (void)hipGetDevice(&dev); (void)hipDeviceGetAttribute(&cus, hipDeviceAttributeMultiprocessorCount, dev);
        if (hipFuncSetAttribute((const void*)fwd_megakernel, hipFuncAttributeMaxDynamicSharedMemorySize, LDS_BYTES) != hipSuccess) { fprintf(stderr, "kernel_launch: hipFuncSetAttribute failed\n"); grid = -1; return; }
        if (hipOccupancyMaxActiveBlocksPerMultiprocessor(&per_cu, (const void*)fwd_megakernel, 512, LDS_BYTES) != hipSuccess || per_cu < 1) { fprintf(stderr, "kernel_launch: occupancy query says %d\n", per_cu); per_cu = 1; }
        (void)hipGetLastError();
        grid = cus * 1;
        if (grid <= 0) grid = 256;
    }
    if (grid < 0) return;
    (void)hipMemsetAsync((char*)d_ws + WS_CTL, 0, 65536, stream);
    Params p{};
    for (int i = 0; i < 27; ++i) p.in[i] = (const float*)d_in[i];
    p.out = (float*)d_out; p.ws = (unsigned char*)d_ws;
#ifndef MK_SPLIT
#ifdef DUMP_PH
    p.ph_lo = 0; p.ph_hi = DUMP_PH;
#else
    p.ph_lo = 0; p.ph_hi = 1000;
#endif
    void* args[] = {&p};
    hipError_t e = hipLaunchCooperativeKernel((const void*)fwd_megakernel, dim3(grid), dim3(512), args, LDS_BYTES, stream);
    if (e != hipSuccess) fprintf(stderr, "cooperative launch failed: %s (grid %d)\n", hipGetErrorString(e), grid);
#else
    const int nph = 2 + NL * 6;
    for (int k = 0; k < nph; ++k) { p.ph_lo = k; p.ph_hi = k + 1; hipLaunchKernelGGL(fwd_megakernel, dim3(grid), dim3(512), LDS_BYTES, stream, p); }
#endif
}
```

```cpp
#include <hip/hip_runtime.h>
#include <hip/hip_cooperative_groups.h>
#include <hip/hip_bf16.h>
#include <cstdio>
#include <cstdint>
namespace cg = cooperative_groups;
namespace pg8 {
#define PG8_LAS __attribute__((address_space(3)))
typedef unsigned short bf16_t;
typedef short bf16x8 __attribute__((ext_vector_type(8)));
typedef float f32x4 __attribute__((ext_vector_type(4)));
typedef unsigned u32x4 __attribute__((ext_vector_type(4)));
constexpr int BM = 256, BK = 64, HALF = 128, HTB = HALF * BK * 2  , STAGE_BYTES = 8 * HTB, NXCD = 8, WGM = 8;

__host__ __device__ __forceinline__ int lds_byte(int r, int c) { const int st = (r >> 4) * 2 + (c >> 5), rr = r & 15, cc = c & 31, ob = rr * 64 + cc * 2; return st * 1024 + (ob ^ (((ob >> 9) & 1) << 5)); }
__host__ __device__ __forceinline__ void stage_rc(int b, int& R, int& C) { const int st = b / 1024, sb = b % 1024, swz = sb ^ (((sb >> 9) & 1) << 5); R = (st >> 1) * 16 + swz / 64; C = (st & 1) * 32 + (swz % 64) / 2; }
__host__ __device__ __forceinline__ int perm32(int rho) { const int n = rho >> 4, i = rho & 15; return 8 * (i >> 2) + 4 * n + (i & 3); }

struct Unit { int pm, pn; };
struct Gemm { const bf16_t* A; const bf16_t* Bt; int M, N, K; };

struct StaticOrder {
    int nM, nN, nwg, G, c;
    __host__ __device__ void init(int M, int N, int G_, int c_) { nM = M / BM; nN = N / BM; nwg = nM * nN; G = G_; c = c_; }
    __host__ __device__ bool next(int i, Unit& u) const {
        const long L = (long)i * G + c; if (L >= nwg) return false;
        int wgid = (int)L; { const int q = nwg / NXCD, r = nwg % NXCD, xcd = wgid % NXCD, off = wgid / NXCD; wgid = (xcd < r ? xcd * (q + 1) : r * (q + 1) + (xcd - r) * q) + off; }
        const int nig = WGM * nN, gid = wgid / nig, fm = gid * WGM, gsz = (nM - fm) < WGM ? (nM - fm) : WGM;
        u.pm = fm + ((wgid % nig) % gsz); u.pn = (wgid % nig) / gsz; return true;
    }
    __device__ __forceinline__ void a_ready(const Unit&) const {}
    __device__ __forceinline__ void done(const Unit&) const {}
};

typedef float f32x2c_t __attribute__((ext_vector_type(2))); typedef __bf16 bf16x2c_t __attribute__((ext_vector_type(2)));
__device__ __forceinline__ unsigned cvt_pk_bf16(float lo, float hi) { f32x2c_t v = {lo, hi}; bf16x2c_t b = __builtin_convertvector(v, bf16x2c_t); return __builtin_bit_cast(unsigned, b); }
typedef float f32x2 __attribute__((ext_vector_type(2)));
typedef unsigned u32x2 __attribute__((ext_vector_type(2)));
__device__ __forceinline__ float bf2f(unsigned short u) { return __uint_as_float(((unsigned)u) << 16); }
__device__ __forceinline__ float fsigmoid(float x) { return __builtin_amdgcn_rcpf(1.0f + __expf(-x)); }
__device__ __forceinline__ float gelu_tanh(float x) { const float u = 1.5957691216057308f * (x + 0.044715f * x * x * x); return x * __builtin_amdgcn_rcpf(1.0f + __expf(-u)); }
__device__ __forceinline__ u32x2 pack4(f32x4 v) { u32x2 w; w.x = cvt_pk_bf16(v[0], v[1]); w.y = cvt_pk_bf16(v[2], v[3]); return w; }
__host__ __device__ __forceinline__ int dim_of_pos(int p) { const int pi = p >> 1, wh = p & 1; return (pi >> 5) * 64 + wh * 32 + (pi & 31); }
__host__ __device__ __forceinline__ int pos_of_dim(int d) { const int ax = d >> 6, wh = (d >> 5) & 1, i = d & 31; return 2 * (ax * 32 + i) + wh; }

constexpr int NTOK = 16384, NCTX = 8192, DM = 1024;
constexpr float EPSN = 1e-6f;


template <bool PERMC>
__device__ __forceinline__ void prenorm_apply(f32x4 (&acc)[2][2][4][2], const Unit& u, int wr, int wc, int fr, int fq, const float* ssq, const float* sw, int ncols, PG8_LAS float* rs) {
    const int rowt = wr * 64 + fr, colw = u.pn * 256 + wc * 32 + (PERMC ? 8 : 4) * fq;
    const int cond = u.pm < 32 ? 0 : 1 + ((u.pm - 32) >> 3);
    const float* swp = sw + (size_t)cond * ncols + colw;
    const int t = (wr * 4 + wc) * 64 + fq * 16 + fr;
    const bool rebuild = ((const PG8_LAS int*)rs)[256] != u.pm;
    if (rebuild && t < 256) {
        const float* sp = ssq + (size_t)(u.pm * 256 + t) * 16;
        const f32x4 s0 = *(const f32x4*)sp, s1 = *(const f32x4*)(sp + 4), s2 = *(const f32x4*)(sp + 8), s3 = *(const f32x4*)(sp + 12);
        const f32x4 st = (s0 + s1) + (s2 + s3);
        rs[t] = __builtin_amdgcn_rsqf(((st[0] + st[1]) + (st[2] + st[3])) * (1.0f / 1024.0f) + EPSN);
    }
    f32x4 sv[2][2];
#pragma unroll
    for (int bj = 0; bj < 2; ++bj)
#pragma unroll
        for (int n = 0; n < 2; ++n) sv[bj][n] = *(const f32x4*)(swp + bj * 128 + (PERMC ? 4 : 16) * n);
    if (rebuild) {
        asm volatile("s_waitcnt lgkmcnt(0)" ::: "memory"); __builtin_amdgcn_s_barrier(); asm volatile("" ::: "memory");
        if (t == 0) ((PG8_LAS int*)rs)[256] = u.pm;
    }
#pragma unroll
    for (int ai = 0; ai < 2; ++ai)
#pragma unroll
        for (int m = 0; m < 4; ++m) {
            const float rstd = rs[ai * 128 + m * 16 + rowt];
#pragma unroll
            for (int bj = 0; bj < 2; ++bj)
#pragma unroll
                for (int n = 0; n < 2; ++n) acc[ai][bj][m][n] = acc[ai][bj][m][n] * rstd + sv[bj][n];
        }
}

struct EpiIn {
    static constexpr bool PERM = true, AFTER_DRAIN = false, HAS_MID = false;
    bf16_t *Q, *KB, *VB, *XR, *GXB, *G; float *outk, *outv; const float *qw, *kw, *rope; PG8_LAS float* red; int layer; const float *ssq, *sw;
    __device__ __forceinline__ void operator()(f32x4 (&acc)[2][2][4][2], const Unit& u, int wr, int wc, int fr, int fq) const {
        asm volatile("" : "+v"(fr), "+v"(fq));
        prenorm_apply<true>(acc, u, wr, wc, fr, fq, ssq, sw, 5632, red + 2048 + 64);
        const int pn = u.pn, pm = u.pm;
        const int rowt = wr * 64 + fr, colw = wc * 32 + 8 * fq;
        const bool latent = pm >= 32;
        if (pn < 5) {
#pragma unroll
            for (int ai = 0; ai < 2; ++ai)
#pragma unroll
                for (int m = 0; m < 4; ++m)
#pragma unroll
                    for (int bj = 0; bj < 2; ++bj) {
                        float s = 0.f;
#pragma unroll
                        for (int n = 0; n < 2; ++n) { const f32x4 x = acc[ai][bj][m][n]; s += (x[0] * x[0] + x[1] * x[1]) + (x[2] * x[2] + x[3] * x[3]); }
                        s += __shfl_xor(s, 16); s += __shfl_xor(s, 32);
                        if (fq == 0) red[((ai * 128 + m * 16 + rowt) * 2 + bj) * 4 + wc] = s;
                    }
            asm volatile("s_waitcnt lgkmcnt(0)" ::: "memory"); __builtin_amdgcn_s_barrier(); asm volatile("" ::: "memory");
            const float* nw = pn < 4 ? qw : kw;
            f32x4 wv[2];
#pragma unroll
            for (int n = 0; n < 2; ++n)
#pragma unroll
                for (int e = 0; e < 4; ++e) wv[n][e] = nw[dim_of_pos(colw + 4 * n + e)];
#pragma unroll
            for (int ai = 0; ai < 2; ++ai)
#pragma unroll
                for (int m = 0; m < 4; ++m) {
                    const int rl = ai * 128 + m * 16 + rowt, row = pm * 256 + rl;
#pragma unroll
                    for (int bj = 0; bj < 2; ++bj) {
                        const f32x4 pr = *(const PG8_LAS f32x4*)(red + (rl * 2 + bj) * 4);
                        const float rstd = __builtin_amdgcn_rsqf(((pr[0] + pr[1]) + (pr[2] + pr[3])) * (1.0f / 128.0f) + EPSN);
                        u32x2 pk[2]; float kx[2][2], ky[2][2];
#pragma unroll
                        for (int n = 0; n < 2; ++n) {
                            f32x4 v = acc[ai][bj][m][n] * rstd * wv[n];
                            const int p = colw + 4 * n;
                            if (!latent && pn == 4) { kx[n][0] = v[0]; kx[n][1] = v[2]; ky[n][0] = v[1]; ky[n][1] = v[3]; }
                            if (latent) {
                                const int t = (row - NCTX) & 2047;
                                const f32x4 cs = *(const f32x4*)(rope + ((size_t)t * 64 + (p >> 1)) * 2);
                                f32x4 o; o[0] = v[0] * cs[0] - v[1] * cs[1]; o[1] = v[1] * cs[0] + v[0] * cs[1]; o[2] = v[2] * cs[2] - v[3] * cs[3]; o[3] = v[3] * cs[2] + v[2] * cs[3];
                                v = o;
                            }
                            pk[n] = pack4(v);
                        }
                        if (!latent && pn == 4) {
                            float* o = outk + ((size_t)((pm * 4 + layer) * 256 + rl) * 2 + bj) * 128 + dim_of_pos(colw);
                            *(f32x4*)o = (f32x4){kx[0][0], kx[0][1], kx[1][0], kx[1][1]}; *(f32x4*)(o + 32) = (f32x4){ky[0][0], ky[0][1], ky[1][0], ky[1][1]};
                        }
                        bf16_t* dst = (pn < 4) ? Q + (size_t)row * 1024 + pn * 256 + bj * 128 + colw : KB + (size_t)row * 256 + bj * 128 + colw;
                        u32x4 w; w.x = pk[0].x; w.y = pk[0].y; w.z = pk[1].x; w.w = pk[1].y;
                        *(u32x4*)dst = w;
                    }
                }
        } else {
#pragma unroll
            for (int ai = 0; ai < 2; ++ai)
#pragma unroll
                for (int m = 0; m < 4; ++m) {
                    const int rl = ai * 128 + m * 16 + rowt, row = pm * 256 + rl;
#pragma unroll
                    for (int bj = 0; bj < 2; ++bj) {
                        f32x4 v0 = acc[ai][bj][m][0], v1 = acc[ai][bj][m][1];
                        const int c = bj * 128 + colw;
                        bf16_t* dst;
                        if (pn == 5) {
                            if (!latent) { float* o = outv + ((size_t)((pm * 4 + layer) * 256 + rl)) * 256 + c; *(f32x4*)o = v0; *(f32x4*)(o + 4) = v1; }
                            dst = VB + (size_t)row * 256 + c;
                        } else if (pn < 10) {
                            dst = XR + (size_t)row * 1024 + (pn - 6) * 256 + c;
                        } else if (pn < 14) {
#pragma unroll
                            for (int e = 0; e < 4; ++e) { v0[e] = gelu_tanh(v0[e]); v1[e] = gelu_tanh(v1[e]); }
                            dst = GXB + (size_t)row * 1024 + (pn - 10) * 256 + c;
                        } else {
#pragma unroll
                            for (int e = 0; e < 4; ++e) { v0[e] = fsigmoid(v0[e]); v1[e] = fsigmoid(v1[e]); }
                            dst = G + (size_t)row * 2048 + (pn - 14) * 256 + c;
                        }
                        const u32x2 p0 = pack4(v0), p1 = pack4(v1);
                        u32x4 w; w.x = p0.x; w.y = p0.y; w.z = p1.x; w.w = p1.y;
                        *(u32x4*)dst = w;
                    }
                }
        }
    }
};

struct EpiMerge {
    static constexpr bool PERM = true, AFTER_DRAIN = false, HAS_MID = true;
    const bf16_t* G; bf16_t* O;
    __device__ __forceinline__ static f32x4 lo4(u32x4 g) { f32x4 r; r[0] = __uint_as_float(g.x << 16); r[1] = __uint_as_float(g.x & 0xffff0000u); r[2] = __uint_as_float(g.y << 16); r[3] = __uint_as_float(g.y & 0xffff0000u); return r; }
    __device__ __forceinline__ static f32x4 hi4(u32x4 g) { f32x4 r; r[0] = __uint_as_float(g.z << 16); r[1] = __uint_as_float(g.z & 0xffff0000u); r[2] = __uint_as_float(g.w << 16); r[3] = __uint_as_float(g.w & 0xffff0000u); return r; }
    __device__ __forceinline__ static f32x4 rcp4(f32x4 x) { f32x4 r; r[0] = __builtin_amdgcn_rcpf(fmaxf(x[0], 1e-20f)); r[1] = __builtin_amdgcn_rcpf(fmaxf(x[1], 1e-20f)); r[2] = __builtin_amdgcn_rcpf(fmaxf(x[2], 1e-20f)); r[3] = __builtin_amdgcn_rcpf(fmaxf(x[3], 1e-20f)); return r; }
    __device__ __forceinline__ void mid(f32x4 (&acc)[2][2][4][2], const Unit& u, int wr, int wc, int fr, int fq) const {
        asm volatile("" : "+v"(fr), "+v"(fq));
        const int rowt = wr * 64 + fr, colw = u.pn * 256 + wc * 32 + 8 * fq;
#pragma unroll
        for (int ai = 0; ai < 2; ++ai)
#pragma unroll
            for (int m = 0; m < 4; ++m) {
                const bf16_t* gr = G + (size_t)(u.pm * 256 + ai * 128 + m * 16 + rowt) * 2048 + colw;
#pragma unroll
                for (int bj = 0; bj < 2; ++bj) {
                    const u32x4 a = *(const u32x4*)(gr + bj * 128), l = *(const u32x4*)(gr + 1024 + bj * 128);
                    acc[ai][bj][m][0] *= lo4(a) * rcp4(lo4(l));
                    acc[ai][bj][m][1] *= hi4(a) * rcp4(hi4(l));
                }
            }
    }
    __device__ __forceinline__ void operator()(f32x4 (&acc)[2][2][4][2], const Unit& u, int wr, int wc, int fr, int fq) const {
        asm volatile("" : "+v"(fr), "+v"(fq));
        const int rowt = wr * 64 + fr, colw = u.pn * 256 + wc * 32 + 8 * fq;
#pragma unroll
        for (int ai = 0; ai < 2; ++ai)
#pragma unroll
            for (int m = 0; m < 4; ++m) {
                const size_t row = (size_t)(u.pm * 256 + ai * 128 + m * 16 + rowt);
                const bf16_t* gr = G + row * 2048 + 1024 + colw;
#pragma unroll
                for (int bj = 0; bj < 2; ++bj) {
                    const u32x4 l = *(const u32x4*)(gr + bj * 128);
                    const u32x2 p0 = pack4(acc[ai][bj][m][0] * lo4(l)), p1 = pack4(acc[ai][bj][m][1] * hi4(l));
                    u32x4 w; w.x = p0.x; w.y = p0.y; w.z = p1.x; w.w = p1.y;
                    *(u32x4*)(O + row * 1024 + colw + bj * 128) = w;
                }
            }
    }
};

struct EpiRes {
    static constexpr bool PERM = false, AFTER_DRAIN = false, HAS_MID = false;
    const float* xin0; const float* xin1; const bf16_t* xs16; bf16_t* x16o; float* yout; const float* gate; bf16_t* Hn; const float* wmod; float* ssq;
    __device__ __forceinline__ void operator()(f32x4 (&acc)[2][2][4][2], const Unit& u, int wr, int wc, int fr, int fq) const {
        asm volatile("" : "+v"(fr), "+v"(fq));
        const int rowt = wr * 64 + fr, colw = u.pn * 256 + wc * 32 + 4 * fq;
        const int cond = u.pm < 32 ? 0 : 1 + ((u.pm - 32) >> 3);
        const float* xin = u.pm < 32 ? xin0 : xin1;
#pragma unroll
        for (int ai = 0; ai < 2; ++ai)
#pragma unroll
            for (int m = 0; m < 4; ++m) {
                const int row = u.pm * 256 + ai * 128 + m * 16 + rowt;
                const size_t off = (size_t)row * 1024 + colw;
                const float* gp = gate + cond * 6144 + colw;
                float sq = 0.f;
#pragma unroll
                for (int bj = 0; bj < 2; ++bj)
#pragma unroll
                    for (int n = 0; n < 2; ++n) {
                        f32x4 x;
                        if (xin0) x = *(const f32x4*)(xin + off + bj * 128 + 16 * n);
                        else { const u32x2 xb = *(const u32x2*)(xs16 + off + bj * 128 + 16 * n);
                            x[0] = __uint_as_float(xb.x << 16); x[1] = __uint_as_float(xb.x & 0xffff0000u); x[2] = __uint_as_float(xb.y << 16); x[3] = __uint_as_float(xb.y & 0xffff0000u); }
                        const f32x4 gvv = *(const f32x4*)(gp + bj * 128 + 16 * n);
                        const f32x4 xn = x + gvv * acc[ai][bj][m][n];
                        if (yout) *(f32x4*)(yout + off + bj * 128 + 16 * n) = xn;
                        else *(u32x2*)(x16o + off + bj * 128 + 16 * n) = pack4(xn);
                        if (Hn) { const f32x4 wm = *(const f32x4*)(wmod + cond * 1024 + colw + bj * 128 + 16 * n);
                            *(u32x2*)(Hn + off + bj * 128 + 16 * n) = pack4(xn * wm);
                            sq += (xn[0] * xn[0] + xn[1] * xn[1]) + (xn[2] * xn[2] + xn[3] * xn[3]); }
                    }
                if (Hn) { sq += __shfl_xor(sq, 16); sq += __shfl_xor(sq, 32); if (fq == 0) ssq[(size_t)row * 16 + u.pn * 4 + wc] = sq; }
            }
    }
};

struct EpiUp {
    static constexpr bool PERM = true, AFTER_DRAIN = false, HAS_MID = false;
    bf16_t* U; const float *ssq, *sw; PG8_LAS float* rs;
    __device__ __forceinline__ void operator()(f32x4 (&acc)[2][2][4][2], const Unit& u, int wr, int wc, int fr, int fq) const {
        asm volatile("" : "+v"(fr), "+v"(fq));
        prenorm_apply<true>(acc, u, wr, wc, fr, fq, ssq, sw, 4096, rs);
        const int rowt = wr * 64 + fr, colw = u.pn * 256 + wc * 32 + 8 * fq;
#pragma unroll
        for (int ai = 0; ai < 2; ++ai)
#pragma unroll
            for (int m = 0; m < 4; ++m) {
                bf16_t* rp = U + (size_t)(u.pm * 256 + ai * 128 + m * 16 + rowt) * 4096 + colw;
#pragma unroll
                for (int bj = 0; bj < 2; ++bj) {
                    f32x4 v0 = acc[ai][bj][m][0], v1 = acc[ai][bj][m][1];
#pragma unroll
                    for (int e = 0; e < 4; ++e) { const float r0 = fmaxf(v0[e], 0.f), r1 = fmaxf(v1[e], 0.f); v0[e] = r0 * r0; v1[e] = r1 * r1; }
                    const u32x2 p0 = pack4(v0), p1 = pack4(v1);
                    u32x4 w; w.x = p0.x; w.y = p0.y; w.z = p1.x; w.w = p1.y;
                    *(u32x4*)(rp + bj * 128) = w;
                }
            }
    }
};
template <class Epi, class Sched, bool ALIGN_EPI = false, bool SP2 = false>
__device__ __forceinline__ void gemm_phase(PG8_LAS unsigned char* lds, const Gemm g, const Sched& S, const Epi& E) {
    int tid_l = threadIdx.x; asm volatile("" : "+v"(tid_l));
    const int tid = tid_l, wid = __builtin_amdgcn_readfirstlane(tid >> 6), lane = tid & 63, wr = wid >> 2, wc = wid & 3, fr = lane & 15, fq = lane >> 4;
    const int K = g.K, nt = K / BK;
    unsigned voffA[2], voffB[2];
#pragma unroll
    for (int i = 0; i < 2; ++i) { int R, C; stage_rc(tid * 16 + i * 8192, R, C); const int Rb = Epi::PERM ? ((R & ~31) + perm32(R & 31)) : R;
        voffA[i] = (unsigned)(R * K + C) * 2u; voffB[i] = (unsigned)(Rb * K + C) * 2u; }
    const size_t kstep = (size_t)(BK * 2);
    const size_t hstep = (size_t)HALF * K * 2;
    const size_t tstep = 2 * hstep;
    const unsigned ldsw = (unsigned)wid * 1024u;
    const int aoff = lds_byte(wr * 64 + fr, fq * 8), boff = lds_byte(wc * 32 + fr, fq * 8);
#define PG8_SA(b, h) (((b) * 2 + (h)) * HTB)
#define PG8_SB(b, h) ((4 + (b) * 2 + (h)) * HTB)
#define PG8_STAGE(bufoff, gbase, voff) do { _Pragma("unroll") for (int _i = 0; _i < 2; ++_i) \
        __builtin_amdgcn_global_load_lds((const unsigned*)((const char*)(gbase) + (voff)[_i]), (PG8_LAS unsigned*)(lds + (bufoff) + ldsw + _i * 8192), 16, 0, 0); } while (0)
#define PG8_LDA(dst, b, h) do { _Pragma("unroll") for (int m = 0; m < 4; ++m) _Pragma("unroll") for (int k = 0; k < 2; ++k) dst[m][k] = *(const PG8_LAS bf16x8*)(lds + PG8_SA(b, h) + aoff + m * 2048 + k * 1024); } while (0)
#define PG8_LDB(dst, b, h) do { _Pragma("unroll") for (int n = 0; n < 2; ++n) _Pragma("unroll") for (int k = 0; k < 2; ++k) dst[n][k] = *(const PG8_LAS bf16x8*)(lds + PG8_SB(b, h) + boff + n * 2048 + k * 1024); } while (0)
#define PG8_MMA(ai, bj, At, Bt) do { __builtin_amdgcn_s_setprio(1); _Pragma("unroll") for (int m = 0; m < 4; ++m) _Pragma("unroll") for (int n = 0; n < 2; ++n) _Pragma("unroll") for (int k = 0; k < 2; ++k) \
        acc[ai][bj][m][n] = __builtin_amdgcn_mfma_f32_16x16x32_bf16(Bt[n][k], At[m][k], acc[ai][bj][m][n], 0, 0, 0); __builtin_amdgcn_s_setprio(0); } while (0)
#define PG8_WAIT_V(n) asm volatile("s_waitcnt vmcnt(" #n ")" ::: "memory")
#define PG8_WAIT_L(n) asm volatile("s_waitcnt lgkmcnt(" #n ")" ::: "memory")
#define PG8_BAR __builtin_amdgcn_s_barrier()
#define PG8_SCHED __builtin_amdgcn_sched_barrier(0)
    Unit cur, nxt; int ui = 0;
    if (!S.next(0, cur)) return;
    f32x4 acc[2][2][4][2];
#pragma unroll
    for (int a = 0; a < 2; ++a)
#pragma unroll
        for (int b = 0; b < 2; ++b)
#pragma unroll
            for (int m = 0; m < 4; ++m)
#pragma unroll
                for (int n = 0; n < 2; ++n) acc[a][b][m][n] = (f32x4){0.f, 0.f, 0.f, 0.f};
    bf16x8 At[4][2], B0[2][2], B1[2][2];
    const char* cA = (const char*)g.A + (size_t)cur.pm * tstep; const char* cB = (const char*)g.Bt + (size_t)cur.pn * tstep;
    S.a_ready(cur);
    if constexpr (SP2) {
        PG8_STAGE(PG8_SB(0, 0), cB, voffB); PG8_STAGE(PG8_SB(0, 1), cB + hstep, voffB); PG8_STAGE(PG8_SA(0, 0), cA, voffA); PG8_STAGE(PG8_SA(0, 1), cA + hstep, voffA);
        if (wr == 1) PG8_BAR;
        PG8_WAIT_V(2); PG8_BAR;
        PG8_STAGE(PG8_SB(1, 0), cB + kstep, voffB); PG8_STAGE(PG8_SA(1, 0), cA + kstep, voffA); PG8_STAGE(PG8_SB(1, 1), cB + hstep + kstep, voffB);
        PG8_WAIT_V(6); PG8_BAR;
    } else {
        PG8_STAGE(PG8_SB(0, 0), cB, voffB); PG8_STAGE(PG8_SA(0, 0), cA, voffA); PG8_STAGE(PG8_SB(0, 1), cB + hstep, voffB); PG8_STAGE(PG8_SA(0, 1), cA + hstep, voffA);
        if (wr == 1) PG8_BAR;
        PG8_WAIT_V(4); PG8_BAR;
        PG8_STAGE(PG8_SB(1, 0), cB + kstep, voffB); PG8_STAGE(PG8_SA(1, 0), cA + kstep, voffA); PG8_STAGE(PG8_SB(1, 1), cB + hstep + kstep, voffB);
        PG8_WAIT_V(6); PG8_BAR;
    }
    for (;;) {
        const bool has_next = S.next(ui + 1, nxt);
        const char* nA = has_next ? (const char*)g.A + (size_t)nxt.pm * tstep : cA; const char* nB = has_next ? (const char*)g.Bt + (size_t)nxt.pn * tstep : cB;
        for (int t = 0; t < nt; t += 2) {
            if constexpr (Epi::HAS_MID) { if (t == (nt >> 1)) E.mid(acc, cur, wr, wc, fr, fq); }
            const bool last = (t == nt - 2);
            const char* a1 = cA + (size_t)(t + 1) * kstep;
            const char* a2 = last ? nA : cA + (size_t)(t + 2) * kstep; const char* b2 = last ? nB : cB + (size_t)(t + 2) * kstep;
            const char* a3 = a2 + kstep; const char* b3 = b2 + kstep;
            if (last && has_next) S.a_ready(nxt);
            if constexpr (SP2) {
            PG8_LDB(B0, 0, 0); PG8_LDB(B1, 0, 1); PG8_SCHED; PG8_LDA(At, 0, 0); PG8_STAGE(PG8_SA(1, 1), a1 + hstep, voffA);
            PG8_WAIT_V(8); PG8_WAIT_L(0); PG8_BAR; PG8_MMA(0, 0, At, B0); PG8_MMA(0, 1, At, B1); PG8_BAR; PG8_SCHED;
            PG8_LDA(At, 0, 1); PG8_STAGE(PG8_SB(0, 0), b2, voffB); PG8_STAGE(PG8_SB(0, 1), b2 + hstep, voffB); PG8_STAGE(PG8_SA(0, 0), a2, voffA);
            PG8_WAIT_V(8); PG8_WAIT_L(0); PG8_BAR; PG8_MMA(1, 0, At, B0); PG8_MMA(1, 1, At, B1); PG8_BAR; PG8_SCHED;
            PG8_LDB(B0, 1, 0); PG8_LDB(B1, 1, 1); PG8_SCHED; PG8_LDA(At, 1, 0); PG8_STAGE(PG8_SA(0, 1), a2 + hstep, voffA);
            PG8_WAIT_V(8); PG8_WAIT_L(0); PG8_BAR; PG8_MMA(0, 0, At, B0); PG8_MMA(0, 1, At, B1); PG8_BAR; PG8_SCHED;
            PG8_LDA(At, 1, 1); PG8_STAGE(PG8_SB(1, 0), b3, voffB); PG8_STAGE(PG8_SB(1, 1), b3 + hstep, voffB); PG8_STAGE(PG8_SA(1, 0), a3, voffA);
            PG8_WAIT_V(8); PG8_WAIT_L(0); PG8_BAR; PG8_MMA(1, 0, At, B0); PG8_MMA(1, 1, At, B1); PG8_BAR; PG8_SCHED;
            } else {
            PG8_LDB(B0, 0, 0); PG8_SCHED; PG8_LDA(At, 0, 0); PG8_STAGE(PG8_SA(1, 1), a1 + hstep, voffA);
            PG8_WAIT_L(8); PG8_BAR; PG8_WAIT_L(0); PG8_MMA(0, 0, At, B0); PG8_BAR; PG8_SCHED;
            PG8_LDB(B1, 0, 1); PG8_STAGE(PG8_SB(0, 0), b2, voffB);
            PG8_BAR; PG8_WAIT_L(0); PG8_MMA(0, 1, At, B1); PG8_BAR;
            PG8_LDA(At, 0, 1); PG8_STAGE(PG8_SA(0, 0), a2, voffA);
            PG8_BAR; PG8_WAIT_L(0); PG8_MMA(1, 0, At, B0); PG8_BAR; PG8_SCHED;
            PG8_STAGE(PG8_SB(0, 1), b2 + hstep, voffB);
            PG8_WAIT_V(6); PG8_BAR; PG8_MMA(1, 1, At, B1); PG8_BAR;
            PG8_LDB(B0, 1, 0); PG8_SCHED; PG8_LDA(At, 1, 0); PG8_STAGE(PG8_SA(0, 1), a2 + hstep, voffA);
            PG8_WAIT_L(8); PG8_BAR; PG8_WAIT_L(0); PG8_MMA(0, 0, At, B0); PG8_BAR; PG8_SCHED;
            PG8_LDB(B1, 1, 1); PG8_STAGE(PG8_SB(1, 0), b3, voffB);
            PG8_BAR; PG8_WAIT_L(0); PG8_MMA(0, 1, At, B1); PG8_BAR;
            PG8_LDA(At, 1, 1); PG8_STAGE(PG8_SA(1, 0), a3, voffA);
            PG8_BAR; PG8_WAIT_L(0); PG8_MMA(1, 0, At, B0); PG8_BAR; PG8_SCHED;
            PG8_STAGE(PG8_SB(1, 1), b3 + hstep, voffB);
            PG8_WAIT_V(6); PG8_BAR; PG8_MMA(1, 1, At, B1); PG8_BAR;
            }
        }
        if constexpr (ALIGN_EPI) { if (wr == 0) PG8_BAR; }
        if constexpr (!Epi::AFTER_DRAIN) { E(acc, cur, wr, wc, fr, fq); S.done(cur); }
        if (!has_next) break;
#pragma unroll
        for (int a = 0; a < 2; ++a)
#pragma unroll
            for (int b = 0; b < 2; ++b)
#pragma unroll
                for (int m = 0; m < 4; ++m)
#pragma unroll
                    for (int n = 0; n < 2; ++n) acc[a][b][m][n] = (f32x4){0.f, 0.f, 0.f, 0.f};
        cur = nxt; cA = nA; cB = nB; ++ui;
        if constexpr (ALIGN_EPI) { if (wr == 1) PG8_BAR; }
    }
    PG8_WAIT_V(0);
    if constexpr (!ALIGN_EPI) { if (wr == 0) PG8_BAR; }
    PG8_BAR;
    if constexpr (Epi::AFTER_DRAIN) { E.fused(acc, cur, wr, wc, fr, fq, lds, wid, lane); S.done(cur); }
#undef PG8_SA
#undef PG8_SB
#undef PG8_STAGE
#undef PG8_LDA
#undef PG8_LDB
#undef PG8_MMA
#undef PG8_WAIT_V
#undef PG8_WAIT_L
#undef PG8_BAR
#undef PG8_SCHED
}
}

namespace att {
using bf16 = unsigned short;
using bf16x8 = __attribute__((ext_vector_type(8))) short;
using s16x4  = __attribute__((ext_vector_type(4))) short;
using f32x16 = __attribute__((ext_vector_type(16))) float;
using u32x4  = __attribute__((ext_vector_type(4))) unsigned;
constexpr int D = 128, NW = 8, QBLK = 32, KVBLK = 64;
constexpr float SCALE = 0.088388347648318440f;
constexpr float THR = 8.f;
constexpr int LDQ = 1024, LDK = 256, LDO = 2048;
constexpr size_t SHM_V = KVBLK * D * 2, SHM_K = KVBLK * D * 2, SHM_ATTN = 2 * SHM_V + 2 * SHM_K + NW * 64 * 4;
#define KSWZ(row, colB) ((row) * 256 + ((colB) ^ (((row) & 7) << 4)))
#define SBAR() __builtin_amdgcn_sched_barrier(0)
__device__ __forceinline__ int crow(int r, int hi) { return (r & 3) + 8 * (r >> 2) + 4 * hi; }
typedef float f32x2a_t __attribute__((ext_vector_type(2))); typedef __bf16 bf16x2a_t __attribute__((ext_vector_type(2)));
__device__ __forceinline__ unsigned cvtpk(float lo, float hi) { f32x2a_t v = {lo, hi}; bf16x2a_t b = __builtin_convertvector(v, bf16x2a_t); return __builtin_bit_cast(unsigned, b); }
__device__ __forceinline__ void partialSM(f32x16& p0, f32x16& p1, float& m_reg, float& mn, float& alpha) {
  constexpr float C = SCALE * 1.4426950408889634f;
  float pmax = p0[0]; for (int r = 1; r < 16; ++r) pmax = fmaxf(pmax, p0[r]); for (int r = 0; r < 16; ++r) pmax = fmaxf(pmax, p1[r]);
  { auto rr = __builtin_amdgcn_permlane32_swap(__float_as_uint(pmax), __float_as_uint(pmax), false, false);
    pmax = fmaxf(__uint_as_float(rr[0]), __uint_as_float(rr[1])); }
  if (__builtin_expect(__all(pmax - m_reg <= THR / SCALE), 1)) { mn = m_reg; alpha = 1.f; }
  else { mn = fmaxf(m_reg, pmax); alpha = __builtin_amdgcn_exp2f((m_reg - mn) * C); m_reg = mn; }
  float mnC = -mn * C;
  for (int r = 0; r < 16; ++r) p0[r] = fmaf(p0[r], C, mnC); for (int r = 0; r < 16; ++r) p1[r] = fmaf(p1[r], C, mnC);
  for (int r = 0; r < 16; ++r) p0[r] = __builtin_amdgcn_exp2f(p0[r]);
}
__device__ __forceinline__ void finishSM(f32x16& p0, f32x16& p1, float alpha, float& l_reg, bf16x8& pa0, bf16x8& pa1, bf16x8& pa2, bf16x8& pa3) {
  for (int r = 0; r < 16; ++r) p1[r] = __builtin_amdgcn_exp2f(p1[r]);
  float ps = 0; for (int r = 0; r < 16; ++r) ps += p0[r]; for (int r = 0; r < 16; ++r) ps += p1[r];
  { auto rr = __builtin_amdgcn_permlane32_swap(__float_as_uint(ps), __float_as_uint(ps), false, false);
    ps = __uint_as_float(rr[0]) + __uint_as_float(rr[1]); }
  l_reg = l_reg * alpha + ps;
#define PK4(P, BASE, OUT) do { unsigned a0 = cvtpk(P[BASE + 0], P[BASE + 1]), a1 = cvtpk(P[BASE + 2], P[BASE + 3]);   \
    unsigned b0 = cvtpk(P[BASE + 4], P[BASE + 5]), b1 = cvtpk(P[BASE + 6], P[BASE + 7]);                              \
    auto r0 = __builtin_amdgcn_permlane32_swap(a0, b0, false, false); auto r1 = __builtin_amdgcn_permlane32_swap(a1, b1, false, false); \
    u32x4 w = {r0[0], r1[0], r0[1], r1[1]}; OUT = *reinterpret_cast<bf16x8*>(&w); } while (0)
  PK4(p0, 0, pa0); PK4(p0, 8, pa1); PK4(p1, 0, pa2); PK4(p1, 8, pa3);
#undef PK4
}
__device__ __forceinline__ void qkt(f32x16& p0, f32x16& p1, const bf16* Ks, const bf16x8* qr, int r32, int hi) {
  p0 = f32x16{}; p1 = f32x16{};
  for (int d0 = 0; d0 < 8; ++d0) { int cb = (d0 * 16 + hi * 8) * 2;
    bf16x8 b0 = *reinterpret_cast<const bf16x8*>((const char*)Ks + KSWZ(r32, cb));
    bf16x8 b1 = *reinterpret_cast<const bf16x8*>((const char*)Ks + KSWZ(32 + r32, cb));
    p0 = __builtin_amdgcn_mfma_f32_32x32x16_bf16(b0, qr[d0], p0, 0, 0, 0);
    p1 = __builtin_amdgcn_mfma_f32_32x32x16_bf16(b1, qr[d0], p1, 0, 0, 0); }
}
__device__ __forceinline__ void bandmask(f32x16& p0, f32x16& p1, int dk0, int hi) {
#pragma unroll
  for (int r = 0; r < 16; ++r) { const int dk = dk0 + crow(r, hi);
    if (dk < -128 || dk > 128) p0[r] = -1e30f;
    if (dk + 32 < -128 || dk + 32 > 128) p1[r] = -1e30f; }
}
__device__ __forceinline__ int v_st(int k, int c) { const int kk = (k & ~0xC) | ((k & 4) << 1) | ((k & 8) >> 1); return ((kk >> 3) * 4 + (c >> 5)) * 512 + ((kk & 7) * 32 + (c & 31)) * 2; }
__device__ __forceinline__ int v_rd_base(int lane) { return ((lane & 3) << 3) | (((lane >> 2) & 3) << 6) | (((lane >> 4) & 1) << 5) | (((lane >> 5) & 1) << 8); }
constexpr int v_rd_off(int d0, int ks, int half) { return d0 * 512 + ks * 4096 + half * 2048; }
template <int OFF> __device__ __forceinline__ s16x4 tr_read(int vb) {
  s16x4 r; asm volatile("ds_read_b64_tr_b16 %0, %1 offset:%2" : "=&v"(r) : "v"(vb), "i"(OFF) : "memory"); return r;
}
template <int D0> __device__ __forceinline__ void pv_one(f32x16& od, int vb, bf16x8 pa0, bf16x8 pa1, bf16x8 pa2, bf16x8 pa3) {
  const s16x4 l0 = tr_read<v_rd_off(D0, 0, 0)>(vb), h0 = tr_read<v_rd_off(D0, 0, 1)>(vb), l1 = tr_read<v_rd_off(D0, 1, 0)>(vb), h1 = tr_read<v_rd_off(D0, 1, 1)>(vb);
  const s16x4 l2 = tr_read<v_rd_off(D0, 2, 0)>(vb), h2 = tr_read<v_rd_off(D0, 2, 1)>(vb), l3 = tr_read<v_rd_off(D0, 3, 0)>(vb), h3 = tr_read<v_rd_off(D0, 3, 1)>(vb);
  asm volatile("s_waitcnt lgkmcnt(0)" ::: "memory"); SBAR();
#define PK(L, H) (bf16x8){L[0], L[1], L[2], L[3], H[0], H[1], H[2], H[3]}
  od = __builtin_amdgcn_mfma_f32_32x32x16_bf16(pa0, PK(l0, h0), od, 0, 0, 0);
  od = __builtin_amdgcn_mfma_f32_32x32x16_bf16(pa1, PK(l1, h1), od, 0, 0, 0);
  od = __builtin_amdgcn_mfma_f32_32x32x16_bf16(pa2, PK(l2, h2), od, 0, 0, 0);
  od = __builtin_amdgcn_mfma_f32_32x32x16_bf16(pa3, PK(l3, h3), od, 0, 0, 0);
#undef PK
}
__device__ __forceinline__ void pv_d0(f32x16* o, int vb, bf16x8 pa0, bf16x8 pa1, bf16x8 pa2, bf16x8 pa3) {
  pv_one<0>(o[0], vb, pa0, pa1, pa2, pa3); pv_one<1>(o[1], vb, pa0, pa1, pa2, pa3); pv_one<2>(o[2], vb, pa0, pa1, pa2, pa3); pv_one<3>(o[3], vb, pa0, pa1, pa2, pa3);
}

__device__ __forceinline__ void attn_unit(const bf16* __restrict__ Qb, const bf16* __restrict__ K0, const bf16* __restrict__ V0, int n0,
                                          const bf16* __restrict__ K1, const bf16* __restrict__ V1, int n1, int dq0, float sinkl2,
                                          bf16* __restrict__ Ob, char* lds) {
  int tid_l = threadIdx.x; asm volatile("" : "+v"(tid_l));
  const int tid = tid_l, wid = tid >> 6, lane = tid & 63, r32 = lane & 31, hi = lane >> 5;
  bf16* V_lds = (bf16*)lds; bf16* K_lds = (bf16*)(lds + 2 * SHM_V);
  float* ws = (float*)(lds + 2 * SHM_V + 2 * SHM_K) + wid * 64; float* li_l = ws; float* al_l = ws + 32;
  float m_reg = -1e30f, l_reg = 0; f32x16 o[4] = {}; bf16x8 qr[8];
  const bf16* Qw = Qb + (long)(wid * QBLK + r32) * LDQ + hi * 8;
#pragma unroll
  for (int d0 = 0; d0 < 8; ++d0) qr[d0] = *reinterpret_cast<const bf16x8*>(Qw + d0 * 16);
  const int sr = tid >> 4, sc = (tid & 15) * 8, vst0 = v_st(sr, sc), vst1 = v_st(32 + sr, sc);
  const int vb0 = (int)(uintptr_t)V_lds + v_rd_base(lane);
  const int dql = dq0 - (wid * QBLK + r32);
  struct { bf16x8 vs0, vs1, ks0, ks1; } sr_[2];
#define SLOAD(i, j) do { const int j_ = (j); const bf16* kt_ = j_ < n0 ? K0 + (long)j_ * (KVBLK * LDK) : K1 + (long)(j_ - n0) * (KVBLK * LDK); \
    const bf16* vt_ = j_ < n0 ? V0 + (long)j_ * (KVBLK * LDK) : V1 + (long)(j_ - n0) * (KVBLK * LDK); \
    sr_[i].vs0 = *reinterpret_cast<const bf16x8*>(&vt_[(long)sr * LDK + sc]); sr_[i].vs1 = *reinterpret_cast<const bf16x8*>(&vt_[(long)(32 + sr) * LDK + sc]); \
    sr_[i].ks0 = *reinterpret_cast<const bf16x8*>(&kt_[(long)sr * LDK + sc]); sr_[i].ks1 = *reinterpret_cast<const bf16x8*>(&kt_[(long)(32 + sr) * LDK + sc]); } while (0)
#define SWRITE(b, i) do { *(bf16x8*)((char*)V_lds + (b) * SHM_V + vst0) = sr_[i].vs0;          \
    *(bf16x8*)((char*)V_lds + (b) * SHM_V + vst1) = sr_[i].vs1; int kc = sc * 2;               \
    *(bf16x8*)((char*)K_lds + (b) * SHM_K + KSWZ(sr, kc)) = sr_[i].ks0;                       \
    *(bf16x8*)((char*)K_lds + (b) * SHM_K + KSWZ(32 + sr, kc)) = sr_[i].ks1; } while (0)
#define SWAIT() asm volatile("s_waitcnt vmcnt(4)" ::: "memory")
#define RESC(a) do { if (__any((a) < 1.f)) { if (hi == 0) al_l[r32] = (a); asm volatile("s_waitcnt lgkmcnt(0)" ::: "memory"); \
    for (int d = 0; d < 4; ++d) for (int r = 0; r < 16; ++r) o[d][r] *= al_l[crow(r, hi)]; } } while (0)
#define MASK(P0, P1, j) do { if ((j) >= n0) bandmask(P0, P1, dql + 64 * ((j) - n0), hi); } while (0)
  f32x16 pA0, pA1, pB0, pB1; float mnA, mnB, alA, alB; bf16x8 pa0, pa1, pa2, pa3; const int NT = n0 + n1;
  constexpr int SE = 0, SO = 1;
  SLOAD(SE, 0); SLOAD(SO, 1);
  asm volatile("s_waitcnt vmcnt(4)" ::: "memory"); SWRITE(0, SE); __syncthreads();
  qkt(pA0, pA1, K_lds, qr, r32, hi); partialSM(pA0, pA1, m_reg, mnA, alA);
  if (2 < NT) SLOAD(SE, 2);
  SWAIT(); SWRITE(1, SO); __syncthreads();
  for (int j = 1; j + 1 < NT; j += 2) {
    SBAR(); qkt(pB0, pB1, (bf16*)((char*)K_lds + SHM_K), qr, r32, hi); MASK(pB0, pB1, j);
    finishSM(pA0, pA1, alA, l_reg, pa0, pa1, pa2, pa3); SBAR();
    SLOAD(SO, j + 2); SBAR();
    pv_d0(o, vb0, pa0, pa1, pa2, pa3); partialSM(pB0, pB1, m_reg, mnB, alB);
    __syncthreads(); SWAIT(); SWRITE(0, SE);
    RESC(alB); __syncthreads();
    SBAR(); qkt(pA0, pA1, K_lds, qr, r32, hi); MASK(pA0, pA1, j + 1);
    finishSM(pB0, pB1, alB, l_reg, pa0, pa1, pa2, pa3); SBAR();
    if (j + 3 < NT) SLOAD(SE, j + 3); SBAR();
    pv_d0(o, vb0 + (int)SHM_V, pa0, pa1, pa2, pa3); partialSM(pA0, pA1, m_reg, mnA, alA);
    __syncthreads(); SWAIT(); SWRITE(1, SO);
    RESC(alA); __syncthreads();
  }
  SBAR(); qkt(pB0, pB1, (bf16*)((char*)K_lds + SHM_K), qr, r32, hi); MASK(pB0, pB1, NT - 1);
  finishSM(pA0, pA1, alA, l_reg, pa0, pa1, pa2, pa3); SBAR();
  pv_d0(o, vb0, pa0, pa1, pa2, pa3); partialSM(pB0, pB1, m_reg, mnB, alB);
  __syncthreads(); RESC(alB);
  finishSM(pB0, pB1, alB, l_reg, pa0, pa1, pa2, pa3); SBAR();
  pv_d0(o, vb0 + (int)SHM_V, pa0, pa1, pa2, pa3);
  l_reg += __builtin_amdgcn_exp2f(sinkl2 - m_reg * (SCALE * 1.4426950408889634f));
  if (hi == 0) li_l[r32] = l_reg; asm volatile("s_waitcnt lgkmcnt(0)" ::: "memory");
  float rli[16];
#pragma unroll
  for (int r = 0; r < 16; ++r) rli[r] = __builtin_amdgcn_rcpf(li_l[crow(r, hi)]);
  asm volatile("" ::: "memory");
  { char* stg = lds + 69632 + wid * 8192;
#pragma unroll
    for (int r = 0; r < 16; ++r) { const int orow = crow(r, hi);
#pragma unroll
      for (int d0 = 0; d0 < 4; ++d0) { const float v = o[d0][r] * rli[r]; *(bf16*)(stg + orow * 256 + (d0 * 32 + r32) * 2) = (bf16)cvtpk(v, v); } }
    asm volatile("s_waitcnt lgkmcnt(0)" ::: "memory");
    bf16* Ow = Ob + (long)(wid * QBLK) * LDO;
#pragma unroll
    for (int i = 0; i < 8; ++i) { const int row = i * 4 + (lane >> 4), ch = lane & 15; const u32x4 v = *(const u32x4*)(stg + row * 256 + ch * 16); *(u32x4*)(Ow + (long)row * LDO + ch * 8) = v; } }
  __syncthreads();
#undef SLOAD
#undef SWRITE
#undef SWAIT
#undef RESC
#undef MASK
}
#undef KSWZ
#undef SBAR
}

#define LAS __attribute__((address_space(3)))
typedef unsigned short bf16_t;
typedef unsigned v4u __attribute__((ext_vector_type(4)));
typedef float f32x4 __attribute__((ext_vector_type(4)));
typedef float f32x16 __attribute__((ext_vector_type(16)));
typedef short bf16x8 __attribute__((ext_vector_type(8)));
using pg8::bf2f; using pg8::dim_of_pos; using pg8::pos_of_dim;

constexpr int NL = 4, NINW = 5632, DFF = 4096, NMOD6 = 6144;
constexpr int NTOK = 16384, NCTX = 8192;
constexpr size_t MiB = 1u << 20;
constexpr size_t WS_CTL = 0, WS_MOD = 1 * MiB, WS_ROPE = 2 * MiB, WS_WIN = 3 * MiB, WS_WCAT = 47 * MiB, WS_WOUT = 63 * MiB, WS_W1 = 71 * MiB, WS_W2 = 103 * MiB,
                 WS_CK = 135 * MiB, WS_CV = 139 * MiB, WS_H = 143 * MiB, WS_Q = 175 * MiB, WS_KB = 207 * MiB, WS_VB = 215 * MiB, WS_XR = 223 * MiB, WS_G = 255 * MiB,
                 WS_ACAT = 319 * MiB, WS_PF = 383 * MiB, WS_PB = 399 * MiB, WS_SSQ = 415 * MiB, WS_SWIN = 416 * MiB, WS_SWUP = 416 * MiB + 512 * 1024, WS_WMOD = 417 * MiB, WS_X16 = 418 * MiB, WS_WFR = 450 * MiB, WS_END = 454 * MiB, WS_TOT = 512 * 1024, WS_U = WS_Q, WS_MERGED = WS_Q;
constexpr size_t OUT_K = 16777216, OUT_V = 25165824, OUT_S = 33554432;
constexpr int RING_BYTES = 131072, RED_OFF = 131072, MISC_OFF = RED_OFF + 8192, LDS_BYTES = 147456;
constexpr int CW_DONE = 1024;
constexpr int CW_QUEUE = 64;

#define XB_TMO      128
#define XB_XCNT(j)  (256  + 64 * (j))
#define XB_XSUB(j)  (1280 + 64 * (j))
#define XB_XGEN(j)  (2304 + 64 * (j))
#define XB_TOP      3328
#define XB_TOPGEN   3392
#define XCD_BAR_WORDS 3456
#define XB_SPIN_CAP (1u << 18)

__device__ __forceinline__ unsigned xb_ld(unsigned* p)              { return __hip_atomic_load(p, __ATOMIC_RELAXED, __HIP_MEMORY_SCOPE_AGENT); }
__device__ __forceinline__ unsigned xb_add(unsigned* p, unsigned v) { return __hip_atomic_fetch_add(p, v, __ATOMIC_RELAXED, __HIP_MEMORY_SCOPE_AGENT); }
__device__ __forceinline__ unsigned xb_xcc_id() { return (unsigned)__builtin_amdgcn_s_getreg((3 << 11) | 20) & 0xFu; }
#define XB_SPIN(cond, bar) do { unsigned _sp = 0; while (cond) { __builtin_amdgcn_s_sleep(1); \
    if ((++_sp & 255u) == 0u) { if (xb_ld(&(bar)[XB_TMO])) break; if (_sp > XB_SPIN_CAP) { atomicAdd(&(bar)[XB_TMO], 1u); break; } } } } while (0)

struct XcdBarrier {
    unsigned* bar; unsigned x;
    volatile LAS unsigned* st;
};

__device__ __forceinline__ XcdBarrier xcd_barrier_post(unsigned* bar, volatile LAS unsigned* st) {
    XcdBarrier b; b.bar = bar; b.x = xb_xcc_id(); b.st = st;
    if (threadIdx.x == 0) (void)xb_add(&bar[XB_XCNT(b.x)], 1u);
    return b;
}
__device__ __forceinline__ void xcd_barrier_complete(unsigned* bar, unsigned x, unsigned& nloc, unsigned& nx) {
    const unsigned G = gridDim.x * gridDim.y * gridDim.z;
    unsigned sum, cnt, mine, sp = 0u;
    for (;;) {
        sum = 0u; cnt = 0u; mine = 0u;
#pragma unroll
        for (unsigned j = 0; j < 16; ++j) { const unsigned c = xb_ld(&bar[XB_XCNT(j)]); sum += c; cnt += (c > 0u) ? 1u : 0u; mine = (j == x) ? c : mine; }
        if (sum == G) break;
        __builtin_amdgcn_s_sleep(1);
        if ((++sp & 255u) == 0u) { if (xb_ld(&bar[XB_TMO])) break; if (sp > XB_SPIN_CAP) { atomicAdd(&bar[XB_TMO], 1u); break; } }
    }
    nloc = mine > 0u ? mine : 1u; nx = cnt > 0u ? cnt : 1u;
}

__device__ __forceinline__ void xcd_barrier(const XcdBarrier& b) {
    asm volatile("s_waitcnt vmcnt(0)" ::: "memory");
    __syncthreads();
    if (threadIdx.x == 0) {
        unsigned* bar = b.bar;
        __builtin_amdgcn_s_waitcnt(0);
        unsigned nloc = b.st[0], nx = b.st[1];
        if (nloc == 0u) { xcd_barrier_complete(bar, b.x, nloc, nx); b.st[0] = nloc; b.st[1] = nx; }
        const unsigned old = xb_add(&bar[XB_XSUB(b.x)], 1u);
        const unsigned gen = old / nloc;
        if (old + 1u == (gen + 1u) * nloc) {
            __builtin_amdgcn_fence(__ATOMIC_RELEASE, "agent");
            asm volatile("s_waitcnt vmcnt(0)" ::: "memory");
            const unsigned og = xb_add(&bar[XB_TOP], 1u);
            const unsigned tg = og / nx;
            if (og + 1u == (tg + 1u) * nx) xb_add(&bar[XB_TOPGEN], 1u);
            else XB_SPIN(xb_ld(&bar[XB_TOPGEN]) == tg, bar);
            __builtin_amdgcn_fence(__ATOMIC_ACQUIRE, "agent");
            xb_add(&bar[XB_XGEN(b.x)], 1u);
            asm volatile("s_waitcnt vmcnt(0)" ::: "memory");
        } else {
            XB_SPIN(xb_ld(&bar[XB_XGEN(b.x)]) == gen, bar);
            __builtin_amdgcn_fence(__ATOMIC_ACQUIRE, "agent");
            asm volatile("s_waitcnt vmcnt(0)" ::: "memory");
        }
    }
    __syncthreads();
}

constexpr int CW_BAR = 4096;

__device__ __forceinline__ int opaque_bid() { int b = blockIdx.x; asm volatile("" : "+s"(b)); return b; }
#ifndef XREP_MIX
#define XREP_MIX 1
#endif
struct OneUnit { int pm, pn;
    __device__ __forceinline__ bool next(int i, pg8::Unit& u) const { if (i != 0) return false; u.pm = pm; u.pn = pn; return true; }
    __device__ __forceinline__ void a_ready(const pg8::Unit&) const {}
    __device__ __forceinline__ void done(const pg8::Unit&) const {} };
struct Params { const float* in[27]; float* out; unsigned char* ws; int ph_lo, ph_hi; };

__device__ __forceinline__ unsigned f2bf(float f) { unsigned u = __builtin_bit_cast(unsigned, f); return (u + 0x7fffu + ((u >> 16) & 1u)) >> 16; }
__device__ __forceinline__ unsigned pk2(float lo, float hi) { return att::cvtpk(lo, hi); }
__device__ __forceinline__ unsigned short f2bfh(float x) { return (unsigned short)att::cvtpk(x, x); }
__device__ __forceinline__ float wave_sum(float v) {
#pragma unroll
    for (int o = 1; o < 64; o <<= 1) v += __shfl_xor(v, o);
    return v;
}

template <bool PERMQK>
__device__ __forceinline__ void tr_item(const float* W, int K, int N, bf16_t* WT, int ldk, int koff, LAS float* scr, int item, int lane) {
    const int nblk = N / 32, kb = item / nblk, nb = item % nblk, k0 = 64 * kb, n0 = 32 * nb;
    float tv[32];
#pragma unroll
    for (int i = 0; i < 32; ++i) { const int kk = 2 * i + (lane >> 5); tv[i] = __builtin_nontemporal_load(&W[(size_t)(k0 + kk) * N + n0 + (lane & 31)]); }
#pragma unroll
    for (int i = 0; i < 32; ++i) { const int kk = 2 * i + (lane >> 5); scr[kk * 33 + (lane & 31)] = tv[i]; }
    asm volatile("s_waitcnt lgkmcnt(0)" ::: "memory");
    const int c = lane & 7;
#pragma unroll
    for (int j = 0; j < 4; ++j) { const int n = (lane >> 3) + 8 * j; const LAS float* s = scr + (8 * c) * 33 + n;
        v4u o; o.x = pk2(s[0 * 33], s[1 * 33]); o.y = pk2(s[2 * 33], s[3 * 33]); o.z = pk2(s[4 * 33], s[5 * 33]); o.w = pk2(s[6 * 33], s[7 * 33]);
        int nn = n0 + n; if (PERMQK && nn < 1280) nn = (nn & ~127) | pos_of_dim(nn & 127);
        *(v4u*)(WT + (size_t)nn * ldk + koff + k0 + 8 * c) = o; }
    asm volatile("s_waitcnt lgkmcnt(0)" ::: "memory");
}

__device__ __forceinline__ void norm_row(const float* xrow, const float* nw, const float* sh, const float* sc, bf16_t* orow, int lane) {
    const f32x4* xr = (const f32x4*)xrow + lane;
    f32x4 v[4]; float s = 0.f;
#pragma unroll
    for (int j = 0; j < 4; ++j) { v[j] = xr[64 * j]; s += (v[j][0] * v[j][0] + v[j][1] * v[j][1]) + (v[j][2] * v[j][2] + v[j][3] * v[j][3]); }
    const float rstd = __builtin_amdgcn_rsqf(wave_sum(s) * (1.f / 1024.f) + 1e-6f);
    unsigned long long* o8 = (unsigned long long*)orow + lane;
#pragma unroll
    for (int j = 0; j < 4; ++j) { const f32x4 w = ((const f32x4*)nw)[lane + 64 * j], a = ((const f32x4*)sc)[lane + 64 * j], b = ((const f32x4*)sh)[lane + 64 * j];
        const f32x4 y = v[j] * rstd * w * (1.0f + a) + b;
        o8[64 * j] = (unsigned long long)pk2(y[0], y[1]) | ((unsigned long long)pk2(y[2], y[3]) << 32); }
}
__device__ __forceinline__ void norm_phase(const Params& P, int layer, int which  , bool first) {
    int tid_l = threadIdx.x; asm volatile("" : "+v"(tid_l));
    const int lane = tid_l & 63, wave = tid_l >> 6, gw = blockIdx.x * 8 + wave, NGW = gridDim.x * 8;
    const float* mod = (const float*)(P.ws + WS_MOD) + (size_t)layer * 5 * NMOD6 + which * 3072;
    const float* nw = P.in[which ? 10 : 9] + layer * 1024;
#define RS_RESET() do { __syncthreads(); if (threadIdx.x == 0) ((LAS int*)(lds + RED_OFF))[2048 + 64 + 256] = -1; __syncthreads(); } while (0)
    bf16_t* H = (bf16_t*)(P.ws + WS_H);
    for (int row = gw; row < NTOK; row += NGW) {
        const int cond = row < NCTX ? 0 : 1 + ((row - NCTX) >> 11);
        const float* x = first ? (row < NCTX ? P.in[0] + (size_t)row * 1024 : P.in[1] + (size_t)(row - NCTX) * 1024) : P.out + (size_t)row * 1024;
        norm_row(x, nw, mod + cond * NMOD6, mod + cond * NMOD6 + 1024, H + (size_t)row * 1024, lane);
    }
}

__device__ __forceinline__ void prep_phase(const Params& P, LAS unsigned char* lds) {
    int tid_l = threadIdx.x; asm volatile("" : "+v"(tid_l));
    const int tid = tid_l, lane = tid & 63, wave = tid >> 6, G = gridDim.x, gw = blockIdx.x * 8 + wave, NGW = G * 8;
    const float* MOD = (const float*)(P.ws + WS_MOD);
    for (int i = blockIdx.x * 512 + tid; i < NL * 2 * 5 * 1024; i += G * 512) {
        const int c = i & 1023, cond = (i >> 10) % 5, w = ((i >> 10) / 5) & 1, l = (i >> 10) / 10;
        ((float*)(P.ws + WS_WMOD))[i] = P.in[w ? 10 : 9][l * 1024 + c] * (1.0f + MOD[(size_t)(l * 5 + cond) * NMOD6 + (w ? 4 : 1) * 1024 + c]);
    }
    {
        const int r32 = lane & 31, hi = lane >> 5;
        constexpr int T_IN = NINW / 32, T_UP = DFF / 32, T_L = T_IN + T_UP;
        for (int tix = gw; tix < NL * T_L; tix += NGW) {
            const int l = tix / T_L, r = tix % T_L, w = r >= T_IN, n0 = 32 * (w ? r - T_IN : r), N = w ? DFF : NINW;
            const bf16_t* Wt = (w ? (const bf16_t*)(P.ws + WS_W1) + (size_t)l * DFF * 1024 : (const bf16_t*)(P.ws + WS_WIN) + (size_t)l * NINW * 1024) + (size_t)(n0 + r32) * 1024 + 8 * hi;
            const float* shp = MOD + (size_t)(l * 5 + (r32 < 5 ? r32 : 0)) * NMOD6 + (w ? 3 : 0) * 1024 + 8 * hi;
            f32x16 acc = {};
#pragma unroll 8
            for (int ks = 0; ks < 64; ++ks) {
                const bf16x8 bfr = *(const bf16x8*)(Wt + 16 * ks);
                bf16x8 afr = {0, 0, 0, 0, 0, 0, 0, 0};
                if (r32 < 5) { const f32x4 s0 = *(const f32x4*)(shp + 16 * ks), s1 = *(const f32x4*)(shp + 16 * ks + 4);
                    v4u t; t.x = pk2(s0[0], s0[1]); t.y = pk2(s0[2], s0[3]); t.z = pk2(s1[0], s1[1]); t.w = pk2(s1[2], s1[3]); afr = __builtin_bit_cast(bf16x8, t); }
                acc = __builtin_amdgcn_mfma_f32_32x32x16_bf16(afr, bfr, acc, 0, 0, 0);
            }
            float* SW = w ? (float*)(P.ws + WS_SWUP) + (size_t)l * 5 * DFF : (float*)(P.ws + WS_SWIN) + (size_t)l * 5 * NINW;
            if (hi == 0) { SW[(size_t)0 * N + n0 + r32] = acc[0]; SW[(size_t)1 * N + n0 + r32] = acc[1]; SW[(size_t)2 * N + n0 + r32] = acc[2]; SW[(size_t)3 * N + n0 + r32] = acc[3]; }
            else SW[(size_t)4 * N + n0 + r32] = acc[0];
        }
    }
    bf16_t* H = (bf16_t*)(P.ws + WS_H); float* SSQ = (float*)(P.ws + WS_SSQ);
    for (int row = gw; row < NTOK; row += NGW) {
        const int cond = row < NCTX ? 0 : 1 + ((row - NCTX) >> 11);
        const float* x = row < NCTX ? P.in[0] + (size_t)row * 1024 : P.in[1] + (size_t)(row - NCTX) * 1024;
        const f32x4* xr = (const f32x4*)x + lane; const f32x4* nw = (const f32x4*)P.in[9] + lane; const f32x4* sc = (const f32x4*)(MOD + (size_t)cond * NMOD6 + 1024) + lane;
        unsigned long long* o8 = (unsigned long long*)(H + (size_t)row * 1024) + lane;
        float s = 0.f;
#pragma unroll
        for (int j = 0; j < 4; ++j) { const f32x4 v = xr[64 * j]; s += (v[0] * v[0] + v[1] * v[1]) + (v[2] * v[2] + v[3] * v[3]);
            const f32x4 y = v * nw[64 * j] * (1.0f + sc[64 * j]);
            o8[64 * j] = (unsigned long long)pk2(y[0], y[1]) | ((unsigned long long)pk2(y[2], y[3]) << 32); }
        s = wave_sum(s);
        if (lane < 16) SSQ[(size_t)row * 16 + lane] = lane == 0 ? s : 0.f;
    }
}

__device__ __forceinline__ void prologue(const Params& P, LAS unsigned char* lds) {
    int tid_l = threadIdx.x; asm volatile("" : "+v"(tid_l));
    const int tid = tid_l, lane = tid & 63, wave = tid >> 6, G = gridDim.x;
    const int gw = blockIdx.x * 8 + wave, NGW = G * 8;
    LAS float* scr = (LAS float*)(lds + wave * 16384);
    constexpr int I_IN = 16 * 176, I_O = 16 * 32, I_1 = 16 * 128, I_2 = 64 * 32, I_L = I_IN + 3 * I_O + I_1 + I_2;
    for (int it = gw; it < NL * I_L; it += NGW) {
        const int l = it / I_L; int r = it % I_L;
        if (r < I_IN) { tr_item<true>(P.in[11] + (size_t)l * 1024 * NINW, 1024, NINW, (bf16_t*)(P.ws + WS_WIN) + (size_t)l * NINW * 1024, 1024, 0, scr, r, lane); continue; } r -= I_IN;
        if (r < I_O) { tr_item<false>(P.in[22] + (size_t)l * 1024 * 1024, 1024, 1024, (bf16_t*)(P.ws + WS_WCAT) + (size_t)l * 1024 * 2048, 2048, 0, scr, r, lane); continue; } r -= I_O;
        if (r < I_O) { tr_item<false>(P.in[23] + (size_t)l * 1024 * 1024, 1024, 1024, (bf16_t*)(P.ws + WS_WCAT) + (size_t)l * 1024 * 2048, 2048, 1024, scr, r, lane); continue; } r -= I_O;
        if (r < I_O) { tr_item<false>(P.in[24] + (size_t)l * 1024 * 1024, 1024, 1024, (bf16_t*)(P.ws + WS_WOUT) + (size_t)l * 1024 * 1024, 1024, 0, scr, r, lane); continue; } r -= I_O;
        if (r < I_1) { tr_item<false>(P.in[25] + (size_t)l * 1024 * DFF, 1024, DFF, (bf16_t*)(P.ws + WS_W1) + (size_t)l * DFF * 1024, 1024, 0, scr, r, lane); continue; } r -= I_1;
        tr_item<false>(P.in[26] + (size_t)l * DFF * 1024, DFF, 1024, (bf16_t*)(P.ws + WS_W2) + (size_t)l * 1024 * DFF, DFF, 0, scr, r, lane);
    }
    __syncthreads();
    {
        LAS float* sv = (LAS float*)lds; LAS float* rb = (LAS float*)(lds + 20480);
        for (int i = tid; i < 5120; i += 512) { const int cond = i >> 10, k = i & 1023; const float x = cond == 0 ? P.in[6][k] : P.in[5][(cond - 1) * 1024 + k]; sv[i] = x * __builtin_amdgcn_rcpf(1.0f + __expf(-x)); }
        __syncthreads();
        for (int it = blockIdx.x; it < NL * 96; it += G) {
            const int l = it / 96, cg_ = it % 96, rg = lane >> 4, c4 = (lane & 15) * 4;
            const float* W = P.in[7] + ((size_t)l * 1024 + wave * 128 + rg) * NMOD6 + cg_ * 64 + c4;
            f32x4 a0 = {0.f, 0.f, 0.f, 0.f}, a1 = a0, a2 = a0, a3 = a0, a4 = a0;
#pragma unroll 8
            for (int k = 0; k < 32; ++k) { const f32x4 w = __builtin_nontemporal_load((const f32x4*)(W + (size_t)(4 * k) * NMOD6)); const int kk = wave * 128 + rg + 4 * k;
                a0 += sv[kk] * w; a1 += sv[1024 + kk] * w; a2 += sv[2048 + kk] * w; a3 += sv[3072 + kk] * w; a4 += sv[4096 + kk] * w; }
#pragma unroll
            for (int e = 0; e < 4; ++e) {
                a0[e] += __shfl_xor(a0[e], 16); a0[e] += __shfl_xor(a0[e], 32); a1[e] += __shfl_xor(a1[e], 16); a1[e] += __shfl_xor(a1[e], 32);
                a2[e] += __shfl_xor(a2[e], 16); a2[e] += __shfl_xor(a2[e], 32); a3[e] += __shfl_xor(a3[e], 16); a3[e] += __shfl_xor(a3[e], 32);
                a4[e] += __shfl_xor(a4[e], 16); a4[e] += __shfl_xor(a4[e], 32); }
            if (rg == 0) { *(LAS f32x4*)(rb + (wave * 5 + 0) * 64 + c4) = a0; *(LAS f32x4*)(rb + (wave * 5 + 1) * 64 + c4) = a1; *(LAS f32x4*)(rb + (wave * 5 + 2) * 64 + c4) = a2;
                           *(LAS f32x4*)(rb + (wave * 5 + 3) * 64 + c4) = a3; *(LAS f32x4*)(rb + (wave * 5 + 4) * 64 + c4) = a4; }
            __syncthreads();
            if (tid < 320) { const int cond = tid >> 6; float s = 0.f;
#pragma unroll
                for (int w = 0; w < 8; ++w) s += rb[(w * 5 + cond) * 64 + lane];
                s += P.in[8][l * NMOD6 + cg_ * 64 + lane];
                ((float*)(P.ws + WS_MOD))[(size_t)(l * 5 + cond) * NMOD6 + cg_ * 64 + lane] = s; }
            __syncthreads();
        }
    }
    const int gt = blockIdx.x * 512 + tid, NGT = G * 512;
#ifdef NANFILL
    { v4u nanv = {0x7FC07FC0u, 0x7FC07FC0u, 0x7FC07FC0u, 0x7FC07FC0u};
      v4u* a = (v4u*)(P.ws + WS_H); const size_t na = (WS_END - WS_H) / 16;
      for (size_t i = gt; i < na; i += NGT) a[i] = nanv;
      v4u* o = (v4u*)P.out; const size_t no = (size_t)(33554432 + 262144) / 4;
      for (size_t i = gt; i < no; i += NGT) o[i] = nanv; }
#endif
    for (int i = gt; i < 4 * 4 * 512 * 256 / 2; i += NGT) {
        const int e = 2 * i, p = e & 127, base = e & ~127;
        const float* ck = P.in[2] + base;
        ((unsigned*)(P.ws + WS_CK))[i] = pk2(ck[dim_of_pos(p)], ck[dim_of_pos(p + 1)]);
        ((unsigned*)(P.ws + WS_CV))[i] = pk2(P.in[3][e], P.in[3][e + 1]);
    }
    for (int i = gt; i < NL * 2 * 8 * 2 * 4 * 8 * 64; i += NGT) {
        const int ln = i & 63, ks = (i >> 6) & 7, w4 = (i >> 9) & 3, gate = (i >> 11) & 1, nb = (i >> 12) & 7, dr = (i >> 15) & 1, l = i >> 16;
        const float* W = (gate ? P.in[20] : P.in[18]) + ((size_t)((l * 2 + dr) * 8 + nb) * 128) * 128 + w4 * 32 + (ln & 31);
        float v[8];
#pragma unroll
        for (int j = 0; j < 8; ++j) v[j] = W[(16 * ks + 8 * (ln >> 5) + j) * 128];
        v4u o; o.x = pk2(v[0], v[1]); o.y = pk2(v[2], v[3]); o.z = pk2(v[4], v[5]); o.w = pk2(v[6], v[7]);
        ((v4u*)(P.ws + WS_WFR))[i] = o;
    }
    for (int i = gt; i < 2048 * 64; i += NGT) {
        const int t = i >> 6, pi = i & 63, ax = pi >> 5, fi = pi & 31;
        const float freq = powf(10000.0f, -(float)(2 * fi) / 64.0f);
        const float ang = (float)(ax == 0 ? (t >> 6) : (t & 63)) * freq;
        float* o = (float*)(P.ws + WS_ROPE) + (size_t)i * 2; o[0] = cosf(ang); o[1] = sinf(ang);
    }
}

__device__ __forceinline__ int crow16(int r, int hi) { return (r & 3) + 8 * (r >> 2) + 4 * hi; }
__device__ __forceinline__ float partner32(float x, int hi) { auto rr = __builtin_amdgcn_permlane32_swap(__float_as_uint(x), __float_as_uint(x), false, false); return __uint_as_float(hi ? rr[0] : rr[1]); }
__device__ __forceinline__ void lru_unit(const Params& P, int layer, int latent, int b, int seg, int nblk, LAS unsigned char* lds) {
    int tid_l = threadIdx.x; asm volatile("" : "+v"(tid_l));
    const int tid = tid_l, lane = tid & 63, r32 = lane & 31, hi = lane >> 5;
    const int wid = __builtin_amdgcn_readfirstlane(tid >> 6), dir = wid >> 2, w4 = wid & 3, gt = tid & 255;
    constexpr int nch = 8;
    const int Tseq = latent ? 2048 : 256, t0seg = seg * 256;
    const int rowseq = latent ? NCTX + b * 2048 : b * 256, rowbase = rowseq + t0seg;
    const int chl = w4 * 32 + r32, ch = nblk * 128 + chl;
    constexpr int TILEB = 32 * 272;
    LAS unsigned char* tiles = lds;
    LAS float* cw = (LAS float*)(lds + 8 * TILEB);
    const bf16_t* XR = (const bf16_t*)(P.ws + WS_XR);
    bf16_t* HT = ((bf16_t*)P.out + (size_t)16777216);
    bf16_t* ACAT = (bf16_t*)(P.ws + WS_ACAT);
    bf16_t* PD = (bf16_t*)(P.ws + (dir ? WS_PB : WS_PF));
    for (int i = tid; i < 640; i += 512) cw[i] = (i < 512) ? P.in[15][((size_t)layer * 4 + (i >> 7)) * 1024 + nblk * 128 + (i & 127)] : P.in[16][layer * 1024 + nblk * 128 + (i & 127)];
    bf16x8 bR[8], bI0;
    LAS unsigned char* wib = lds + 72704 + wid * 7168 + lane * 16;
    {
        const v4u* fr = (const v4u*)(P.ws + WS_WFR) + ((size_t)(((layer * 2 + dir) * 8 + nblk) * 2) * 4 + w4) * 512 + lane;
#pragma unroll
        for (int ks = 0; ks < 8; ++ks) { const v4u a = fr[ks * 64], g = fr[2048 + ks * 64];
            bR[ks] = __builtin_bit_cast(bf16x8, a); if (ks == 0) bI0 = __builtin_bit_cast(bf16x8, g); else *(LAS v4u*)(wib + (ks - 1) * 1024) = g; }
    }
    const float ba = P.in[19][(layer * 2 + dir) * 1024 + ch], bi = P.in[21][(layer * 2 + dir) * 1024 + ch];
    const float lam = P.in[17][(layer * 2 + dir) * 1024 + ch];
    const float clam = -8.0f * 1.4426950408889634f * log1pf(__expf(-lam));
    float h = 0.f, p = 1.f;
    const int st = 2 * (gt >> 4), c8 = (gt & 15) * 8;
    const int strow = 8 * ((st & 15) >> 2) + 4 * (st >> 4) + (st & 3);
    v4u pre[5];
#define LRU_LOAD(ck_) do { const int ck__ = (ck_); _Pragma("unroll") for (int i = 0; i < 5; ++i) { \
        const int tt = t0seg + ck__ * 32 + st + i - 2; \
        pre[i] = (tt >= 0 && tt < Tseq) ? *(const v4u*)(XR + (size_t)(rowseq + tt) * 1024 + nblk * 128 + c8) : (v4u){0u, 0u, 0u, 0u}; } } while (0)
#define LRU_CONV(buf_) do { float y0[8], y1[8]; { const f32x4 b0 = *(const LAS f32x4*)(cw + 512 + c8), b1 = *(const LAS f32x4*)(cw + 512 + c8 + 4); \
            _Pragma("unroll") for (int j = 0; j < 4; ++j) { y0[j] = b0[j]; y0[4 + j] = b1[j]; y1[j] = b0[j]; y1[4 + j] = b1[j]; } } \
        _Pragma("unroll") for (int k = 0; k < 4; ++k) { const f32x4 w0 = *(const LAS f32x4*)(cw + k * 128 + c8), w1 = *(const LAS f32x4*)(cw + k * 128 + c8 + 4); \
            const v4u xa = pre[k], xb = pre[k + 1]; \
            _Pragma("unroll") for (int q = 0; q < 4; ++q) { const float wlo = q < 2 ? w0[2 * q] : w1[2 * q - 4], whi = q < 2 ? w0[2 * q + 1] : w1[2 * q - 3]; \
                y0[2 * q] += wlo * __uint_as_float(xa[q] << 16); y0[2 * q + 1] += whi * __uint_as_float(xa[q] & 0xffff0000u); \
                y1[2 * q] += wlo * __uint_as_float(xb[q] << 16); y1[2 * q + 1] += whi * __uint_as_float(xb[q] & 0xffff0000u); } } \
        v4u o; o.x = pk2(y0[0], y0[1]); o.y = pk2(y0[2], y0[3]); o.z = pk2(y0[4], y0[5]); o.w = pk2(y0[6], y0[7]); \
        *(LAS v4u*)(tiles + (buf_) * TILEB + strow * 272 + c8 * 2) = o; \
        o.x = pk2(y1[0], y1[1]); o.y = pk2(y1[2], y1[3]); o.z = pk2(y1[4], y1[5]); o.w = pk2(y1[6], y1[7]); \
        *(LAS v4u*)(tiles + (buf_) * TILEB + (strow + 1) * 272 + c8 * 2) = o; } while (0)
    LRU_LOAD(dir ? nch - 1 : 0);
    __syncthreads();
    LRU_CONV(dir ? nch - 1 : 0);
    __syncthreads();
    for (int k = 0; k < nch; ++k) {
        const int ck = dir ? nch - 1 - k : k;
        const LAS unsigned char* tile = tiles + ck * TILEB;
        f32x16 aR = {}, aI = {};
#pragma unroll
        for (int ks = 0; ks < 8; ++ks) { const bf16x8 af = *(const LAS bf16x8*)(tile + r32 * 272 + (16 * ks + 8 * hi) * 2);
            aR = __builtin_amdgcn_mfma_f32_32x32x16_bf16(af, bR[ks], aR, 0, 0, 0);
            aI = __builtin_amdgcn_mfma_f32_32x32x16_bf16(af, ks == 0 ? bI0 : *(const LAS bf16x8*)(wib + (ks - 1) * 1024), aI, 0, 0, 0); }
        float av[16], bv[16];
#pragma unroll
        for (int r = 0; r < 16; ++r) { const int t = crow16(r, hi);
            const float x = bf2f(*(const LAS unsigned short*)(tile + t * 272 + chl * 2));
            const float eu = 1.0f + __builtin_amdgcn_exp2f(-1.4426950408889634f * (aR[r] + ba)), ev = 1.0f + __builtin_amdgcn_exp2f(-1.4426950408889634f * (aI[r] + bi));
            const float inv = __builtin_amdgcn_rcpf(eu * ev);
            const float rr = ev * inv, ii = eu * inv;
            const float a = __builtin_amdgcn_exp2f(clam * rr);
            av[r] = a; bv[r] = __builtin_amdgcn_sqrtf(fmaxf(fmaf(-a, a, 1.0f), 0.f)) * (ii * x); }
        if (k < 3) LRU_LOAD(dir ? nch - 2 - k : k + 1);
        if (dir == 0) {
#pragma unroll
            for (int r = 1; r < 16; ++r) { bv[r] = fmaf(av[r], bv[r - 1], bv[r]); av[r] *= av[r - 1]; }
            const float ho = fmaf(av[15], h, bv[15]), po = av[15] * p;
            const float nh = partner32(ho, hi), np = partner32(po, hi);
            const float hin = hi ? nh : h, pin = hi ? np : p;
#pragma unroll
            for (int r = 0; r < 16; ++r) { bv[r] = fmaf(av[r], hin, bv[r]); av[r] *= pin; }
            const float eh = partner32(bv[15], hi), ep = partner32(av[15], hi);
            h = hi ? bv[15] : eh; p = hi ? av[15] : ep;
        } else {
#pragma unroll
            for (int r = 14; r >= 0; --r) { bv[r] = fmaf(av[r], bv[r + 1], bv[r]); av[r] *= av[r + 1]; }
            const float ho = fmaf(av[0], h, bv[0]), po = av[0] * p;
            const float nh = partner32(ho, hi), np = partner32(po, hi);
            const float hin = hi ? h : nh, pin = hi ? p : np;
#pragma unroll
            for (int r = 0; r < 16; ++r) { bv[r] = fmaf(av[r], hin, bv[r]); av[r] *= pin; }
            const float eh = partner32(bv[0], hi), ep = partner32(av[0], hi);
            h = hi ? eh : bv[0]; p = hi ? ep : av[0];
        }
        {
            char* hb_ = dir ? (char*)ACAT + (size_t)(rowbase + ck * 32) * 4096 + 2048 : (char*)HT + (size_t)(rowbase + ck * 32) * 2048;
            const unsigned rs_ = dir ? 4096u : 2048u;
            const unsigned lo1 = (unsigned)(16 * hi) * rs_ + (unsigned)(ch * 2);
#pragma unroll
            for (int r = 0; r < 16; ++r) *(bf16_t*)(hb_ + (lo1 + (unsigned)r * rs_)) = f2bfh(bv[r]);
            if (latent) {
                char* pdb = (char*)PD + (size_t)(rowbase - NCTX + ck * 32) * 2048;
                const unsigned lo2 = (unsigned)((16 * hi) * 2048 + ch * 2);
#pragma unroll
                for (int r = 0; r < 16; ++r) *(bf16_t*)(pdb + (lo2 + (unsigned)(r * 2048))) = f2bfh(av[r]);
            }
        }
        if (k < 3) LRU_CONV(dir ? nch - 2 - k : k + 1);
        asm volatile("s_waitcnt lgkmcnt(0)\n\ts_barrier" ::: "memory");
    }
    if (hi == 0) {
        if (latent) { float* tot = (float*)(P.ws + WS_TOT) + ((size_t)(((b * 8 + nblk) * 8 + seg) * 2 + dir) * 2) * 128 + chl; tot[0] = p; tot[128] = h; }
        else P.out[OUT_S + ((size_t)(b * 4 + layer) * 2 + dir) * 1024 + ch] = h;
    }
    asm volatile("s_waitcnt vmcnt(0)" ::: "memory"); __syncthreads();
    if (!latent) {
        const bf16_t* GXB = ((const bf16_t*)P.out);
#pragma unroll
        for (int hb4 = 0; hb4 < 2; ++hb4) {
            v4u hf[4], hb[4], gx[4];
#pragma unroll
            for (int i = 0; i < 4; ++i) { const int it = tid + (hb4 * 4 + i) * 512; const size_t row = (size_t)rowbase + (it >> 4); const int col = nblk * 128 + (it & 15) * 8;
                hf[i] = *(const v4u*)(HT + row * 1024 + col); hb[i] = *(const v4u*)(ACAT + row * 2048 + 1024 + col); gx[i] = *(const v4u*)(GXB + row * 1024 + col); }
#pragma unroll
            for (int i = 0; i < 4; ++i) { const int it = tid + (hb4 * 4 + i) * 512; const size_t row = (size_t)rowbase + (it >> 4); const int col = nblk * 128 + (it & 15) * 8;
                v4u o;
#pragma unroll
                for (int q = 0; q < 4; ++q) {
                    const float ylo = (__uint_as_float(hf[i][q] << 16) + __uint_as_float(hb[i][q] << 16)) * __uint_as_float(gx[i][q] << 16);
                    const float yhi = (__uint_as_float(hf[i][q] & 0xffff0000u) + __uint_as_float(hb[i][q] & 0xffff0000u)) * __uint_as_float(gx[i][q] & 0xffff0000u);
                    o[q] = pk2(ylo, yhi); }
                *(v4u*)(ACAT + row * 2048 + 1024 + col) = o; }
        }
    }
    if (latent) {
        if (tid == 0) { __builtin_amdgcn_fence(__ATOMIC_RELEASE, "agent"); asm volatile("s_waitcnt vmcnt(0)" ::: "memory");
            __hip_atomic_fetch_add((unsigned*)(P.ws + WS_CTL) + CW_DONE + ((layer * 4 + b) * 8 + nblk) * 16, 1u, __ATOMIC_RELAXED, __HIP_MEMORY_SCOPE_AGENT); }
    }
#undef LRU_LOAD
#undef LRU_CONV
}

__device__ __forceinline__ void lru_fix_unit(const Params& P, int layer, int u, LAS unsigned char* lds) {
    int tid_l = threadIdx.x; asm volatile("" : "+v"(tid_l));
    const int tid = tid_l;
    LAS float* carr = (LAS float*)lds;
    const bf16_t* HT = ((const bf16_t*)P.out + (size_t)16777216); const bf16_t* PF = (const bf16_t*)(P.ws + WS_PF); const bf16_t* PB = (const bf16_t*)(P.ws + WS_PB);
    bf16_t* ACAT = (bf16_t*)(P.ws + WS_ACAT);
    {
        const int b = u >> 6, n = (u >> 3) & 7, seg = u & 7;
        if (tid == 0) {
            unsigned* dn = (unsigned*)(P.ws + WS_CTL) + CW_DONE + ((layer * 4 + b) * 8 + n) * 16; unsigned spins = 0;
            while (__hip_atomic_load(dn, __ATOMIC_RELAXED, __HIP_MEMORY_SCOPE_AGENT) < 8u && ++spins < (1u << 22)) __builtin_amdgcn_s_sleep(4);
            __builtin_amdgcn_fence(__ATOMIC_ACQUIRE, "agent"); asm volatile("s_waitcnt vmcnt(0)" ::: "memory");
        }
        __syncthreads();
        if (tid < 256) {
            const int dir = tid >> 7, c = tid & 127;
            float cy = P.in[4][((size_t)(b * 4 + layer) * 2 + dir) * 1024 + n * 128 + c];
            const float* tot = (const float*)(P.ws + WS_TOT) + ((size_t)((b * 8 + n) * 8) * 2 + dir) * 2 * 128 + c;
            float tp[8], th[8];
#pragma unroll
            for (int j = 0; j < 8; ++j) { tp[j] = tot[j * 512]; th[j] = tot[j * 512 + 128]; }
            if (dir == 0) {
#pragma unroll
                for (int j = 0; j < 7; ++j) if (j < seg) cy = fmaf(tp[j], cy, th[j]);
            } else {
#pragma unroll
                for (int j = 7; j > 0; --j) if (j > seg) cy = fmaf(tp[j], cy, th[j]);
            }
            carr[tid] = cy;
        }
        __syncthreads();
        const size_t row0 = (size_t)NCTX + b * 2048 + seg * 256;
#pragma unroll
        for (int hb4 = 0; hb4 < 2; ++hb4) {
            v4u s[4], s2[4], pf[4], pb[4], gx[4];
#pragma unroll
            for (int i = 0; i < 4; ++i) { const int it = tid + (hb4 * 4 + i) * 512; const size_t row = row0 + (it >> 4); const int col = n * 128 + (it & 15) * 8;
                s[i] = *(const v4u*)(HT + row * 1024 + col); s2[i] = *(const v4u*)(ACAT + row * 2048 + 1024 + col);
                pf[i] = *(const v4u*)(PF + (row - NCTX) * 1024 + col); pb[i] = *(const v4u*)(PB + (row - NCTX) * 1024 + col);
                gx[i] = *(const v4u*)((const bf16_t*)P.out + row * 1024 + col); }
#pragma unroll
            for (int i = 0; i < 4; ++i) { const int it = tid + (hb4 * 4 + i) * 512; const size_t row = row0 + (it >> 4); const int c8 = (it & 15) * 8, col = n * 128 + c8;
                const f32x4 cf0 = *(const LAS f32x4*)(carr + c8), cf1 = *(const LAS f32x4*)(carr + c8 + 4), cb0 = *(const LAS f32x4*)(carr + 128 + c8), cb1 = *(const LAS f32x4*)(carr + 128 + c8 + 4);
                v4u o;
#pragma unroll
                for (int q = 0; q < 4; ++q) { const float cfl = q < 2 ? cf0[2 * q] : cf1[2 * q - 4], cfh = q < 2 ? cf0[2 * q + 1] : cf1[2 * q - 3], cbl = q < 2 ? cb0[2 * q] : cb1[2 * q - 4], cbh = q < 2 ? cb0[2 * q + 1] : cb1[2 * q - 3];
                    const float ylo = (__uint_as_float(s[i][q] << 16) + __uint_as_float(s2[i][q] << 16) + __uint_as_float(pf[i][q] << 16) * cfl + __uint_as_float(pb[i][q] << 16) * cbl) * __uint_as_float(gx[i][q] << 16);
                    const float yhi = (__uint_as_float(s[i][q] & 0xffff0000u) + __uint_as_float(s2[i][q] & 0xffff0000u) + __uint_as_float(pf[i][q] & 0xffff0000u) * cfh + __uint_as_float(pb[i][q] & 0xffff0000u) * cbh) * __uint_as_float(gx[i][q] & 0xffff0000u);
                    o[q] = pk2(ylo, yhi); }
                *(v4u*)(ACAT + row * 2048 + 1024 + col) = o; }
        }
        __syncthreads();
    }
}

__device__ __forceinline__ void mixer_phase(const Params& P, int layer, unsigned char* lds_generic, LAS unsigned char* lds, int rep, const pg8::EpiIn& EI) {
    unsigned* ctr = (unsigned*)(P.ws + WS_CTL) + CW_QUEUE + 64 * (layer + 4 * rep);
    volatile LAS unsigned* misc = (volatile LAS unsigned*)(lds + MISC_OFF);
    const bf16_t* Q = (const bf16_t*)(P.ws + WS_Q); const bf16_t* KB = (const bf16_t*)(P.ws + WS_KB); const bf16_t* VB = (const bf16_t*)(P.ws + WS_VB);
    const bf16_t* CK = (const bf16_t*)(P.ws + WS_CK); const bf16_t* CV = (const bf16_t*)(P.ws + WS_CV);
    bf16_t* ACAT = (bf16_t*)(P.ws + WS_ACAT);
    if (threadIdx.x == 0) misc[0] = __hip_atomic_fetch_add(ctr, 1u, __ATOMIC_RELAXED, __HIP_MEMORY_SCOPE_AGENT);
    for (int it = 0;; ++it) {
        __syncthreads();
        unsigned nxt = 0u;
        if (threadIdx.x == 0) nxt = __hip_atomic_fetch_add(ctr, 1u, __ATOMIC_RELAXED, __HIP_MEMORY_SCOPE_AGENT);
        const int tk = __builtin_amdgcn_readfirstlane((int)misc[it & 1]);
        if (tk >= 1408) break;
        const int idx = tk < 768 ? tk : (tk < 896 ? tk - 896 : tk - 128);
        if (idx < 0) {
            const int u = idx + 128;
            pg8::Gemm g{(const bf16_t*)(P.ws + WS_H), (const bf16_t*)(P.ws + WS_WIN) + (size_t)layer * NINW * 1024, NTOK, NINW, 1024};
            if (threadIdx.x == 0) ((LAS int*)(lds + RED_OFF))[2048 + 64 + 256] = -1;
            __syncthreads();
            OneUnit S1{u & 63, 20 + (u >> 6)};
            pg8::gemm_phase<pg8::EpiIn, OneUnit, true, true>(lds, g, S1, EI);
        }
        else if (idx >= 1024) { lru_fix_unit(P, layer, idx - 1024, lds); }
        else if (idx >= 256 && idx < 768) {
#ifndef NO_LRU
            const int j = idx - 256, latent = j < 256, jj = j & 255;
            lru_unit(P, layer, latent, latent ? (jj >> 6) : (jj >> 3), latent ? ((jj >> 3) & 7) : 0, jj & 7, lds);
#endif
        } else {
#ifndef NO_ATT
            const bool latent = idx < 256;
            const int j = latent ? idx : idx - 768;
            const int b = latent ? (j >> 6) : (j >> 3), hh = latent ? ((j >> 3) & 7) : (j & 7), qb = latent ? (j & 7) : 0, kvh = hh >> 2;
            const int q0 = qb * 256, ks = q0 - 128 < 0 ? 0 : q0 - 128, ke = q0 + 384 > 2048 ? 2048 : q0 + 384;
            const size_t rq = latent ? (size_t)NCTX + b * 2048 + q0 : (size_t)b * 256;
            const size_t rk = (size_t)NCTX + b * 2048 + ks, ck0 = (size_t)(b * 4 + layer) * 512;
            const bf16_t* K0 = latent ? CK + ck0 * 256 + kvh * 128 : KB + rq * 256 + kvh * 128;
            const bf16_t* V0 = latent ? CV + ck0 * 256 + kvh * 128 : VB + rq * 256 + kvh * 128;
            att::attn_unit(Q + rq * 1024 + hh * 128, K0, V0, latent ? 8 : 4,
                           KB + rk * 256 + kvh * 128, VB + rk * 256 + kvh * 128, latent ? (ke - ks) / 64 : 0, ks - q0,
                           P.in[14][layer * 8 + hh] * 1.4426950408889634f, ACAT + rq * 2048 + hh * 128, (char*)lds_generic);
#endif
        }
        if (threadIdx.x == 0) misc[(it + 1) & 1] = nxt;
    }
}

__global__ void __launch_bounds__(512, 2) fwd_megakernel(Params P) {
    extern __shared__ __attribute__((aligned(16))) unsigned char lds_raw[];
    LAS unsigned char* lds = (LAS unsigned char*)lds_raw;
    cg::grid_group grid = cg::this_grid();
    const int lo = P.ph_lo, hi = P.ph_hi, G = gridDim.x;
    int ph = 0;
    { volatile LAS unsigned* m = (volatile LAS unsigned*)(lds + MISC_OFF); if (threadIdx.x < 16) m[threadIdx.x] = 0u; }
    __syncthreads();
    XcdBarrier bar = xcd_barrier_post((unsigned*)(P.ws + WS_CTL) + CW_BAR, (volatile LAS unsigned*)(lds + MISC_OFF) + 8);
#define PHASE(...) do { if (ph >= lo && ph < hi) { __VA_ARGS__; if (ph + 1 < hi) { if (lo < 0) grid.sync(); else xcd_barrier(bar); } } ++ph; } while (0)
    bf16_t* H = (bf16_t*)(P.ws + WS_H);
#ifndef NO_PRO
    PHASE(prologue(P, lds));
#endif
    PHASE(prep_phase(P, lds));
#ifdef XSYNC
    if (hi > 1) { for (int i = 0; i < XSYNC; ++i) grid.sync(); }
#endif
    for (int l = 0; l < NL; ++l) {
        const float* mod = (const float*)(P.ws + WS_MOD) + (size_t)l * 5 * NMOD6;
        const pg8::EpiIn EI{(bf16_t*)(P.ws + WS_Q), (bf16_t*)(P.ws + WS_KB), (bf16_t*)(P.ws + WS_VB), (bf16_t*)(P.ws + WS_XR), ((bf16_t*)P.out), (bf16_t*)(P.ws + WS_G),
                         P.out + OUT_K, P.out + OUT_V, P.in[12] + l * 128, P.in[13] + l * 128, (const float*)(P.ws + WS_ROPE), (LAS float*)(lds + RED_OFF), l,
                         (const float*)(P.ws + WS_SSQ), (const float*)(P.ws + WS_SWIN) + (size_t)l * 5 * NINW};
        PHASE({ RS_RESET(); pg8::Gemm g{H, (const bf16_t*)(P.ws + WS_WIN) + (size_t)l * NINW * 1024, NTOK, NINW, 1024}; pg8::StaticOrder S; S.init(NTOK, 5120, G, opaque_bid());
            pg8::gemm_phase<pg8::EpiIn, pg8::StaticOrder, true, true>(lds, g, S, EI); });
        PHASE({ _Pragma("nounroll") for (int rep = 0; rep < XREP_MIX; ++rep) { mixer_phase(P, l, lds_raw, lds, rep, EI); if (rep + 1 < XREP_MIX) xcd_barrier(bar); } });
        PHASE({ pg8::Gemm g{(const bf16_t*)(P.ws + WS_ACAT), (const bf16_t*)(P.ws + WS_WCAT) + (size_t)l * 1024 * 2048, NTOK, 1024, 2048}; pg8::StaticOrder S; S.init(NTOK, 1024, G, opaque_bid());
            pg8::EpiMerge E{(const bf16_t*)(P.ws + WS_G), (bf16_t*)(P.ws + WS_MERGED)};

#ifndef NO_G2
 pg8::gemm_phase<pg8::EpiMerge, pg8::StaticOrder, true, true>(lds, g, S, E);
#endif
 });
        PHASE({ pg8::Gemm g{(const bf16_t*)(P.ws + WS_MERGED), (const bf16_t*)(P.ws + WS_WOUT) + (size_t)l * 1024 * 1024, NTOK, 1024, 1024}; pg8::StaticOrder S; S.init(NTOK, 1024, G, opaque_bid());
            pg8::EpiRes E{l == 0 ? P.in[0] : (const float*)nullptr, P.in[1] - (size_t)NCTX * 1024, (const bf16_t*)(P.ws + WS_X16), (bf16_t*)(P.ws + WS_X16), (float*)nullptr, mod + 2048, H, (const float*)(P.ws + WS_WMOD) + (size_t)(l * 2 + 1) * 5 * 1024, (float*)(P.ws + WS_SSQ)};

#ifndef NO_G3
 pg8::gemm_phase<pg8::EpiRes, pg8::StaticOrder, true, true>(lds, g, S, E);
#endif
 });
        PHASE({ RS_RESET(); pg8::Gemm g{H, (const bf16_t*)(P.ws + WS_W1) + (size_t)l * DFF * 1024, NTOK, DFF, 1024}; pg8::StaticOrder S; S.init(NTOK, DFF, G, opaque_bid());
            pg8::EpiUp E{(bf16_t*)(P.ws + WS_U), (const float*)(P.ws + WS_SSQ), (const float*)(P.ws + WS_SWUP) + (size_t)l * 5 * DFF, (LAS float*)(lds + RED_OFF) + 2048 + 64};

#ifndef NO_G4
 pg8::gemm_phase<pg8::EpiUp, pg8::StaticOrder, true, true>(lds, g, S, E);
#endif
 });
        PHASE({ pg8::Gemm g{(const bf16_t*)(P.ws + WS_U), (const bf16_t*)(P.ws + WS_W2) + (size_t)l * 1024 * DFF, NTOK, 1024, DFF}; pg8::StaticOrder S; S.init(NTOK, 1024, G, opaque_bid());
            pg8::EpiRes E{(const float*)nullptr, (const float*)nullptr, (const bf16_t*)(P.ws + WS_X16), (bf16_t*)(P.ws + WS_X16), l + 1 < NL ? (float*)nullptr : P.out, mod + 5 * 1024, l + 1 < NL ? H : (bf16_t*)nullptr, (const float*)(P.ws + WS_WMOD) + (size_t)((l + 1) * 2) * 5 * 1024, (float*)(P.ws + WS_SSQ)};

#ifndef NO_G3
 pg8::gemm_phase<pg8::EpiRes, pg8::StaticOrder, true, true>(lds, g, S, E);
#endif
 });
    }
#undef PHASE
#ifdef DUMP_PH
    grid.sync();
    { const v4u* src = (const v4u*)(P.ws + (size_t)DUMP_OFF * MiB); v4u* dst = (v4u*)P.out; const size_t n = (size_t)(33554432 + 262144) / 4;
      const size_t nl = (size_t)DUMP_LEN * MiB / 16; const v4u z = {0u, 0u, 0u, 0u};
      for (size_t i = (size_t)blockIdx.x * 512 + threadIdx.x; i < n; i += (size_t)gridDim.x * 512) dst[i] = i < nl ? src[i] : z; }
#endif
}

extern "C" void kernel_launch(void* const* d_in, const int* in_sizes, int n_in, void* d_out, int out_size, void* d_ws, size_t ws_size, hipStream_t stream) {
    static int grid = 0;
    if (grid == 0) {
        if (n_in != 27 || ws_size < WS_END) { fprintf(stderr, "kernel_launch: unexpected n_in %d / ws_size %zu (need %zu)\n", n_in, ws_size, (size_t)WS_END); grid = -1; return; }
        int dev = 0, cus = 0, per_cu = 0;
        (void)hipGetDevice(&dev); (void)hipDeviceGetAttribute(&cus, hipDeviceAttributeMultiprocessorCount, dev);
        if (hipFuncSetAttribute((const void*)fwd_megakernel, hipFuncAttributeMaxDynamicSharedMemorySize, LDS_BYTES) != hipSuccess) { fprintf(stderr, "kernel_launch: hipFuncSetAttribute failed\n"); grid = -1; return; }
        if (hipOccupancyMaxActiveBlocksPerMultiprocessor(&per_cu, (const void*)fwd_megakernel, 512, LDS_BYTES) != hipSuccess || per_cu < 1) { fprintf(stderr, "kernel_launch: occupancy query says %d\n", per_cu); per_cu = 1; }
        (void)hipGetLastError();
        grid = cus * 1;
        if (grid <= 0) grid = 256;
    }
    if (grid < 0) return;
    (void)hipMemsetAsync((char*)d_ws + WS_CTL, 0, 65536, stream);
    Params p{};
    for (int i = 0; i < 27; ++i) p.in[i] = (const float*)d_in[i];
    p.out = (float*)d_out; p.ws = (unsigned char*)d_ws;
#ifndef MK_SPLIT
#ifdef DUMP_PH
    p.ph_lo = 0; p.ph_hi = DUMP_PH;
#else
    p.ph_lo = 0; p.ph_hi = 1000;
#endif
    void* args[] = {&p};
    hipError_t e = hipLaunchCooperativeKernel((const void*)fwd_megakernel, dim3(grid), dim3(512), args, LDS_BYTES, stream);
    if (e != hipSuccess) fprintf(stderr, "cooperative launch failed: %s (grid %d)\n", hipGetErrorString(e), grid);
#else
    const int nph = 2 + NL * 6;
    for (int k = 0; k < nph; ++k) { p.ph_lo = k; p.ph_hi = k + 1; hipLaunchKernelGGL(fwd_megakernel, dim3(grid), dim3(512), LDS_BYTES, stream, p); }
#endif
}
```

```cpp
#include <hip/hip_runtime.h>
#include <hip/hip_cooperative_groups.h>
#include <hip/hip_bf16.h>
#include <cstdio>
#include <cstdint>
namespace cg = cooperative_groups;
namespace pg8 {
#define PG8_LAS __attribute__((address_space(3)))
typedef unsigned short bf16_t;
typedef short bf16x8 __attribute__((ext_vector_type(8)));
typedef float f32x4 __attribute__((ext_vector_type(4)));
typedef unsigned u32x4 __attribute__((ext_vector_type(4)));
constexpr int BM = 256, BK = 64, HALF = 128, HTB = HALF * BK * 2  , STAGE_BYTES = 8 * HTB, NXCD = 8, WGM = 8;

__host__ __device__ __forceinline__ int lds_byte(int r, int c) { const int st = (r >> 4) * 2 + (c >> 5), rr = r & 15, cc = c & 31, ob = rr * 64 + cc * 2; return st * 1024 + (ob ^ (((ob >> 9) & 1) << 5)); }
__host__ __device__ __forceinline__ void stage_rc(int b, int& R, int& C) { const int st = b / 1024, sb = b % 1024, swz = sb ^ (((sb >> 9) & 1) << 5); R = (st >> 1) * 16 + swz / 64; C = (st & 1) * 32 + (swz % 64) / 2; }
__host__ __device__ __forceinline__ int perm32(int rho) { const int n = rho >> 4, i = rho & 15; return 8 * (i >> 2) + 4 * n + (i & 3); }

struct Unit { int pm, pn; };
struct Gemm { const bf16_t* A; const bf16_t* Bt; int M, N, K; };

struct StaticOrder {
    int nM, nN, nwg, G, c;
    __host__ __device__ void init(int M, int N, int G_, int c_) { nM = M / BM; nN = N / BM; nwg = nM * nN; G = G_; c = c_; }
    __host__ __device__ bool next(int i, Unit& u) const {
        const long L = (long)i * G + c; if (L >= nwg) return false;
        int wgid = (int)L; { const int q = nwg / NXCD, r = nwg % NXCD, xcd = wgid % NXCD, off = wgid / NXCD; wgid = (xcd < r ? xcd * (q + 1) : r * (q + 1) + (xcd - r) * q) + off; }
        const int nig = WGM * nN, gid = wgid / nig, fm = gid * WGM, gsz = (nM - fm) < WGM ? (nM - fm) : WGM;
        u.pm = fm + ((wgid % nig) % gsz); u.pn = (wgid % nig) / gsz; return true;
    }
    __device__ __forceinline__ void a_ready(const Unit&) const {}
    __device__ __forceinline__ void done(const Unit&) const {}
};

typedef float f32x2c_t __attribute__((ext_vector_type(2))); typedef __bf16 bf16x2c_t __attribute__((ext_vector_type(2)));
__device__ __forceinline__ unsigned cvt_pk_bf16(float lo, float hi) { f32x2c_t v = {lo, hi}; bf16x2c_t b = __builtin_convertvector(v, bf16x2c_t); return __builtin_bit_cast(unsigned, b); }
typedef float f32x2 __attribute__((ext_vector_type(2)));
typedef unsigned u32x2 __attribute__((ext_vector_type(2)));
__device__ __forceinline__ float bf2f(unsigned short u) { return __uint_as_float(((unsigned)u) << 16); }
__device__ __forceinline__ float fsigmoid(float x) { return __builtin_amdgcn_rcpf(1.0f + __expf(-x)); }
__device__ __forceinline__ float gelu_tanh(float x) { const float u = 1.5957691216057308f * (x + 0.044715f * x * x * x); return x * __builtin_amdgcn_rcpf(1.0f + __expf(-u)); }
__device__ __forceinline__ u32x2 pack4(f32x4 v) { u32x2 w; w.x = cvt_pk_bf16(v[0], v[1]); w.y = cvt_pk_bf16(v[2], v[3]); return w; }
__host__ __device__ __forceinline__ int dim_of_pos(int p) { const int pi = p >> 1, wh = p & 1; return (pi >> 5) * 64 + wh * 32 + (pi & 31); }
__host__ __device__ __forceinline__ int pos_of_dim(int d) { const int ax = d >> 6, wh = (d >> 5) & 1, i = d & 31; return 2 * (ax * 32 + i) + wh; }

constexpr int NTOK = 16384, NCTX = 8192, DM = 1024;
constexpr float EPSN = 1e-6f;


template <bool PERMC>
__device__ __forceinline__ void prenorm_apply(f32x4 (&acc)[2][2][4][2], const Unit& u, int wr, int wc, int fr, int fq, const float* ssq, const float* sw, int ncols, PG8_LAS float* rs) {
    const int rowt = wr * 64 + fr, colw = u.pn * 256 + wc * 32 + (PERMC ? 8 : 4) * fq;
    const int cond = u.pm < 32 ? 0 : 1 + ((u.pm - 32) >> 3);
    const float* swp = sw + (size_t)cond * ncols + colw;
    const int t = (wr * 4 + wc) * 64 + fq * 16 + fr;
    const bool rebuild = ((const PG8_LAS int*)rs)[256] != u.pm;
    if (rebuild && t < 256) {
        const float* sp = ssq + (size_t)(u.pm * 256 + t) * 16;
        const f32x4 s0 = *(const f32x4*)sp, s1 = *(const f32x4*)(sp + 4), s2 = *(const f32x4*)(sp + 8), s3 = *(const f32x4*)(sp + 12);
        const f32x4 st = (s0 + s1) + (s2 + s3);
        rs[t] = __builtin_amdgcn_rsqf(((st[0] + st[1]) + (st[2] + st[3])) * (1.0f / 1024.0f) + EPSN);
    }
    f32x4 sv[2][2];
#pragma unroll
    for (int bj = 0; bj < 2; ++bj)
#pragma unroll
        for (int n = 0; n < 2; ++n) sv[bj][n] = *(const f32x4*)(swp + bj * 128 + (PERMC ? 4 : 16) * n);
    if (rebuild) {
        asm volatile("s_waitcnt lgkmcnt(0)" ::: "memory"); __builtin_amdgcn_s_barrier(); asm volatile("" ::: "memory");
        if (t == 0) ((PG8_LAS int*)rs)[256] = u.pm;
    }
#pragma unroll
    for (int ai = 0; ai < 2; ++ai)
#pragma unroll
        for (int m = 0; m < 4; ++m) {
            const float rstd = rs[ai * 128 + m * 16 + rowt];
#pragma unroll
            for (int bj = 0; bj < 2; ++bj)
#pragma unroll
                for (int n = 0; n < 2; ++n) acc[ai][bj][m][n] = acc[ai][bj][m][n] * rstd + sv[bj][n];
        }
}

struct EpiIn {
    static constexpr bool PERM = true, AFTER_DRAIN = false, HAS_MID = false;
    bf16_t *Q, *KB, *VB, *XR, *GXB, *G; float *outk, *outv; const float *qw, *kw, *rope; PG8_LAS float* red; int layer; const float *ssq, *sw;
    __device__ __forceinline__ void operator()(f32x4 (&acc)[2][2][4][2], const Unit& u, int wr, int wc, int fr, int fq) const {
        asm volatile("" : "+v"(fr), "+v"(fq));
        prenorm_apply<true>(acc, u, wr, wc, fr, fq, ssq, sw, 5632, red + 2048 + 64);
        const int pn = u.pn, pm = u.pm;
        const int rowt = wr * 64 + fr, colw = wc * 32 + 8 * fq;
        const bool latent = pm >= 32;
        if (pn < 5) {
#pragma unroll
            for (int ai = 0; ai < 2; ++ai)
#pragma unroll
                for (int m = 0; m < 4; ++m)
#pragma unroll
                    for (int bj = 0; bj < 2; ++bj) {
                        float s = 0.f;
#pragma unroll
                        for (int n = 0; n < 2; ++n) { const f32x4 x = acc[ai][bj][m][n]; s += (x[0] * x[0] + x[1] * x[1]) + (x[2] * x[2] + x[3] * x[3]); }
                        s += __shfl_xor(s, 16); s += __shfl_xor(s, 32);
                        if (fq == 0) red[((ai * 128 + m * 16 + rowt) * 2 + bj) * 4 + wc] = s;
                    }
            asm volatile("s_waitcnt lgkmcnt(0)" ::: "memory"); __builtin_amdgcn_s_barrier(); asm volatile("" ::: "memory");
            const float* nw = pn < 4 ? qw : kw;
            f32x4 wv[2];
#pragma unroll
            for (int n = 0; n < 2; ++n)
#pragma unroll
                for (int e = 0; e < 4; ++e) wv[n][e] = nw[dim_of_pos(colw + 4 * n + e)];
#pragma unroll
            for (int ai = 0; ai < 2; ++ai)
#pragma unroll
                for (int m = 0; m < 4; ++m) {
                    const int rl = ai * 128 + m * 16 + rowt, row = pm * 256 + rl;
#pragma unroll
                    for (int bj = 0; bj < 2; ++bj) {
                        const f32x4 pr = *(const PG8_LAS f32x4*)(red + (rl * 2 + bj) * 4);
                        const float rstd = __builtin_amdgcn_rsqf(((pr[0] + pr[1]) + (pr[2] + pr[3])) * (1.0f / 128.0f) + EPSN);
                        u32x2 pk[2]; float kx[2][2], ky[2][2];
#pragma unroll
                        for (int n = 0; n < 2; ++n) {
                            f32x4 v = acc[ai][bj][m][n] * rstd * wv[n];
                            const int p = colw + 4 * n;
                            if (!latent && pn == 4) { kx[n][0] = v[0]; kx[n][1] = v[2]; ky[n][0] = v[1]; ky[n][1] = v[3]; }
                            if (latent) {
                                const int t = (row - NCTX) & 2047;
                                const f32x4 cs = *(const f32x4*)(rope + ((size_t)t * 64 + (p >> 1)) * 2);
                                f32x4 o; o[0] = v[0] * cs[0] - v[1] * cs[1]; o[1] = v[1] * cs[0] + v[0] * cs[1]; o[2] = v[2] * cs[2] - v[3] * cs[3]; o[3] = v[3] * cs[2] + v[2] * cs[3];
                                v = o;
                            }
                            pk[n] = pack4(v);
                        }
                        if (!latent && pn == 4) {
                            float* o = outk + ((size_t)((pm * 4 + layer) * 256 + rl) * 2 + bj) * 128 + dim_of_pos(colw);
                            *(f32x4*)o = (f32x4){kx[0][0], kx[0][1], kx[1][0], kx[1][1]}; *(f32x4*)(o + 32) = (f32x4){ky[0][0], ky[0][1], ky[1][0], ky[1][1]};
                        }
                        bf16_t* dst = (pn < 4) ? Q + (size_t)row * 1024 + pn * 256 + bj * 128 + colw : KB + (size_t)row * 256 + bj * 128 + colw;
                        u32x4 w; w.x = pk[0].x; w.y = pk[0].y; w.z = pk[1].x; w.w = pk[1].y;
                        *(u32x4*)dst = w;
                    }
                }
        } else {
#pragma unroll
            for (int ai = 0; ai < 2; ++ai)
#pragma unroll
                for (int m = 0; m < 4; ++m) {
                    const int rl = ai * 128 + m * 16 + rowt, row = pm * 256 + rl;
#pragma unroll
                    for (int bj = 0; bj < 2; ++bj) {
                        f32x4 v0 = acc[ai][bj][m][0], v1 = acc[ai][bj][m][1];
                        const int c = bj * 128 + colw;
                        bf16_t* dst;
                        if (pn == 5) {
                            if (!latent) { float* o = outv + ((size_t)((pm * 4 + layer) * 256 + rl)) * 256 + c; *(f32x4*)o = v0; *(f32x4*)(o + 4) = v1; }
                            dst = VB + (size_t)row * 256 + c;
                        } else if (pn < 10) {
                            dst = XR + (size_t)row * 1024 + (pn - 6) * 256 + c;
                        } else if (pn < 14) {
#pragma unroll
                            for (int e = 0; e < 4; ++e) { v0[e] = gelu_tanh(v0[e]); v1[e] = gelu_tanh(v1[e]); }
                            dst = GXB + (size_t)row * 1024 + (pn - 10) * 256 + c;
                        } else {
#pragma unroll
                            for (int e = 0; e < 4; ++e) { v0[e] = fsigmoid(v0[e]); v1[e] = fsigmoid(v1[e]); }
                            dst = G + (size_t)row * 2048 + (pn - 14) * 256 + c;
                        }
                        const u32x2 p0 = pack4(v0), p1 = pack4(v1);
                        u32x4 w; w.x = p0.x; w.y = p0.y; w.z = p1.x; w.w = p1.y;
                        *(u32x4*)dst = w;
                    }
                }
        }
    }
};

struct EpiMerge {
    static constexpr bool PERM = true, AFTER_DRAIN = false, HAS_MID = true;
    const bf16_t* G; bf16_t* O;
    __device__ __forceinline__ static f32x4 lo4(u32x4 g) { f32x4 r; r[0] = __uint_as_float(g.x << 16); r[1] = __uint_as_float(g.x & 0xffff0000u); r[2] = __uint_as_float(g.y << 16); r[3] = __uint_as_float(g.y & 0xffff0000u); return r; }
    __device__ __forceinline__ static f32x4 hi4(u32x4 g) { f32x4 r; r[0] = __uint_as_float(g.z << 16); r[1] = __uint_as_float(g.z & 0xffff0000u); r[2] = __uint_as_float(g.w << 16); r[3] = __uint_as_float(g.w & 0xffff0000u); return r; }
    __device__ __forceinline__ static f32x4 rcp4(f32x4 x) { f32x4 r; r[0] = __builtin_amdgcn_rcpf(fmaxf(x[0], 1e-20f)); r[1] = __builtin_amdgcn_rcpf(fmaxf(x[1], 1e-20f)); r[2] = __builtin_amdgcn_rcpf(fmaxf(x[2], 1e-20f)); r[3] = __builtin_amdgcn_rcpf(fmaxf(x[3], 1e-20f)); return r; }
    __device__ __forceinline__ void mid(f32x4 (&acc)[2][2][4][2], const Unit& u, int wr, int wc, int fr, int fq) const {
        asm volatile("" : "+v"(fr), "+v"(fq));
        const int rowt = wr * 64 + fr, colw = u.pn * 256 + wc * 32 + 8 * fq;
#pragma unroll
        for (int ai = 0; ai < 2; ++ai)
#pragma unroll
            for (int m = 0; m < 4; ++m) {
                const bf16_t* gr = G + (size_t)(u.pm * 256 + ai * 128 + m * 16 + rowt) * 2048 + colw;
#pragma unroll
                for (int bj = 0; bj < 2; ++bj) {
                    const u32x4 a = *(const u32x4*)(gr + bj * 128), l = *(const u32x4*)(gr + 1024 + bj * 128);
                    acc[ai][bj][m][0] *= lo4(a) * rcp4(lo4(l));
                    acc[ai][bj][m][1] *= hi4(a) * rcp4(hi4(l));
                }
            }
    }
    __device__ __forceinline__ void operator()(f32x4 (&acc)[2][2][4][2], const Unit& u, int wr, int wc, int fr, int fq) const {
        asm volatile("" : "+v"(fr), "+v"(fq));
        const int rowt = wr * 64 + fr, colw = u.pn * 256 + wc * 32 + 8 * fq;
#pragma unroll
        for (int ai = 0; ai < 2; ++ai)
#pragma unroll
            for (int m = 0; m < 4; ++m) {
                const size_t row = (size_t)(u.pm * 256 + ai * 128 + m * 16 + rowt);
                const bf16_t* gr = G + row * 2048 + 1024 + colw;
#pragma unroll
                for (int bj = 0; bj < 2; ++bj) {
                    const u32x4 l = *(const u32x4*)(gr + bj * 128);
                    const u32x2 p0 = pack4(acc[ai][bj][m][0] * lo4(l)), p1 = pack4(acc[ai][bj][m][1] * hi4(l));
                    u32x4 w; w.x = p0.x; w.y = p0.y; w.z = p1.x; w.w = p1.y;
                    *(u32x4*)(O + row * 1024 + colw + bj * 128) = w;
                }
            }
    }
};

struct EpiRes {
    static constexpr bool PERM = true, AFTER_DRAIN = false, HAS_MID = false;
    const float* xin0; const float* xin1; const bf16_t* xs16; bf16_t* x16o; float* yout; const float* gate; bf16_t* Hn; const float* wmod; float* ssq;
    __device__ __forceinline__ void operator()(f32x4 (&acc)[2][2][4][2], const Unit& u, int wr, int wc, int fr, int fq) const {
        asm volatile("" : "+v"(fr), "+v"(fq));
        const int rowt = wr * 64 + fr, colw = u.pn * 256 + wc * 32 + 8 * fq;
        const int cond = u.pm < 32 ? 0 : 1 + ((u.pm - 32) >> 3);
        const float* xin = u.pm < 32 ? xin0 : xin1;
#pragma unroll
        for (int ai = 0; ai < 2; ++ai)
#pragma unroll
            for (int m = 0; m < 4; ++m) {
                const int row = u.pm * 256 + ai * 128 + m * 16 + rowt;
                const size_t off = (size_t)row * 1024 + colw;
                const float* gp = gate + cond * 6144 + colw;
                float sq = 0.f;
#pragma unroll
                for (int bj = 0; bj < 2; ++bj) {
                    f32x4 x0, x1;
                    if (xin0) { x0 = *(const f32x4*)(xin + off + bj * 128); x1 = *(const f32x4*)(xin + off + bj * 128 + 4); }
                    else { const u32x4 xb = *(const u32x4*)(xs16 + off + bj * 128);
                        x0[0] = __uint_as_float(xb.x << 16); x0[1] = __uint_as_float(xb.x & 0xffff0000u); x0[2] = __uint_as_float(xb.y << 16); x0[3] = __uint_as_float(xb.y & 0xffff0000u);
                        x1[0] = __uint_as_float(xb.z << 16); x1[1] = __uint_as_float(xb.z & 0xffff0000u); x1[2] = __uint_as_float(xb.w << 16); x1[3] = __uint_as_float(xb.w & 0xffff0000u); }
                    const f32x4 g0 = *(const f32x4*)(gp + bj * 128), g1 = *(const f32x4*)(gp + bj * 128 + 4);
                    const f32x4 xn0 = x0 + g0 * acc[ai][bj][m][0], xn1 = x1 + g1 * acc[ai][bj][m][1];
                    if (yout) { *(f32x4*)(yout + off + bj * 128) = xn0; *(f32x4*)(yout + off + bj * 128 + 4) = xn1; }
                    else { const u32x2 p0 = pack4(xn0), p1 = pack4(xn1); u32x4 w; w.x = p0.x; w.y = p0.y; w.z = p1.x; w.w = p1.y; *(u32x4*)(x16o + off + bj * 128) = w; }
                    if (Hn) { const f32x4 w0 = *(const f32x4*)(wmod + cond * 1024 + colw + bj * 128), w1 = *(const f32x4*)(wmod + cond * 1024 + colw + bj * 128 + 4);
                        const u32x2 p0 = pack4(xn0 * w0), p1 = pack4(xn1 * w1); u32x4 w; w.x = p0.x; w.y = p0.y; w.z = p1.x; w.w = p1.y; *(u32x4*)(Hn + off + bj * 128) = w;
                        sq += ((xn0[0] * xn0[0] + xn0[1] * xn0[1]) + (xn0[2] * xn0[2] + xn0[3] * xn0[3])) + ((xn1[0] * xn1[0] + xn1[1] * xn1[1]) + (xn1[2] * xn1[2] + xn1[3] * xn1[3])); }
                }
                if (Hn) { sq += __shfl_xor(sq, 16); sq += __shfl_xor(sq, 32); if (fq == 0) ssq[(size_t)row * 16 + u.pn * 4 + wc] = sq; }
            }
    }
};

struct EpiUp {
    static constexpr bool PERM = true, AFTER_DRAIN = false, HAS_MID = false;
    bf16_t* U; const float *ssq, *sw; PG8_LAS float* rs;
    __device__ __forceinline__ void operator()(f32x4 (&acc)[2][2][4][2], const Unit& u, int wr, int wc, int fr, int fq) const {
        asm volatile("" : "+v"(fr), "+v"(fq));
        prenorm_apply<true>(acc, u, wr, wc, fr, fq, ssq, sw, 4096, rs);
        const int rowt = wr * 64 + fr, colw = u.pn * 256 + wc * 32 + 8 * fq;
#pragma unroll
        for (int ai = 0; ai < 2; ++ai)
#pragma unroll
            for (int m = 0; m < 4; ++m) {
                bf16_t* rp = U + (size_t)(u.pm * 256 + ai * 128 + m * 16 + rowt) * 4096 + colw;
#pragma unroll
                for (int bj = 0; bj < 2; ++bj) {
                    f32x4 v0 = acc[ai][bj][m][0], v1 = acc[ai][bj][m][1];
#pragma unroll
                    for (int e = 0; e < 4; ++e) { const float r0 = fmaxf(v0[e], 0.f), r1 = fmaxf(v1[e], 0.f); v0[e] = r0 * r0; v1[e] = r1 * r1; }
                    const u32x2 p0 = pack4(v0), p1 = pack4(v1);
                    u32x4 w; w.x = p0.x; w.y = p0.y; w.z = p1.x; w.w = p1.y;
                    *(u32x4*)(rp + bj * 128) = w;
                }
            }
    }
};
template <class Epi, class Sched, bool ALIGN_EPI = false, bool SP2 = false>
__device__ __forceinline__ void gemm_phase(PG8_LAS unsigned char* lds, const Gemm g, const Sched& S, const Epi& E) {
    int tid_l = threadIdx.x; asm volatile("" : "+v"(tid_l));
    const int tid = tid_l, wid = __builtin_amdgcn_readfirstlane(tid >> 6), lane = tid & 63, wr = wid >> 2, wc = wid & 3, fr = lane & 15, fq = lane >> 4;
    const int K = g.K, nt = K / BK;
    unsigned voffA[2], voffB[2];
#pragma unroll
    for (int i = 0; i < 2; ++i) { int R, C; stage_rc(tid * 16 + i * 8192, R, C); const int Rb = Epi::PERM ? ((R & ~31) + perm32(R & 31)) : R;
        voffA[i] = (unsigned)(R * K + C) * 2u; voffB[i] = (unsigned)(Rb * K + C) * 2u; }
    const size_t kstep = (size_t)(BK * 2);
    const size_t hstep = (size_t)HALF * K * 2;
    const size_t tstep = 2 * hstep;
    const unsigned ldsw = (unsigned)wid * 1024u;
    const int aoff = lds_byte(wr * 64 + fr, fq * 8), boff = lds_byte(wc * 32 + fr, fq * 8);
#define PG8_SA(b, h) (((b) * 2 + (h)) * HTB)
#define PG8_SB(b, h) ((4 + (b) * 2 + (h)) * HTB)
#define PG8_STAGE(bufoff, gbase, voff) do { _Pragma("unroll") for (int _i = 0; _i < 2; ++_i) \
        __builtin_amdgcn_global_load_lds((const unsigned*)((const char*)(gbase) + (voff)[_i]), (PG8_LAS unsigned*)(lds + (bufoff) + ldsw + _i * 8192), 16, 0, 0); } while (0)
#define PG8_LDA(dst, b, h) do { _Pragma("unroll") for (int m = 0; m < 4; ++m) _Pragma("unroll") for (int k = 0; k < 2; ++k) dst[m][k] = *(const PG8_LAS bf16x8*)(lds + PG8_SA(b, h) + aoff + m * 2048 + k * 1024); } while (0)
#define PG8_LDB(dst, b, h) do { _Pragma("unroll") for (int n = 0; n < 2; ++n) _Pragma("unroll") for (int k = 0; k < 2; ++k) dst[n][k] = *(const PG8_LAS bf16x8*)(lds + PG8_SB(b, h) + boff + n * 2048 + k * 1024); } while (0)
#define PG8_MMA(ai, bj, At, Bt) do { __builtin_amdgcn_s_setprio(1); _Pragma("unroll") for (int m = 0; m < 4; ++m) _Pragma("unroll") for (int n = 0; n < 2; ++n) _Pragma("unroll") for (int k = 0; k < 2; ++k) \
        acc[ai][bj][m][n] = __builtin_amdgcn_mfma_f32_16x16x32_bf16(Bt[n][k], At[m][k], acc[ai][bj][m][n], 0, 0, 0); __builtin_amdgcn_s_setprio(0); } while (0)
#define PG8_WAIT_V(n) asm volatile("s_waitcnt vmcnt(" #n ")" ::: "memory")
#define PG8_WAIT_L(n) asm volatile("s_waitcnt lgkmcnt(" #n ")" ::: "memory")
#define PG8_BAR __builtin_amdgcn_s_barrier()
#define PG8_SCHED __builtin_amdgcn_sched_barrier(0)
    Unit cur, nxt; int ui = 0;
    if (!S.next(0, cur)) return;
    f32x4 acc[2][2][4][2];
#pragma unroll
    for (int a = 0; a < 2; ++a)
#pragma unroll
        for (int b = 0; b < 2; ++b)
#pragma unroll
            for (int m = 0; m < 4; ++m)
#pragma unroll
                for (int n = 0; n < 2; ++n) acc[a][b][m][n] = (f32x4){0.f, 0.f, 0.f, 0.f};
    bf16x8 At[4][2], B0[2][2], B1[2][2];
    const char* cA = (const char*)g.A + (size_t)cur.pm * tstep; const char* cB = (const char*)g.Bt + (size_t)cur.pn * tstep;
    S.a_ready(cur);
    if constexpr (SP2) {
        PG8_STAGE(PG8_SB(0, 0), cB, voffB); PG8_STAGE(PG8_SB(0, 1), cB + hstep, voffB); PG8_STAGE(PG8_SA(0, 0), cA, voffA); PG8_STAGE(PG8_SA(0, 1), cA + hstep, voffA);
        if (wr == 1) PG8_BAR;
        PG8_WAIT_V(2); PG8_BAR;
        PG8_STAGE(PG8_SB(1, 0), cB + kstep, voffB); PG8_STAGE(PG8_SA(1, 0), cA + kstep, voffA); PG8_STAGE(PG8_SB(1, 1), cB + hstep + kstep, voffB);
        PG8_WAIT_V(6); PG8_BAR;
    } else {
        PG8_STAGE(PG8_SB(0, 0), cB, voffB); PG8_STAGE(PG8_SA(0, 0), cA, voffA); PG8_STAGE(PG8_SB(0, 1), cB + hstep, voffB); PG8_STAGE(PG8_SA(0, 1), cA + hstep, voffA);
        if (wr == 1) PG8_BAR;
        PG8_WAIT_V(4); PG8_BAR;
        PG8_STAGE(PG8_SB(1, 0), cB + kstep, voffB); PG8_STAGE(PG8_SA(1, 0), cA + kstep, voffA); PG8_STAGE(PG8_SB(1, 1), cB + hstep + kstep, voffB);
        PG8_WAIT_V(6); PG8_BAR;
    }
    for (;;) {
        const bool has_next = S.next(ui + 1, nxt);
        const char* nA = has_next ? (const char*)g.A + (size_t)nxt.pm * tstep : cA; const char* nB = has_next ? (const char*)g.Bt + (size_t)nxt.pn * tstep : cB;
        for (int t = 0; t < nt; t += 2) {
            if constexpr (Epi::HAS_MID) { if (t == (nt >> 1)) E.mid(acc, cur, wr, wc, fr, fq); }
            const bool last = (t == nt - 2);
            const char* a1 = cA + (size_t)(t + 1) * kstep;
            const char* a2 = last ? nA : cA + (size_t)(t + 2) * kstep; const char* b2 = last ? nB : cB + (size_t)(t + 2) * kstep;
            const char* a3 = a2 + kstep; const char* b3 = b2 + kstep;
            if (last && has_next) S.a_ready(nxt);
            if constexpr (SP2) {
            PG8_LDB(B0, 0, 0); PG8_LDB(B1, 0, 1); PG8_SCHED; PG8_LDA(At, 0, 0); PG8_STAGE(PG8_SA(1, 1), a1 + hstep, voffA);
            PG8_WAIT_V(8); PG8_WAIT_L(0); PG8_BAR; PG8_MMA(0, 0, At, B0); PG8_MMA(0, 1, At, B1); PG8_BAR; PG8_SCHED;
            PG8_LDA(At, 0, 1); PG8_STAGE(PG8_SB(0, 0), b2, voffB); PG8_STAGE(PG8_SB(0, 1), b2 + hstep, voffB); PG8_STAGE(PG8_SA(0, 0), a2, voffA);
            PG8_WAIT_V(8); PG8_WAIT_L(0); PG8_BAR; PG8_MMA(1, 0, At, B0); PG8_MMA(1, 1, At, B1); PG8_BAR; PG8_SCHED;
            PG8_LDB(B0, 1, 0); PG8_LDB(B1, 1, 1); PG8_SCHED; PG8_LDA(At, 1, 0); PG8_STAGE(PG8_SA(0, 1), a2 + hstep, voffA);
            PG8_WAIT_V(8); PG8_WAIT_L(0); PG8_BAR; PG8_MMA(0, 0, At, B0); PG8_MMA(0, 1, At, B1); PG8_BAR; PG8_SCHED;
            PG8_LDA(At, 1, 1); PG8_STAGE(PG8_SB(1, 0), b3, voffB); PG8_STAGE(PG8_SB(1, 1), b3 + hstep, voffB); PG8_STAGE(PG8_SA(1, 0), a3, voffA);
            PG8_WAIT_V(8); PG8_WAIT_L(0); PG8_BAR; PG8_MMA(1, 0, At, B0); PG8_MMA(1, 1, At, B1); PG8_BAR; PG8_SCHED;
            } else {
            PG8_LDB(B0, 0, 0); PG8_SCHED; PG8_LDA(At, 0, 0); PG8_STAGE(PG8_SA(1, 1), a1 + hstep, voffA);
            PG8_WAIT_L(8); PG8_BAR; PG8_WAIT_L(0); PG8_MMA(0, 0, At, B0); PG8_BAR; PG8_SCHED;
            PG8_LDB(B1, 0, 1); PG8_STAGE(PG8_SB(0, 0), b2, voffB);
            PG8_BAR; PG8_WAIT_L(0); PG8_MMA(0, 1, At, B1); PG8_BAR;
            PG8_LDA(At, 0, 1); PG8_STAGE(PG8_SA(0, 0), a2, voffA);
            PG8_BAR; PG8_WAIT_L(0); PG8_MMA(1, 0, At, B0); PG8_BAR; PG8_SCHED;
            PG8_STAGE(PG8_SB(0, 1), b2 + hstep, voffB);
            PG8_WAIT_V(6); PG8_BAR; PG8_MMA(1, 1, At, B1); PG8_BAR;
            PG8_LDB(B0, 1, 0); PG8_SCHED; PG8_LDA(At, 1, 0); PG8_STAGE(PG8_SA(0, 1), a2 + hstep, voffA);
            PG8_WAIT_L(8); PG8_BAR; PG8_WAIT_L(0); PG8_MMA(0, 0, At, B0); PG8_BAR; PG8_SCHED;
            PG8_LDB(B1, 1, 1); PG8_STAGE(PG8_SB(1, 0), b3, voffB);
            PG8_BAR; PG8_WAIT_L(0); PG8_MMA(0, 1, At, B1); PG8_BAR;
            PG8_LDA(At, 1, 1); PG8_STAGE(PG8_SA(1, 0), a3, voffA);
            PG8_BAR; PG8_WAIT_L(0); PG8_MMA(1, 0, At, B0); PG8_BAR; PG8_SCHED;
            PG8_STAGE(PG8_SB(1, 1), b3 + hstep, voffB);
            PG8_WAIT_V(6); PG8_BAR; PG8_MMA(1, 1, At, B1); PG8_BAR;
            }
        }
        if constexpr (ALIGN_EPI) { if (wr == 0) PG8_BAR; }
        if constexpr (!Epi::AFTER_DRAIN) { E(acc, cur, wr, wc, fr, fq); S.done(cur); }
        if (!has_next) break;
#pragma unroll
        for (int a = 0; a < 2; ++a)
#pragma unroll
            for (int b = 0; b < 2; ++b)
#pragma unroll
                for (int m = 0; m < 4; ++m)
#pragma unroll
                    for (int n = 0; n < 2; ++n) acc[a][b][m][n] = (f32x4){0.f, 0.f, 0.f, 0.f};
        cur = nxt; cA = nA; cB = nB; ++ui;
        if constexpr (ALIGN_EPI) { if (wr == 1) PG8_BAR; }
    }
    PG8_WAIT_V(0);
    if constexpr (!ALIGN_EPI) { if (wr == 0) PG8_BAR; }
    PG8_BAR;
    if constexpr (Epi::AFTER_DRAIN) { E.fused(acc, cur, wr, wc, fr, fq, lds, wid, lane); S.done(cur); }
#undef PG8_SA
#undef PG8_SB
#undef PG8_STAGE
#undef PG8_LDA
#undef PG8_LDB
#undef PG8_MMA
#undef PG8_WAIT_V
#undef PG8_WAIT_L
#undef PG8_BAR
#undef PG8_SCHED
}
}

namespace att {
using bf16 = unsigned short;
using bf16x8 = __attribute__((ext_vector_type(8))) short;
using s16x4  = __attribute__((ext_vector_type(4))) short;
using f32x16 = __attribute__((ext_vector_type(16))) float;
using u32x4  = __attribute__((ext_vector_type(4))) unsigned;
constexpr int D = 128, NW = 8, QBLK = 32, KVBLK = 64;
constexpr float SCALE = 0.088388347648318440f;
constexpr float THR = 8.f;
constexpr int LDQ = 1024, LDK = 256, LDO = 2048;
constexpr size_t SHM_V = KVBLK * D * 2, SHM_K = KVBLK * D * 2, SHM_ATTN = 2 * SHM_V + 2 * SHM_K + NW * 64 * 4;
#define KSWZ(row, colB) ((row) * 256 + ((colB) ^ (((row) & 7) << 4)))
#define SBAR() __builtin_amdgcn_sched_barrier(0)
__device__ __forceinline__ int crow(int r, int hi) { return (r & 3) + 8 * (r >> 2) + 4 * hi; }
typedef float f32x2a_t __attribute__((ext_vector_type(2))); typedef __bf16 bf16x2a_t __attribute__((ext_vector_type(2)));
__device__ __forceinline__ unsigned cvtpk(float lo, float hi) { f32x2a_t v = {lo, hi}; bf16x2a_t b = __builtin_convertvector(v, bf16x2a_t); return __builtin_bit_cast(unsigned, b); }
__device__ __forceinline__ void partialSM(f32x16& p0, f32x16& p1, float& m_reg, float& mn, float& alpha) {
  constexpr float C = SCALE * 1.4426950408889634f;
  float pmax = p0[0]; for (int r = 1; r < 16; ++r) pmax = fmaxf(pmax, p0[r]); for (int r = 0; r < 16; ++r) pmax = fmaxf(pmax, p1[r]);
  { auto rr = __builtin_amdgcn_permlane32_swap(__float_as_uint(pmax), __float_as_uint(pmax), false, false);
    pmax = fmaxf(__uint_as_float(rr[0]), __uint_as_float(rr[1])); }
  if (__builtin_expect(__all(pmax - m_reg <= THR / SCALE), 1)) { mn = m_reg; alpha = 1.f; }
  else { mn = fmaxf(m_reg, pmax); alpha = __builtin_amdgcn_exp2f((m_reg - mn) * C); m_reg = mn; }
  float mnC = -mn * C;
  for (int r = 0; r < 16; ++r) p0[r] = fmaf(p0[r], C, mnC); for (int r = 0; r < 16; ++r) p1[r] = fmaf(p1[r], C, mnC);
  for (int r = 0; r < 16; ++r) p0[r] = __builtin_amdgcn_exp2f(p0[r]);
}
__device__ __forceinline__ void finishSM(f32x16& p0, f32x16& p1, float alpha, float& l_reg, bf16x8& pa0, bf16x8& pa1, bf16x8& pa2, bf16x8& pa3) {
  for (int r = 0; r < 16; ++r) p1[r] = __builtin_amdgcn_exp2f(p1[r]);
  float ps = 0; for (int r = 0; r < 16; ++r) ps += p0[r]; for (int r = 0; r < 16; ++r) ps += p1[r];
  { auto rr = __builtin_amdgcn_permlane32_swap(__float_as_uint(ps), __float_as_uint(ps), false, false);
    ps = __uint_as_float(rr[0]) + __uint_as_float(rr[1]); }
  l_reg = l_reg * alpha + ps;
#define PK4(P, BASE, OUT) do { unsigned a0 = cvtpk(P[BASE + 0], P[BASE + 1]), a1 = cvtpk(P[BASE + 2], P[BASE + 3]);   \
    unsigned b0 = cvtpk(P[BASE + 4], P[BASE + 5]), b1 = cvtpk(P[BASE + 6], P[BASE + 7]);                              \
    auto r0 = __builtin_amdgcn_permlane32_swap(a0, b0, false, false); auto r1 = __builtin_amdgcn_permlane32_swap(a1, b1, false, false); \
    u32x4 w = {r0[0], r1[0], r0[1], r1[1]}; OUT = *reinterpret_cast<bf16x8*>(&w); } while (0)
  PK4(p0, 0, pa0); PK4(p0, 8, pa1); PK4(p1, 0, pa2); PK4(p1, 8, pa3);
#undef PK4
}
__device__ __forceinline__ void qkt(f32x16& p0, f32x16& p1, const bf16* Ks, const bf16x8* qr, int r32, int hi) {
  p0 = f32x16{}; p1 = f32x16{};
  for (int d0 = 0; d0 < 8; ++d0) { int cb = (d0 * 16 + hi * 8) * 2;
    bf16x8 b0 = *reinterpret_cast<const bf16x8*>((const char*)Ks + KSWZ(r32, cb));
    bf16x8 b1 = *reinterpret_cast<const bf16x8*>((const char*)Ks + KSWZ(32 + r32, cb));
    p0 = __builtin_amdgcn_mfma_f32_32x32x16_bf16(b0, qr[d0], p0, 0, 0, 0);
    p1 = __builtin_amdgcn_mfma_f32_32x32x16_bf16(b1, qr[d0], p1, 0, 0, 0); }
}
__device__ __forceinline__ void bandmask(f32x16& p0, f32x16& p1, int dk0, int hi) {
#pragma unroll
  for (int r = 0; r < 16; ++r) { const int dk = dk0 + crow(r, hi);
    if (dk < -128 || dk > 128) p0[r] = -1e30f;
    if (dk + 32 < -128 || dk + 32 > 128) p1[r] = -1e30f; }
}
__device__ __forceinline__ int v_st(int k, int c) { const int kk = (k & ~0xC) | ((k & 4) << 1) | ((k & 8) >> 1); return ((kk >> 3) * 4 + (c >> 5)) * 512 + ((kk & 7) * 32 + (c & 31)) * 2; }
__device__ __forceinline__ int v_rd_base(int lane) { return ((lane & 3) << 3) | (((lane >> 2) & 3) << 6) | (((lane >> 4) & 1) << 5) | (((lane >> 5) & 1) << 8); }
constexpr int v_rd_off(int d0, int ks, int half) { return d0 * 512 + ks * 4096 + half * 2048; }
template <int OFF> __device__ __forceinline__ s16x4 tr_read(int vb) {
  s16x4 r; asm volatile("ds_read_b64_tr_b16 %0, %1 offset:%2" : "=&v"(r) : "v"(vb), "i"(OFF) : "memory"); return r;
}
template <int D0> __device__ __forceinline__ void pv_one(f32x16& od, int vb, bf16x8 pa0, bf16x8 pa1, bf16x8 pa2, bf16x8 pa3) {
  const s16x4 l0 = tr_read<v_rd_off(D0, 0, 0)>(vb), h0 = tr_read<v_rd_off(D0, 0, 1)>(vb), l1 = tr_read<v_rd_off(D0, 1, 0)>(vb), h1 = tr_read<v_rd_off(D0, 1, 1)>(vb);
  const s16x4 l2 = tr_read<v_rd_off(D0, 2, 0)>(vb), h2 = tr_read<v_rd_off(D0, 2, 1)>(vb), l3 = tr_read<v_rd_off(D0, 3, 0)>(vb), h3 = tr_read<v_rd_off(D0, 3, 1)>(vb);
  asm volatile("s_waitcnt lgkmcnt(0)" ::: "memory"); SBAR();
#define PK(L, H) (bf16x8){L[0], L[1], L[2], L[3], H[0], H[1], H[2], H[3]}
  od = __builtin_amdgcn_mfma_f32_32x32x16_bf16(pa0, PK(l0, h0), od, 0, 0, 0);
  od = __builtin_amdgcn_mfma_f32_32x32x16_bf16(pa1, PK(l1, h1), od, 0, 0, 0);
  od = __builtin_amdgcn_mfma_f32_32x32x16_bf16(pa2, PK(l2, h2), od, 0, 0, 0);
  od = __builtin_amdgcn_mfma_f32_32x32x16_bf16(pa3, PK(l3, h3), od, 0, 0, 0);
#undef PK
}
__device__ __forceinline__ void pv_d0(f32x16* o, int vb, bf16x8 pa0, bf16x8 pa1, bf16x8 pa2, bf16x8 pa3) {
  pv_one<0>(o[0], vb, pa0, pa1, pa2, pa3); pv_one<1>(o[1], vb, pa0, pa1, pa2, pa3); pv_one<2>(o[2], vb, pa0, pa1, pa2, pa3); pv_one<3>(o[3], vb, pa0, pa1, pa2, pa3);
}

__device__ __forceinline__ void attn_unit(const bf16* __restrict__ Qb, const bf16* __restrict__ K0, const bf16* __restrict__ V0, int n0,
                                          const bf16* __restrict__ K1, const bf16* __restrict__ V1, int n1, int dq0, float sinkl2,
                                          bf16* __restrict__ Ob, char* lds) {
  int tid_l = threadIdx.x; asm volatile("" : "+v"(tid_l));
  const int tid = tid_l, wid = tid >> 6, lane = tid & 63, r32 = lane & 31, hi = lane >> 5;
  bf16* V_lds = (bf16*)lds; bf16* K_lds = (bf16*)(lds + 2 * SHM_V);
  float* ws = (float*)(lds + 2 * SHM_V + 2 * SHM_K) + wid * 64; float* li_l = ws; float* al_l = ws + 32;
  float m_reg = -1e30f, l_reg = 0; f32x16 o[4] = {}; bf16x8 qr[8];
  const bf16* Qw = Qb + (long)(wid * QBLK + r32) * LDQ + hi * 8;
#pragma unroll
  for (int d0 = 0; d0 < 8; ++d0) qr[d0] = *reinterpret_cast<const bf16x8*>(Qw + d0 * 16);
  const int sr = tid >> 4, sc = (tid & 15) * 8, vst0 = v_st(sr, sc), vst1 = v_st(32 + sr, sc);
  const int vb0 = (int)(uintptr_t)V_lds + v_rd_base(lane);
  const int dql = dq0 - (wid * QBLK + r32);
  struct { bf16x8 vs0, vs1, ks0, ks1; } sr_[2];
#define SLOAD(i, j) do { const int j_ = (j); const bf16* kt_ = j_ < n0 ? K0 + (long)j_ * (KVBLK * LDK) : K1 + (long)(j_ - n0) * (KVBLK * LDK); \
    const bf16* vt_ = j_ < n0 ? V0 + (long)j_ * (KVBLK * LDK) : V1 + (long)(j_ - n0) * (KVBLK * LDK); \
    sr_[i].vs0 = *reinterpret_cast<const bf16x8*>(&vt_[(long)sr * LDK + sc]); sr_[i].vs1 = *reinterpret_cast<const bf16x8*>(&vt_[(long)(32 + sr) * LDK + sc]); \
    sr_[i].ks0 = *reinterpret_cast<const bf16x8*>(&kt_[(long)sr * LDK + sc]); sr_[i].ks1 = *reinterpret_cast<const bf16x8*>(&kt_[(long)(32 + sr) * LDK + sc]); } while (0)
#define SWRITE(b, i) do { *(bf16x8*)((char*)V_lds + (b) * SHM_V + vst0) = sr_[i].vs0;          \
    *(bf16x8*)((char*)V_lds + (b) * SHM_V + vst1) = sr_[i].vs1; int kc = sc * 2;               \
    *(bf16x8*)((char*)K_lds + (b) * SHM_K + KSWZ(sr, kc)) = sr_[i].ks0;                       \
    *(bf16x8*)((char*)K_lds + (b) * SHM_K + KSWZ(32 + sr, kc)) = sr_[i].ks1; } while (0)
#define SWAIT() asm volatile("s_waitcnt vmcnt(4)" ::: "memory")
#define RESC(a) do { if (__any((a) < 1.f)) { if (hi == 0) al_l[r32] = (a); asm volatile("s_waitcnt lgkmcnt(0)" ::: "memory"); \
    for (int d = 0; d < 4; ++d) for (int r = 0; r < 16; ++r) o[d][r] *= al_l[crow(r, hi)]; } } while (0)
#define MASK(P0, P1, j) do { if ((j) >= n0) bandmask(P0, P1, dql + 64 * ((j) - n0), hi); } while (0)
  f32x16 pA0, pA1, pB0, pB1; float mnA, mnB, alA, alB; bf16x8 pa0, pa1, pa2, pa3; const int NT = n0 + n1;
  constexpr int SE = 0, SO = 1;
  SLOAD(SE, 0); SLOAD(SO, 1);
  asm volatile("s_waitcnt vmcnt(4)" ::: "memory"); SWRITE(0, SE); __syncthreads();
  qkt(pA0, pA1, K_lds, qr, r32, hi); partialSM(pA0, pA1, m_reg, mnA, alA);
  if (2 < NT) SLOAD(SE, 2);
  SWAIT(); SWRITE(1, SO); __syncthreads();
  for (int j = 1; j + 1 < NT; j += 2) {
    SBAR(); qkt(pB0, pB1, (bf16*)((char*)K_lds + SHM_K), qr, r32, hi); MASK(pB0, pB1, j);
    finishSM(pA0, pA1, alA, l_reg, pa0, pa1, pa2, pa3); SBAR();
    SLOAD(SO, j + 2); SBAR();
    pv_d0(o, vb0, pa0, pa1, pa2, pa3); partialSM(pB0, pB1, m_reg, mnB, alB);
    __syncthreads(); SWAIT(); SWRITE(0, SE);
    RESC(alB); __syncthreads();
    SBAR(); qkt(pA0, pA1, K_lds, qr, r32, hi); MASK(pA0, pA1, j + 1);
    finishSM(pB0, pB1, alB, l_reg, pa0, pa1, pa2, pa3); SBAR();
    if (j + 3 < NT) SLOAD(SE, j + 3); SBAR();
    pv_d0(o, vb0 + (int)SHM_V, pa0, pa1, pa2, pa3); partialSM(pA0, pA1, m_reg, mnA, alA);
    __syncthreads(); SWAIT(); SWRITE(1, SO);
    RESC(alA); __syncthreads();
  }
  SBAR(); qkt(pB0, pB1, (bf16*)((char*)K_lds + SHM_K), qr, r32, hi); MASK(pB0, pB1, NT - 1);
  finishSM(pA0, pA1, alA, l_reg, pa0, pa1, pa2, pa3); SBAR();
  pv_d0(o, vb0, pa0, pa1, pa2, pa3); partialSM(pB0, pB1, m_reg, mnB, alB);
  __syncthreads(); RESC(alB);
  finishSM(pB0, pB1, alB, l_reg, pa0, pa1, pa2, pa3); SBAR();
  pv_d0(o, vb0 + (int)SHM_V, pa0, pa1, pa2, pa3);
  l_reg += __builtin_amdgcn_exp2f(sinkl2 - m_reg * (SCALE * 1.4426950408889634f));
  if (hi == 0) li_l[r32] = l_reg; asm volatile("s_waitcnt lgkmcnt(0)" ::: "memory");
  float rli[16];
#pragma unroll
  for (int r = 0; r < 16; ++r) rli[r] = __builtin_amdgcn_rcpf(li_l[crow(r, hi)]);
  asm volatile("" ::: "memory");
  { char* stg = lds + 69632 + wid * 8192;
#pragma unroll
    for (int r = 0; r < 16; ++r) { const int orow = crow(r, hi);
#pragma unroll
      for (int d0 = 0; d0 < 4; ++d0) { const float v = o[d0][r] * rli[r]; *(bf16*)(stg + orow * 256 + (d0 * 32 + r32) * 2) = (bf16)cvtpk(v, v); } }
    asm volatile("s_waitcnt lgkmcnt(0)" ::: "memory");
    bf16* Ow = Ob + (long)(wid * QBLK) * LDO;
#pragma unroll
    for (int i = 0; i < 8; ++i) { const int row = i * 4 + (lane >> 4), ch = lane & 15; const u32x4 v = *(const u32x4*)(stg + row * 256 + ch * 16); *(u32x4*)(Ow + (long)row * LDO + ch * 8) = v; } }
  __syncthreads();
#undef SLOAD
#undef SWRITE
#undef SWAIT
#undef RESC
#undef MASK
}
#undef KSWZ
#undef SBAR
}

#define LAS __attribute__((address_space(3)))
typedef unsigned short bf16_t;
typedef unsigned v4u __attribute__((ext_vector_type(4)));
typedef float f32x4 __attribute__((ext_vector_type(4)));
typedef float f32x16 __attribute__((ext_vector_type(16)));
typedef short bf16x8 __attribute__((ext_vector_type(8)));
using pg8::bf2f; using pg8::dim_of_pos; using pg8::pos_of_dim;

constexpr int NL = 4, NINW = 5632, DFF = 4096, NMOD6 = 6144;
constexpr int NTOK = 16384, NCTX = 8192;
constexpr size_t MiB = 1u << 20;
constexpr size_t WS_CTL = 0, WS_MOD = 1 * MiB, WS_ROPE = 2 * MiB, WS_WIN = 3 * MiB, WS_WCAT = 47 * MiB, WS_WOUT = 63 * MiB, WS_W1 = 71 * MiB, WS_W2 = 103 * MiB,
                 WS_CK = 135 * MiB, WS_CV = 139 * MiB, WS_H = 143 * MiB, WS_Q = 175 * MiB, WS_KB = 207 * MiB, WS_VB = 215 * MiB, WS_XR = 223 * MiB, WS_G = 255 * MiB,
                 WS_ACAT = 319 * MiB, WS_PF = 383 * MiB, WS_PB = 399 * MiB, WS_SSQ = 415 * MiB, WS_SWIN = 416 * MiB, WS_SWUP = 416 * MiB + 512 * 1024, WS_WMOD = 417 * MiB, WS_X16 = 418 * MiB, WS_WFR = 450 * MiB, WS_END = 454 * MiB, WS_TOT = 512 * 1024, WS_U = WS_Q, WS_MERGED = WS_Q;
constexpr size_t OUT_K = 16777216, OUT_V = 25165824, OUT_S = 33554432;
constexpr int RING_BYTES = 131072, RED_OFF = 131072, MISC_OFF = RED_OFF + 8192, LDS_BYTES = 147456;
constexpr int CW_DONE = 1024;
constexpr int CW_QUEUE = 64;

#define XB_TMO      128
#define XB_XCNT(j)  (256  + 64 * (j))
#define XB_XSUB(j)  (1280 + 64 * (j))
#define XB_XGEN(j)  (2304 + 64 * (j))
#define XB_TOP      3328
#define XB_TOPGEN   3392
#define XCD_BAR_WORDS 3456
#define XB_SPIN_CAP (1u << 18)

__device__ __forceinline__ unsigned xb_ld(unsigned* p)              { return __hip_atomic_load(p, __ATOMIC_RELAXED, __HIP_MEMORY_SCOPE_AGENT); }
__device__ __forceinline__ unsigned xb_add(unsigned* p, unsigned v) { return __hip_atomic_fetch_add(p, v, __ATOMIC_RELAXED, __HIP_MEMORY_SCOPE_AGENT); }
__device__ __forceinline__ unsigned xb_xcc_id() { return (unsigned)__builtin_amdgcn_s_getreg((3 << 11) | 20) & 0xFu; }
#define XB_SPIN(cond, bar) do { unsigned _sp = 0; while (cond) { __builtin_amdgcn_s_sleep(1); \
    if ((++_sp & 255u) == 0u) { if (xb_ld(&(bar)[XB_TMO])) break; if (_sp > XB_SPIN_CAP) { atomicAdd(&(bar)[XB_TMO], 1u); break; } } } } while (0)

struct XcdBarrier {
    unsigned* bar; unsigned x;
    volatile LAS unsigned* st;
};

__device__ __forceinline__ XcdBarrier xcd_barrier_post(unsigned* bar, volatile LAS unsigned* st) {
    XcdBarrier b; b.bar = bar; b.x = xb_xcc_id(); b.st = st;
    if (threadIdx.x == 0) (void)xb_add(&bar[XB_XCNT(b.x)], 1u);
    return b;
}
__device__ __forceinline__ void xcd_barrier_complete(unsigned* bar, unsigned x, unsigned& nloc, unsigned& nx) {
    const unsigned G = gridDim.x * gridDim.y * gridDim.z;
    unsigned sum, cnt, mine, sp = 0u;
    for (;;) {
        sum = 0u; cnt = 0u; mine = 0u;
#pragma unroll
        for (unsigned j = 0; j < 16; ++j) { const unsigned c = xb_ld(&bar[XB_XCNT(j)]); sum += c; cnt += (c > 0u) ? 1u : 0u; mine = (j == x) ? c : mine; }
        if (sum == G) break;
        __builtin_amdgcn_s_sleep(1);
        if ((++sp & 255u) == 0u) { if (xb_ld(&bar[XB_TMO])) break; if (sp > XB_SPIN_CAP) { atomicAdd(&bar[XB_TMO], 1u); break; } }
    }
    nloc = mine > 0u ? mine : 1u; nx = cnt > 0u ? cnt : 1u;
}

__device__ __forceinline__ void xcd_barrier(const XcdBarrier& b) {
    asm volatile("s_waitcnt vmcnt(0)" ::: "memory");
    __syncthreads();
    if (threadIdx.x == 0) {
        unsigned* bar = b.bar;
        __builtin_amdgcn_s_waitcnt(0);
        unsigned nloc = b.st[0], nx = b.st[1];
        if (nloc == 0u) { xcd_barrier_complete(bar, b.x, nloc, nx); b.st[0] = nloc; b.st[1] = nx; }
        const unsigned old = xb_add(&bar[XB_XSUB(b.x)], 1u);
        const unsigned gen = old / nloc;
        if (old + 1u == (gen + 1u) * nloc) {
            __builtin_amdgcn_fence(__ATOMIC_RELEASE, "agent");
            asm volatile("s_waitcnt vmcnt(0)" ::: "memory");
            const unsigned og = xb_add(&bar[XB_TOP], 1u);
            const unsigned tg = og / nx;
            if (og + 1u == (tg + 1u) * nx) xb_add(&bar[XB_TOPGEN], 1u);
            else XB_SPIN(xb_ld(&bar[XB_TOPGEN]) == tg, bar);
            __builtin_amdgcn_fence(__ATOMIC_ACQUIRE, "agent");
            xb_add(&bar[XB_XGEN(b.x)], 1u);
            asm volatile("s_waitcnt vmcnt(0)" ::: "memory");
        } else {
            XB_SPIN(xb_ld(&bar[XB_XGEN(b.x)]) == gen, bar);
            __builtin_amdgcn_fence(__ATOMIC_ACQUIRE, "agent");
            asm volatile("s_waitcnt vmcnt(0)" ::: "memory");
        }
    }
    __syncthreads();
}

constexpr int CW_BAR = 4096;

__device__ __forceinline__ int opaque_bid() { int b = blockIdx.x; asm volatile("" : "+s"(b)); return b; }
#ifndef XREP_MIX
#define XREP_MIX 1
#endif
struct OneUnit { int pm, pn;
    __device__ __forceinline__ bool next(int i, pg8::Unit& u) const { if (i != 0) return false; u.pm = pm; u.pn = pn; return true; }
    __device__ __forceinline__ void a_ready(const pg8::Unit&) const {}
    __device__ __forceinline__ void done(const pg8::Unit&) const {} };
struct Params { const float* in[27]; float* out; unsigned char* ws; int ph_lo, ph_hi; };

__device__ __forceinline__ unsigned f2bf(float f) { unsigned u = __builtin_bit_cast(unsigned, f); return (u + 0x7fffu + ((u >> 16) & 1u)) >> 16; }
__device__ __forceinline__ unsigned pk2(float lo, float hi) { return att::cvtpk(lo, hi); }
__device__ __forceinline__ unsigned short f2bfh(float x) { return (unsigned short)att::cvtpk(x, x); }
__device__ __forceinline__ float wave_sum(float v) {
#pragma unroll
    for (int o = 1; o < 64; o <<= 1) v += __shfl_xor(v, o);
    return v;
}

template <bool PERMQK>
__device__ __forceinline__ void tr_item(const float* W, int K, int N, bf16_t* WT, int ldk, int koff, LAS float* scr, int item, int lane) {
    const int nblk = N / 32, kb = item / nblk, nb = item % nblk, k0 = 64 * kb, n0 = 32 * nb;
    float tv[32];
#pragma unroll
    for (int i = 0; i < 32; ++i) { const int kk = 2 * i + (lane >> 5); tv[i] = __builtin_nontemporal_load(&W[(size_t)(k0 + kk) * N + n0 + (lane & 31)]); }
#pragma unroll
    for (int i = 0; i < 32; ++i) { const int kk = 2 * i + (lane >> 5); scr[kk * 33 + (lane & 31)] = tv[i]; }
    asm volatile("s_waitcnt lgkmcnt(0)" ::: "memory");
    const int c = lane & 7;
#pragma unroll
    for (int j = 0; j < 4; ++j) { const int n = (lane >> 3) + 8 * j; const LAS float* s = scr + (8 * c) * 33 + n;
        v4u o; o.x = pk2(s[0 * 33], s[1 * 33]); o.y = pk2(s[2 * 33], s[3 * 33]); o.z = pk2(s[4 * 33], s[5 * 33]); o.w = pk2(s[6 * 33], s[7 * 33]);
        int nn = n0 + n; if (PERMQK && nn < 1280) nn = (nn & ~127) | pos_of_dim(nn & 127);
        *(v4u*)(WT + (size_t)nn * ldk + koff + k0 + 8 * c) = o; }
    asm volatile("s_waitcnt lgkmcnt(0)" ::: "memory");
}

__device__ __forceinline__ void norm_row(const float* xrow, const float* nw, const float* sh, const float* sc, bf16_t* orow, int lane) {
    const f32x4* xr = (const f32x4*)xrow + lane;
    f32x4 v[4]; float s = 0.f;
#pragma unroll
    for (int j = 0; j < 4; ++j) { v[j] = xr[64 * j]; s += (v[j][0] * v[j][0] + v[j][1] * v[j][1]) + (v[j][2] * v[j][2] + v[j][3] * v[j][3]); }
    const float rstd = __builtin_amdgcn_rsqf(wave_sum(s) * (1.f / 1024.f) + 1e-6f);
    unsigned long long* o8 = (unsigned long long*)orow + lane;
#pragma unroll
    for (int j = 0; j < 4; ++j) { const f32x4 w = ((const f32x4*)nw)[lane + 64 * j], a = ((const f32x4*)sc)[lane + 64 * j], b = ((const f32x4*)sh)[lane + 64 * j];
        const f32x4 y = v[j] * rstd * w * (1.0f + a) + b;
        o8[64 * j] = (unsigned long long)pk2(y[0], y[1]) | ((unsigned long long)pk2(y[2], y[3]) << 32); }
}
__device__ __forceinline__ void norm_phase(const Params& P, int layer, int which  , bool first) {
    int tid_l = threadIdx.x; asm volatile("" : "+v"(tid_l));
    const int lane = tid_l & 63, wave = tid_l >> 6, gw = blockIdx.x * 8 + wave, NGW = gridDim.x * 8;
    const float* mod = (const float*)(P.ws + WS_MOD) + (size_t)layer * 5 * NMOD6 + which * 3072;
    const float* nw = P.in[which ? 10 : 9] + layer * 1024;
#define RS_RESET() do { __syncthreads(); if (threadIdx.x == 0) ((LAS int*)(lds + RED_OFF))[2048 + 64 + 256] = -1; __syncthreads(); } while (0)
    bf16_t* H = (bf16_t*)(P.ws + WS_H);
    for (int row = gw; row < NTOK; row += NGW) {
        const int cond = row < NCTX ? 0 : 1 + ((row - NCTX) >> 11);
        const float* x = first ? (row < NCTX ? P.in[0] + (size_t)row * 1024 : P.in[1] + (size_t)(row - NCTX) * 1024) : P.out + (size_t)row * 1024;
        norm_row(x, nw, mod + cond * NMOD6, mod + cond * NMOD6 + 1024, H + (size_t)row * 1024, lane);
    }
}

__device__ __forceinline__ void prep_phase(const Params& P, LAS unsigned char* lds) {
    int tid_l = threadIdx.x; asm volatile("" : "+v"(tid_l));
    const int tid = tid_l, lane = tid & 63, wave = tid >> 6, G = gridDim.x, gw = blockIdx.x * 8 + wave, NGW = G * 8;
    const float* MOD = (const float*)(P.ws + WS_MOD);
    for (int i = blockIdx.x * 512 + tid; i < NL * 2 * 5 * 1024; i += G * 512) {
        const int c = i & 1023, cond = (i >> 10) % 5, w = ((i >> 10) / 5) & 1, l = (i >> 10) / 10;
        ((float*)(P.ws + WS_WMOD))[i] = P.in[w ? 10 : 9][l * 1024 + c] * (1.0f + MOD[(size_t)(l * 5 + cond) * NMOD6 + (w ? 4 : 1) * 1024 + c]);
    }
    {
        const int r32 = lane & 31, hi = lane >> 5;
        constexpr int T_IN = NINW / 32, T_UP = DFF / 32, T_L = T_IN + T_UP;
        for (int tix = gw; tix < NL * T_L; tix += NGW) {
            const int l = tix / T_L, r = tix % T_L, w = r >= T_IN, n0 = 32 * (w ? r - T_IN : r), N = w ? DFF : NINW;
            const bf16_t* Wt = (w ? (const bf16_t*)(P.ws + WS_W1) + (size_t)l * DFF * 1024 : (const bf16_t*)(P.ws + WS_WIN) + (size_t)l * NINW * 1024) + (size_t)(n0 + r32) * 1024 + 8 * hi;
            const float* shp = MOD + (size_t)(l * 5 + (r32 < 5 ? r32 : 0)) * NMOD6 + (w ? 3 : 0) * 1024 + 8 * hi;
            f32x16 acc = {};
#pragma unroll 8
            for (int ks = 0; ks < 64; ++ks) {
                const bf16x8 bfr = *(const bf16x8*)(Wt + 16 * ks);
                bf16x8 afr = {0, 0, 0, 0, 0, 0, 0, 0};
                if (r32 < 5) { const f32x4 s0 = *(const f32x4*)(shp + 16 * ks), s1 = *(const f32x4*)(shp + 16 * ks + 4);
                    v4u t; t.x = pk2(s0[0], s0[1]); t.y = pk2(s0[2], s0[3]); t.z = pk2(s1[0], s1[1]); t.w = pk2(s1[2], s1[3]); afr = __builtin_bit_cast(bf16x8, t); }
                acc = __builtin_amdgcn_mfma_f32_32x32x16_bf16(afr, bfr, acc, 0, 0, 0);
            }
            float* SW = w ? (float*)(P.ws + WS_SWUP) + (size_t)l * 5 * DFF : (float*)(P.ws + WS_SWIN) + (size_t)l * 5 * NINW;
            if (hi == 0) { SW[(size_t)0 * N + n0 + r32] = acc[0]; SW[(size_t)1 * N + n0 + r32] = acc[1]; SW[(size_t)2 * N + n0 + r32] = acc[2]; SW[(size_t)3 * N + n0 + r32] = acc[3]; }
            else SW[(size_t)4 * N + n0 + r32] = acc[0];
        }
    }
    bf16_t* H = (bf16_t*)(P.ws + WS_H); float* SSQ = (float*)(P.ws + WS_SSQ);
    for (int row = gw; row < NTOK; row += NGW) {
        const int cond = row < NCTX ? 0 : 1 + ((row - NCTX) >> 11);
        const float* x = row < NCTX ? P.in[0] + (size_t)row * 1024 : P.in[1] + (size_t)(row - NCTX) * 1024;
        const f32x4* xr = (const f32x4*)x + lane; const f32x4* nw = (const f32x4*)P.in[9] + lane; const f32x4* sc = (const f32x4*)(MOD + (size_t)cond * NMOD6 + 1024) + lane;
        unsigned long long* o8 = (unsigned long long*)(H + (size_t)row * 1024) + lane;
        float s = 0.f;
#pragma unroll
        for (int j = 0; j < 4; ++j) { const f32x4 v = xr[64 * j]; s += (v[0] * v[0] + v[1] * v[1]) + (v[2] * v[2] + v[3] * v[3]);
            const f32x4 y = v * nw[64 * j] * (1.0f + sc[64 * j]);
            o8[64 * j] = (unsigned long long)pk2(y[0], y[1]) | ((unsigned long long)pk2(y[2], y[3]) << 32); }
        s = wave_sum(s);
        if (lane < 16) SSQ[(size_t)row * 16 + lane] = lane == 0 ? s : 0.f;
    }
}

__device__ __forceinline__ void prologue(const Params& P, LAS unsigned char* lds) {
    int tid_l = threadIdx.x; asm volatile("" : "+v"(tid_l));
    const int tid = tid_l, lane = tid & 63, wave = tid >> 6, G = gridDim.x;
    const int gw = blockIdx.x * 8 + wave, NGW = G * 8;
    LAS float* scr = (LAS float*)(lds + wave * 16384);
    constexpr int I_IN = 16 * 176, I_O = 16 * 32, I_1 = 16 * 128, I_2 = 64 * 32, I_L = I_IN + 3 * I_O + I_1 + I_2;
    for (int it = gw; it < NL * I_L; it += NGW) {
        const int l = it / I_L; int r = it % I_L;
        if (r < I_IN) { tr_item<true>(P.in[11] + (size_t)l * 1024 * NINW, 1024, NINW, (bf16_t*)(P.ws + WS_WIN) + (size_t)l * NINW * 1024, 1024, 0, scr, r, lane); continue; } r -= I_IN;
        if (r < I_O) { tr_item<false>(P.in[22] + (size_t)l * 1024 * 1024, 1024, 1024, (bf16_t*)(P.ws + WS_WCAT) + (size_t)l * 1024 * 2048, 2048, 0, scr, r, lane); continue; } r -= I_O;
        if (r < I_O) { tr_item<false>(P.in[23] + (size_t)l * 1024 * 1024, 1024, 1024, (bf16_t*)(P.ws + WS_WCAT) + (size_t)l * 1024 * 2048, 2048, 1024, scr, r, lane); continue; } r -= I_O;
        if (r < I_O) { tr_item<false>(P.in[24] + (size_t)l * 1024 * 1024, 1024, 1024, (bf16_t*)(P.ws + WS_WOUT) + (size_t)l * 1024 * 1024, 1024, 0, scr, r, lane); continue; } r -= I_O;
        if (r < I_1) { tr_item<false>(P.in[25] + (size_t)l * 1024 * DFF, 1024, DFF, (bf16_t*)(P.ws + WS_W1) + (size_t)l * DFF * 1024, 1024, 0, scr, r, lane); continue; } r -= I_1;
        tr_item<false>(P.in[26] + (size_t)l * DFF * 1024, DFF, 1024, (bf16_t*)(P.ws + WS_W2) + (size_t)l * 1024 * DFF, DFF, 0, scr, r, lane);
    }
    __syncthreads();
    {
        LAS float* sv = (LAS float*)lds; LAS float* rb = (LAS float*)(lds + 20480);
        for (int i = tid; i < 5120; i += 512) { const int cond = i >> 10, k = i & 1023; const float x = cond == 0 ? P.in[6][k] : P.in[5][(cond - 1) * 1024 + k]; sv[i] = x * __builtin_amdgcn_rcpf(1.0f + __expf(-x)); }
        __syncthreads();
        for (int it = blockIdx.x; it < NL * 96; it += G) {
            const int l = it / 96, cg_ = it % 96;
            const float* W = P.in[7] + ((size_t)l * 1024 + wave * 128) * NMOD6 + cg_ * 64 + lane;
            float a0 = 0.f, a1 = 0.f, a2 = 0.f, a3 = 0.f, a4 = 0.f;
#pragma unroll 16
            for (int k = 0; k < 128; ++k) { const float w = __builtin_nontemporal_load(&W[(size_t)k * NMOD6]); const int kk = wave * 128 + k;
                a0 += sv[kk] * w; a1 += sv[1024 + kk] * w; a2 += sv[2048 + kk] * w; a3 += sv[3072 + kk] * w; a4 += sv[4096 + kk] * w; }
            rb[(wave * 5 + 0) * 64 + lane] = a0; rb[(wave * 5 + 1) * 64 + lane] = a1; rb[(wave * 5 + 2) * 64 + lane] = a2; rb[(wave * 5 + 3) * 64 + lane] = a3; rb[(wave * 5 + 4) * 64 + lane] = a4;
            __syncthreads();
            if (tid < 320) { const int cond = tid >> 6; float s = 0.f;
#pragma unroll
                for (int w = 0; w < 8; ++w) s += rb[(w * 5 + cond) * 64 + lane];
                s += P.in[8][l * NMOD6 + cg_ * 64 + lane];
                ((float*)(P.ws + WS_MOD))[(size_t)(l * 5 + cond) * NMOD6 + cg_ * 64 + lane] = s; }
            __syncthreads();
        }
    }
    const int gt = blockIdx.x * 512 + tid, NGT = G * 512;
#ifdef NANFILL
    { v4u nanv = {0x7FC07FC0u, 0x7FC07FC0u, 0x7FC07FC0u, 0x7FC07FC0u};
      v4u* a = (v4u*)(P.ws + WS_H); const size_t na = (WS_END - WS_H) / 16;
      for (size_t i = gt; i < na; i += NGT) a[i] = nanv;
      v4u* o = (v4u*)P.out; const size_t no = (size_t)(33554432 + 262144) / 4;
      for (size_t i = gt; i < no; i += NGT) o[i] = nanv; }
#endif
    for (int i = gt; i < 4 * 4 * 512 * 256 / 2; i += NGT) {
        const int e = 2 * i, p = e & 127, base = e & ~127;
        const float* ck = P.in[2] + base;
        ((unsigned*)(P.ws + WS_CK))[i] = pk2(ck[dim_of_pos(p)], ck[dim_of_pos(p + 1)]);
        ((unsigned*)(P.ws + WS_CV))[i] = pk2(P.in[3][e], P.in[3][e + 1]);
    }
    for (int i = gt; i < NL * 2 * 8 * 2 * 4 * 8 * 64; i += NGT) {
        const int ln = i & 63, ks = (i >> 6) & 7, w4 = (i >> 9) & 3, gate = (i >> 11) & 1, nb = (i >> 12) & 7, dr = (i >> 15) & 1, l = i >> 16;
        const float* W = (gate ? P.in[20] : P.in[18]) + ((size_t)((l * 2 + dr) * 8 + nb) * 128) * 128 + w4 * 32 + (ln & 31);
        float v[8];
#pragma unroll
        for (int j = 0; j < 8; ++j) v[j] = W[(16 * ks + 8 * (ln >> 5) + j) * 128];
        v4u o; o.x = pk2(v[0], v[1]); o.y = pk2(v[2], v[3]); o.z = pk2(v[4], v[5]); o.w = pk2(v[6], v[7]);
        ((v4u*)(P.ws + WS_WFR))[i] = o;
    }
    for (int i = gt; i < 2048 * 64; i += NGT) {
        const int t = i >> 6, pi = i & 63, ax = pi >> 5, fi = pi & 31;
        const float freq = powf(10000.0f, -(float)(2 * fi) / 64.0f);
        const float ang = (float)(ax == 0 ? (t >> 6) : (t & 63)) * freq;
        float* o = (float*)(P.ws + WS_ROPE) + (size_t)i * 2; o[0] = cosf(ang); o[1] = sinf(ang);
    }
}

__device__ __forceinline__ int crow16(int r, int hi) { return (r & 3) + 8 * (r >> 2) + 4 * hi; }
__device__ __forceinline__ float partner32(float x, int hi) { auto rr = __builtin_amdgcn_permlane32_swap(__float_as_uint(x), __float_as_uint(x), false, false); return __uint_as_float(hi ? rr[0] : rr[1]); }
__device__ __forceinline__ void lru_unit(const Params& P, int layer, int latent, int b, int seg, int nblk, LAS unsigned char* lds) {
    int tid_l = threadIdx.x; asm volatile("" : "+v"(tid_l));
    const int tid = tid_l, lane = tid & 63, r32 = lane & 31, hi = lane >> 5;
    const int wid = __builtin_amdgcn_readfirstlane(tid >> 6), dir = wid >> 2, w4 = wid & 3, gt = tid & 255;
    constexpr int nch = 8;
    const int Tseq = latent ? 2048 : 256, t0seg = seg * 256;
    const int rowseq = latent ? NCTX + b * 2048 : b * 256, rowbase = rowseq + t0seg;
    const int chl = w4 * 32 + r32, ch = nblk * 128 + chl;
    constexpr int TILEB = 32 * 272;
    LAS unsigned char* tiles = lds;
    LAS float* cw = (LAS float*)(lds + 8 * TILEB);
    const bf16_t* XR = (const bf16_t*)(P.ws + WS_XR);
    bf16_t* HT = ((bf16_t*)P.out + (size_t)16777216);
    bf16_t* ACAT = (bf16_t*)(P.ws + WS_ACAT);
    bf16_t* PD = (bf16_t*)(P.ws + (dir ? WS_PB : WS_PF));
    for (int i = tid; i < 640; i += 512) cw[i] = (i < 512) ? P.in[15][((size_t)layer * 4 + (i >> 7)) * 1024 + nblk * 128 + (i & 127)] : P.in[16][layer * 1024 + nblk * 128 + (i & 127)];
    bf16x8 bR[8], bI0;
    LAS unsigned char* wib = lds + 72704 + wid * 7168 + lane * 16;
    {
        const v4u* fr = (const v4u*)(P.ws + WS_WFR) + ((size_t)(((layer * 2 + dir) * 8 + nblk) * 2) * 4 + w4) * 512 + lane;
#pragma unroll
        for (int ks = 0; ks < 8; ++ks) { const v4u a = fr[ks * 64], g = fr[2048 + ks * 64];
            bR[ks] = __builtin_bit_cast(bf16x8, a); if (ks == 0) bI0 = __builtin_bit_cast(bf16x8, g); else *(LAS v4u*)(wib + (ks - 1) * 1024) = g; }
    }
    const float ba = P.in[19][(layer * 2 + dir) * 1024 + ch], bi = P.in[21][(layer * 2 + dir) * 1024 + ch];
    const float lam = P.in[17][(layer * 2 + dir) * 1024 + ch];
    const float clam = -8.0f * 1.4426950408889634f * log1pf(__expf(-lam));
    float h = 0.f, p = 1.f;
    const int st = 2 * (gt >> 4), c8 = (gt & 15) * 8;
    const int strow = 8 * ((st & 15) >> 2) + 4 * (st >> 4) + (st & 3);
    v4u pre[5];
#define LRU_LOAD(ck_) do { const int ck__ = (ck_); _Pragma("unroll") for (int i = 0; i < 5; ++i) { \
        const int tt = t0seg + ck__ * 32 + st + i - 2; \
        pre[i] = (tt >= 0 && tt < Tseq) ? *(const v4u*)(XR + (size_t)(rowseq + tt) * 1024 + nblk * 128 + c8) : (v4u){0u, 0u, 0u, 0u}; } } while (0)
#define LRU_CONV(buf_) do { float y0[8], y1[8]; { const f32x4 b0 = *(const LAS f32x4*)(cw + 512 + c8), b1 = *(const LAS f32x4*)(cw + 512 + c8 + 4); \
            _Pragma("unroll") for (int j = 0; j < 4; ++j) { y0[j] = b0[j]; y0[4 + j] = b1[j]; y1[j] = b0[j]; y1[4 + j] = b1[j]; } } \
        _Pragma("unroll") for (int k = 0; k < 4; ++k) { const f32x4 w0 = *(const LAS f32x4*)(cw + k * 128 + c8), w1 = *(const LAS f32x4*)(cw + k * 128 + c8 + 4); \
            const v4u xa = pre[k], xb = pre[k + 1]; \
            _Pragma("unroll") for (int q = 0; q < 4; ++q) { const float wlo = q < 2 ? w0[2 * q] : w1[2 * q - 4], whi = q < 2 ? w0[2 * q + 1] : w1[2 * q - 3]; \
                y0[2 * q] += wlo * __uint_as_float(xa[q] << 16); y0[2 * q + 1] += whi * __uint_as_float(xa[q] & 0xffff0000u); \
                y1[2 * q] += wlo * __uint_as_float(xb[q] << 16); y1[2 * q + 1] += whi * __uint_as_float(xb[q] & 0xffff0000u); } } \
        v4u o; o.x = pk2(y0[0], y0[1]); o.y = pk2(y0[2], y0[3]); o.z = pk2(y0[4], y0[5]); o.w = pk2(y0[6], y0[7]); \
        *(LAS v4u*)(tiles + (buf_) * TILEB + strow * 272 + c8 * 2) = o; \
        o.x = pk2(y1[0], y1[1]); o.y = pk2(y1[2], y1[3]); o.z = pk2(y1[4], y1[5]); o.w = pk2(y1[6], y1[7]); \
        *(LAS v4u*)(tiles + (buf_) * TILEB + (strow + 1) * 272 + c8 * 2) = o; } while (0)
    LRU_LOAD(dir ? nch - 1 : 0);
    __syncthreads();
    LRU_CONV(dir ? nch - 1 : 0);
    __syncthreads();
    for (int k = 0; k < nch; ++k) {
        const int ck = dir ? nch - 1 - k : k;
        const LAS unsigned char* tile = tiles + ck * TILEB;
        f32x16 aR = {}, aI = {};
#pragma unroll
        for (int ks = 0; ks < 8; ++ks) { const bf16x8 af = *(const LAS bf16x8*)(tile + r32 * 272 + (16 * ks + 8 * hi) * 2);
            aR = __builtin_amdgcn_mfma_f32_32x32x16_bf16(af, bR[ks], aR, 0, 0, 0);
            aI = __builtin_amdgcn_mfma_f32_32x32x16_bf16(af, ks == 0 ? bI0 : *(const LAS bf16x8*)(wib + (ks - 1) * 1024), aI, 0, 0, 0); }
        float av[16], bv[16];
#pragma unroll
        for (int r = 0; r < 16; ++r) { const int t = crow16(r, hi);
            const float x = bf2f(*(const LAS unsigned short*)(tile + t * 272 + chl * 2));
            const float eu = 1.0f + __builtin_amdgcn_exp2f(-1.4426950408889634f * (aR[r] + ba)), ev = 1.0f + __builtin_amdgcn_exp2f(-1.4426950408889634f * (aI[r] + bi));
            const float inv = __builtin_amdgcn_rcpf(eu * ev);
            const float rr = ev * inv, ii = eu * inv;
            const float a = __builtin_amdgcn_exp2f(clam * rr);
            av[r] = a; bv[r] = __builtin_amdgcn_sqrtf(fmaxf(fmaf(-a, a, 1.0f), 0.f)) * (ii * x); }
        if (k < 3) LRU_LOAD(dir ? nch - 2 - k : k + 1);
        if (dir == 0) {
#pragma unroll
            for (int r = 1; r < 16; ++r) { bv[r] = fmaf(av[r], bv[r - 1], bv[r]); av[r] *= av[r - 1]; }
            const float ho = fmaf(av[15], h, bv[15]), po = av[15] * p;
            const float nh = partner32(ho, hi), np = partner32(po, hi);
            const float hin = hi ? nh : h, pin = hi ? np : p;
#pragma unroll
            for (int r = 0; r < 16; ++r) { bv[r] = fmaf(av[r], hin, bv[r]); av[r] *= pin; }
            const float eh = partner32(bv[15], hi), ep = partner32(av[15], hi);
            h = hi ? bv[15] : eh; p = hi ? av[15] : ep;
        } else {
#pragma unroll
            for (int r = 14; r >= 0; --r) { bv[r] = fmaf(av[r], bv[r + 1], bv[r]); av[r] *= av[r + 1]; }
            const float ho = fmaf(av[0], h, bv[0]), po = av[0] * p;
            const float nh = partner32(ho, hi), np = partner32(po, hi);
            const float hin = hi ? h : nh, pin = hi ? p : np;
#pragma unroll
            for (int r = 0; r < 16; ++r) { bv[r] = fmaf(av[r], hin, bv[r]); av[r] *= pin; }
            const float eh = partner32(bv[0], hi), ep = partner32(av[0], hi);
            h = hi ? eh : bv[0]; p = hi ? ep : av[0];
        }
        {
            char* hb_ = dir ? (char*)ACAT + (size_t)(rowbase + ck * 32) * 4096 + 2048 : (char*)HT + (size_t)(rowbase + ck * 32) * 2048;
            const unsigned rs_ = dir ? 4096u : 2048u;
            const unsigned lo1 = (unsigned)(16 * hi) * rs_ + (unsigned)(ch * 2);
#pragma unroll
            for (int r = 0; r < 16; ++r) *(bf16_t*)(hb_ + (lo1 + (unsigned)r * rs_)) = f2bfh(bv[r]);
            if (latent) {
                char* pdb = (char*)PD + (size_t)(rowbase - NCTX + ck * 32) * 2048;
                const unsigned lo2 = (unsigned)((16 * hi) * 2048 + ch * 2);
#pragma unroll
                for (int r = 0; r < 16; ++r) *(bf16_t*)(pdb + (lo2 + (unsigned)(r * 2048))) = f2bfh(av[r]);
            }
        }
        if (k < 3) LRU_CONV(dir ? nch - 2 - k : k + 1);
        asm volatile("s_waitcnt lgkmcnt(0)\n\ts_barrier" ::: "memory");
    }
    if (hi == 0) {
        if (latent) { float* tot = (float*)(P.ws + WS_TOT) + ((size_t)(((b * 8 + nblk) * 8 + seg) * 2 + dir) * 2) * 128 + chl; tot[0] = p; tot[128] = h; }
        else P.out[OUT_S + ((size_t)(b * 4 + layer) * 2 + dir) * 1024 + ch] = h;
    }
    asm volatile("s_waitcnt vmcnt(0)" ::: "memory"); __syncthreads();
    if (!latent) {
        const bf16_t* GXB = ((const bf16_t*)P.out);
#pragma unroll
        for (int hb4 = 0; hb4 < 2; ++hb4) {
            v4u hf[4], hb[4], gx[4];
#pragma unroll
            for (int i = 0; i < 4; ++i) { const int it = tid + (hb4 * 4 + i) * 512; const size_t row = (size_t)rowbase + (it >> 4); const int col = nblk * 128 + (it & 15) * 8;
                hf[i] = *(const v4u*)(HT + row * 1024 + col); hb[i] = *(const v4u*)(ACAT + row * 2048 + 1024 + col); gx[i] = *(const v4u*)(GXB + row * 1024 + col); }
#pragma unroll
            for (int i = 0; i < 4; ++i) { const int it = tid + (hb4 * 4 + i) * 512; const size_t row = (size_t)rowbase + (it >> 4); const int col = nblk * 128 + (it & 15) * 8;
                v4u o;
#pragma unroll
                for (int q = 0; q < 4; ++q) {
                    const float ylo = (__uint_as_float(hf[i][q] << 16) + __uint_as_float(hb[i][q] << 16)) * __uint_as_float(gx[i][q] << 16);
                    const float yhi = (__uint_as_float(hf[i][q] & 0xffff0000u) + __uint_as_float(hb[i][q] & 0xffff0000u)) * __uint_as_float(gx[i][q] & 0xffff0000u);
                    o[q] = pk2(ylo, yhi); }
                *(v4u*)(ACAT + row * 2048 + 1024 + col) = o; }
        }
    }
    if (latent) {
        if (tid == 0) { __builtin_amdgcn_fence(__ATOMIC_RELEASE, "agent"); asm volatile("s_waitcnt vmcnt(0)" ::: "memory");
            __hip_atomic_fetch_add((unsigned*)(P.ws + WS_CTL) + CW_DONE + ((layer * 4 + b) * 8 + nblk) * 16, 1u, __ATOMIC_RELAXED, __HIP_MEMORY_SCOPE_AGENT); }
    }
#undef LRU_LOAD
#undef LRU_CONV
}

__device__ __forceinline__ void lru_fix_unit(const Params& P, int layer, int u, LAS unsigned char* lds) {
    int tid_l = threadIdx.x; asm volatile("" : "+v"(tid_l));
    const int tid = tid_l;
    LAS float* carr = (LAS float*)lds;
    const bf16_t* HT = ((const bf16_t*)P.out + (size_t)16777216); const bf16_t* PF = (const bf16_t*)(P.ws + WS_PF); const bf16_t* PB = (const bf16_t*)(P.ws + WS_PB);
    bf16_t* ACAT = (bf16_t*)(P.ws + WS_ACAT);
    {
        const int b = u >> 6, n = (u >> 3) & 7, seg = u & 7;
        if (tid == 0) {
            unsigned* dn = (unsigned*)(P.ws + WS_CTL) + CW_DONE + ((layer * 4 + b) * 8 + n) * 16; unsigned spins = 0;
            while (__hip_atomic_load(dn, __ATOMIC_RELAXED, __HIP_MEMORY_SCOPE_AGENT) < 8u && ++spins < (1u << 22)) __builtin_amdgcn_s_sleep(4);
            __builtin_amdgcn_fence(__ATOMIC_ACQUIRE, "agent"); asm volatile("s_waitcnt vmcnt(0)" ::: "memory");
        }
        __syncthreads();
        if (tid < 256) {
            const int dir = tid >> 7, c = tid & 127;
            float cy = P.in[4][((size_t)(b * 4 + layer) * 2 + dir) * 1024 + n * 128 + c];
            const float* tot = (const float*)(P.ws + WS_TOT) + ((size_t)((b * 8 + n) * 8) * 2 + dir) * 2 * 128 + c;
            float tp[8], th[8];
#pragma unroll
            for (int j = 0; j < 8; ++j) { tp[j] = tot[j * 512]; th[j] = tot[j * 512 + 128]; }
            if (dir == 0) {
#pragma unroll
                for (int j = 0; j < 7; ++j) if (j < seg) cy = fmaf(tp[j], cy, th[j]);
            } else {
#pragma unroll
                for (int j = 7; j > 0; --j) if (j > seg) cy = fmaf(tp[j], cy, th[j]);
            }
            carr[tid] = cy;
        }
        __syncthreads();
        const size_t row0 = (size_t)NCTX + b * 2048 + seg * 256;
#pragma unroll
        for (int hb4 = 0; hb4 < 2; ++hb4) {
            v4u s[4], s2[4], pf[4], pb[4], gx[4];
#pragma unroll
            for (int i = 0; i < 4; ++i) { const int it = tid + (hb4 * 4 + i) * 512; const size_t row = row0 + (it >> 4); const int col = n * 128 + (it & 15) * 8;
                s[i] = *(const v4u*)(HT + row * 1024 + col); s2[i] = *(const v4u*)(ACAT + row * 2048 + 1024 + col);
                pf[i] = *(const v4u*)(PF + (row - NCTX) * 1024 + col); pb[i] = *(const v4u*)(PB + (row - NCTX) * 1024 + col);
                gx[i] = *(const v4u*)((const bf16_t*)P.out + row * 1024 + col); }
#pragma unroll
            for (int i = 0; i < 4; ++i) { const int it = tid + (hb4 * 4 + i) * 512; const size_t row = row0 + (it >> 4); const int c8 = (it & 15) * 8, col = n * 128 + c8;
                const f32x4 cf0 = *(const LAS f32x4*)(carr + c8), cf1 = *(const LAS f32x4*)(carr + c8 + 4), cb0 = *(const LAS f32x4*)(carr + 128 + c8), cb1 = *(const LAS f32x4*)(carr + 128 + c8 + 4);
                v4u o;
#pragma unroll
                for (int q = 0; q < 4; ++q) { const float cfl = q < 2 ? cf0[2 * q] : cf1[2 * q - 4], cfh = q < 2 ? cf0[2 * q + 1] : cf1[2 * q - 3], cbl = q < 2 ? cb0[2 * q] : cb1[2 * q - 4], cbh = q < 2 ? cb0[2 * q + 1] : cb1[2 * q - 3];
                    const float ylo = (__uint_as_float(s[i][q] << 16) + __uint_as_float(s2[i][q] << 16) + __uint_as_float(pf[i][q] << 16) * cfl + __uint_as_float(pb[i][q] << 16) * cbl) * __uint_as_float(gx[i][q] << 16);
                    const float yhi = (__uint_as_float(s[i][q] & 0xffff0000u) + __uint_as_float(s2[i][q] & 0xffff0000u) + __uint_as_float(pf[i][q] & 0xffff0000u) * cfh + __uint_as_float(pb[i][q] & 0xffff0000u) * cbh) * __uint_as_float(gx[i][q] & 0xffff0000u);
                    o[q] = pk2(ylo, yhi); }
                *(v4u*)(ACAT + row * 2048 + 1024 + col) = o; }
        }
        __syncthreads();
    }
}

__device__ __forceinline__ void mixer_phase(const Params& P, int layer, unsigned char* lds_generic, LAS unsigned char* lds, int rep, const pg8::EpiIn& EI) {
    unsigned* ctr = (unsigned*)(P.ws + WS_CTL) + CW_QUEUE + 64 * (layer + 4 * rep);
    volatile LAS unsigned* misc = (volatile LAS unsigned*)(lds + MISC_OFF);
    const bf16_t* Q = (const bf16_t*)(P.ws + WS_Q); const bf16_t* KB = (const bf16_t*)(P.ws + WS_KB); const bf16_t* VB = (const bf16_t*)(P.ws + WS_VB);
    const bf16_t* CK = (const bf16_t*)(P.ws + WS_CK); const bf16_t* CV = (const bf16_t*)(P.ws + WS_CV);
    bf16_t* ACAT = (bf16_t*)(P.ws + WS_ACAT);
    if (threadIdx.x == 0) misc[0] = __hip_atomic_fetch_add(ctr, 1u, __ATOMIC_RELAXED, __HIP_MEMORY_SCOPE_AGENT);
    for (int it = 0;; ++it) {
        __syncthreads();
        unsigned nxt = 0u;
        if (threadIdx.x == 0) nxt = __hip_atomic_fetch_add(ctr, 1u, __ATOMIC_RELAXED, __HIP_MEMORY_SCOPE_AGENT);
        const int tk = __builtin_amdgcn_readfirstlane((int)misc[it & 1]);
        if (tk >= 1408) break;
        const int idx = tk < 768 ? tk : (tk < 896 ? tk - 896 : tk - 128);
        if (idx < 0) {
            const int u = idx + 128;
            pg8::Gemm g{(const bf16_t*)(P.ws + WS_H), (const bf16_t*)(P.ws + WS_WIN) + (size_t)layer * NINW * 1024, NTOK, NINW, 1024};
            if (threadIdx.x == 0) ((LAS int*)(lds + RED_OFF))[2048 + 64 + 256] = -1;
            __syncthreads();
            OneUnit S1{u & 63, 20 + (u >> 6)};
            pg8::gemm_phase<pg8::EpiIn, OneUnit, true, true>(lds, g, S1, EI);
        }
        else if (idx >= 1024) { lru_fix_unit(P, layer, idx - 1024, lds); }
        else if (idx >= 256 && idx < 768) {
#ifndef NO_LRU
            const int j = idx - 256, latent = j < 256, jj = j & 255;
            lru_unit(P, layer, latent, latent ? (jj >> 6) : (jj >> 3), latent ? ((jj >> 3) & 7) : 0, jj & 7, lds);
#endif
        } else {
#ifndef NO_ATT
            const bool latent = idx < 256;
            const int j = latent ? idx : idx - 768;
            const int b = latent ? (j >> 6) : (j >> 3), hh = latent ? ((j >> 3) & 7) : (j & 7), qb = latent ? (j & 7) : 0, kvh = hh >> 2;
            const int q0 = qb * 256, ks = q0 - 128 < 0 ? 0 : q0 - 128, ke = q0 + 384 > 2048 ? 2048 : q0 + 384;
            const size_t rq = latent ? (size_t)NCTX + b * 2048 + q0 : (size_t)b * 256;
            const size_t rk = (size_t)NCTX + b * 2048 + ks, ck0 = (size_t)(b * 4 + layer) * 512;
            const bf16_t* K0 = latent ? CK + ck0 * 256 + kvh * 128 : KB + rq * 256 + kvh * 128;
            const bf16_t* V0 = latent ? CV + ck0 * 256 + kvh * 128 : VB + rq * 256 + kvh * 128;
            att::attn_unit(Q + rq * 1024 + hh * 128, K0, V0, latent ? 8 : 4,
                           KB + rk * 256 + kvh * 128, VB + rk * 256 + kvh * 128, latent ? (ke - ks) / 64 : 0, ks - q0,
                           P.in[14][layer * 8 + hh] * 1.4426950408889634f, ACAT + rq * 2048 + hh * 128, (char*)lds_generic);
#endif
        }
        if (threadIdx.x == 0) misc[(it + 1) & 1] = nxt;
    }
}

__global__ void __launch_bounds__(512, 2) fwd_megakernel(Params P) {
    extern __shared__ __attribute__((aligned(16))) unsigned char lds_raw[];
    LAS unsigned char* lds = (LAS unsigned char*)lds_raw;
    cg::grid_group grid = cg::this_grid();
    const int lo = P.ph_lo, hi = P.ph_hi, G = gridDim.x;
    int ph = 0;
    { volatile LAS unsigned* m = (volatile LAS unsigned*)(lds + MISC_OFF); if (threadIdx.x < 16) m[threadIdx.x] = 0u; }
    __syncthreads();
    XcdBarrier bar = xcd_barrier_post((unsigned*)(P.ws + WS_CTL) + CW_BAR, (volatile LAS unsigned*)(lds + MISC_OFF) + 8);
#define PHASE(...) do { if (ph >= lo && ph < hi) { __VA_ARGS__; if (ph + 1 < hi) { if (lo < 0) grid.sync(); else xcd_barrier(bar); } } ++ph; } while (0)
    bf16_t* H = (bf16_t*)(P.ws + WS_H);
#ifndef NO_PRO
    PHASE(prologue(P, lds));
#endif
    PHASE(prep_phase(P, lds));
#ifdef XSYNC
    if (hi > 1) { for (int i = 0; i < XSYNC; ++i) grid.sync(); }
#endif
    for (int l = 0; l < NL; ++l) {
        const float* mod = (const float*)(P.ws + WS_MOD) + (size_t)l * 5 * NMOD6;
        const pg8::EpiIn EI{(bf16_t*)(P.ws + WS_Q), (bf16_t*)(P.ws + WS_KB), (bf16_t*)(P.ws + WS_VB), (bf16_t*)(P.ws + WS_XR), ((bf16_t*)P.out), (bf16_t*)(P.ws + WS_G),
                         P.out + OUT_K, P.out + OUT_V, P.in[12] + l * 128, P.in[13] + l * 128, (const float*)(P.ws + WS_ROPE), (LAS float*)(lds + RED_OFF), l,
                         (const float*)(P.ws + WS_SSQ), (const float*)(P.ws + WS_SWIN) + (size_t)l * 5 * NINW};
        PHASE({ RS_RESET(); pg8::Gemm g{H, (const bf16_t*)(P.ws + WS_WIN) + (size_t)l * NINW * 1024, NTOK, NINW, 1024}; pg8::StaticOrder S; S.init(NTOK, 5120, G, opaque_bid());
            pg8::gemm_phase<pg8::EpiIn, pg8::StaticOrder, true, true>(lds, g, S, EI); });
        PHASE({ _Pragma("nounroll") for (int rep = 0; rep < XREP_MIX; ++rep) { mixer_phase(P, l, lds_raw, lds, rep, EI); if (rep + 1 < XREP_MIX) xcd_barrier(bar); } });
        PHASE({ pg8::Gemm g{(const bf16_t*)(P.ws + WS_ACAT), (const bf16_t*)(P.ws + WS_WCAT) + (size_t)l * 1024 * 2048, NTOK, 1024, 2048}; pg8::StaticOrder S; S.init(NTOK, 1024, G, opaque_bid());
            pg8::EpiMerge E{(const bf16_t*)(P.ws + WS_G), (bf16_t*)(P.ws + WS_MERGED)};

#ifndef NO_G2
 pg8::gemm_phase<pg8::EpiMerge, pg8::StaticOrder, true, true>(lds, g, S, E);
#endif
 });
        PHASE({ pg8::Gemm g{(const bf16_t*)(P.ws + WS_MERGED), (const bf16_t*)(P.ws + WS_WOUT) + (size_t)l * 1024 * 1024, NTOK, 1024, 1024}; pg8::StaticOrder S; S.init(NTOK, 1024, G, opaque_bid());
            pg8::EpiRes E{l == 0 ? P.in[0] : (const float*)nullptr, P.in[1] - (size_t)NCTX * 1024, (const bf16_t*)(P.ws + WS_X16), (bf16_t*)(P.ws + WS_X16), (float*)nullptr, mod + 2048, H, (const float*)(P.ws + WS_WMOD) + (size_t)(l * 2 + 1) * 5 * 1024, (float*)(P.ws + WS_SSQ)};

#ifndef NO_G3
 pg8::gemm_phase<pg8::EpiRes, pg8::StaticOrder, true, true>(lds, g, S, E);
#endif
 });
        PHASE({ RS_RESET(); pg8::Gemm g{H, (const bf16_t*)(P.ws + WS_W1) + (size_t)l * DFF * 1024, NTOK, DFF, 1024}; pg8::StaticOrder S; S.init(NTOK, DFF, G, opaque_bid());
            pg8::EpiUp E{(bf16_t*)(P.ws + WS_U), (const float*)(P.ws + WS_SSQ), (const float*)(P.ws + WS_SWUP) + (size_t)l * 5 * DFF, (LAS float*)(lds + RED_OFF) + 2048 + 64};

#ifndef NO_G4
 pg8::gemm_phase<pg8::EpiUp, pg8::StaticOrder, true, true>(lds, g, S, E);
#endif
 });
        PHASE({ pg8::Gemm g{(const bf16_t*)(P.ws + WS_U), (const bf16_t*)(P.ws + WS_W2) + (size_t)l * 1024 * DFF, NTOK, 1024, DFF}; pg8::StaticOrder S; S.init(NTOK, 1024, G, opaque_bid());
            pg8::EpiRes E{(const float*)nullptr, (const float*)nullptr, (const bf16_t*)(P.ws + WS_X16), (bf16_t*)(P.ws + WS_X16), l + 1 < NL ? (float*)nullptr : P.out, mod + 5 * 1024, l + 1 < NL ? H : (bf16_t*)nullptr, (const float*)(P.ws + WS_WMOD) + (size_t)((l + 1) * 2) * 5 * 1024, (float*)(P.ws + WS_SSQ)};

#ifndef NO_G3
 pg8::gemm_phase<pg8::EpiRes, pg8::StaticOrder, true, true>(lds, g, S, E);
#endif
 });
    }
#undef PHASE
#ifdef DUMP_PH
    grid.sync();
    { const v4u* src = (const v4u*)(P.ws + (size_t)DUMP_OFF * MiB); v4u* dst = (v4u*)P.out; const size_t n = (size_t)(33554432 + 262144) / 4;
      const size_t nl = (size_t)DUMP_LEN * MiB / 16; const v4u z = {0u, 0u, 0u, 0u};
      for (size_t i = (size_t)blockIdx.x * 512 + threadIdx.x; i < n; i += (size_t)gridDim.x * 512) dst[i] = i < nl ? src[i] : z; }
#endif
}

extern "C" void kernel_launch(void* const* d_in, const int* in_sizes, int n_in, void* d_out, int out_size, void* d_ws, size_t ws_size, hipStream_t stream) {
    static int grid = 0;
    if (grid == 0) {
        if (n_in != 27 || ws_size < WS_END) { fprintf(stderr, "kernel_launch: unexpected n_in %d / ws_size %zu (need %zu)\n", n_in, ws_size, (size_t)WS_END); grid = -1; return; }
        int dev = 0, cus = 0, per_cu = 0;
        (void)hipGetDevice(&dev); (void)hipDeviceGetAttribute(&cus, hipDeviceAttributeMultiprocessorCount, dev);
        if (hipFuncSetAttribute((const void*)fwd_megakernel, hipFuncAttributeMaxDynamicSharedMemorySize, LDS_BYTES) != hipSuccess) { fprintf(stderr, "kernel_launch: hipFuncSetAttribute failed\n"); grid = -1; return; }
        if (hipOccupancyMaxActiveBlocksPerMultiprocessor(&per_cu, (const void*)fwd_megakernel, 512, LDS_BYTES) != hipSuccess || per_cu < 1) { fprintf(stderr, "kernel_launch: occupancy query says %d\n", per_cu); per_cu = 1; }
        (void)hipGetLastError();
        grid = cus * 1;
        if (grid <= 0) grid = 256;
    }
    if (grid < 0) return;
    (void)hipMemsetAsync((char*)d_ws + WS_CTL, 0, 65536, stream);
    Params p{};
    for (int i = 0; i < 27; ++i) p.in[i] = (const float*)d_in[i];
    p.out = (float*)d_out; p.ws = (unsigned char*)d_ws;
#ifndef MK_SPLIT
#ifdef DUMP_PH
    p.ph_lo = 0; p.ph_hi = DUMP_PH;
#else
    p.ph_lo = 0; p.ph_hi = 1000;
#endif
    void* args[] = {&p};
    hipError_t e = hipLaunchCooperativeKernel((const void*)fwd_megakernel, dim3(grid), dim3(512), args, LDS_BYTES, stream);
    if (e != hipSuccess) fprintf(stderr, "cooperative launch failed: %s (grid %d)\n", hipGetErrorString(e), grid);
#else
    const int nph = 2 + NL * 6;
    for (int k = 0; k < nph; ++k) { p.ph_lo = k; p.ph_hi = k + 1; hipLaunchKernelGGL(fwd_megakernel, dim3(grid), dim3(512), LDS_BYTES, stream, p); }
#endif
}
```

```cpp
#include <hip/hip_runtime.h>
#include <hip/hip_cooperative_groups.h>
#include <hip/hip_bf16.h>
#include <cstdio>
#include <cstdint>
namespace cg = cooperative_groups;
namespace pg8 {
#define PG8_LAS __attribute__((address_space(3)))
typedef unsigned short bf16_t;
typedef short bf16x8 __attribute__((ext_vector_type(8)));
typedef float f32x4 __attribute__((ext_vector_type(4)));
typedef unsigned u32x4 __attribute__((ext_vector_type(4)));
constexpr int BM = 256, BK = 64, HALF = 128, HTB = HALF * BK * 2  , STAGE_BYTES = 8 * HTB, NXCD = 8, WGM = 8;

__host__ __device__ __forceinline__ int lds_byte(int r, int c) { const int st = (r >> 4) * 2 + (c >> 5), rr = r & 15, cc = c & 31, ob = rr * 64 + cc * 2; return st * 1024 + (ob ^ (((ob >> 9) & 1) << 5)); }
__host__ __device__ __forceinline__ void stage_rc(int b, int& R, int& C) { const int st = b / 1024, sb = b % 1024, swz = sb ^ (((sb >> 9) & 1) << 5); R = (st >> 1) * 16 + swz / 64; C = (st & 1) * 32 + (swz % 64) / 2; }
__host__ __device__ __forceinline__ int perm32(int rho) { const int n = rho >> 4, i = rho & 15; return 8 * (i >> 2) + 4 * n + (i & 3); }

struct Unit { int pm, pn; };
struct Gemm { const bf16_t* A; const bf16_t* Bt; int M, N, K; };

struct StaticOrder {
    int nM, nN, nwg, G, c;
    __host__ __device__ void init(int M, int N, int G_, int c_) { nM = M / BM; nN = N / BM; nwg = nM * nN; G = G_; c = c_; }
    __host__ __device__ bool next(int i, Unit& u) const {
        const long L = (long)i * G + c; if (L >= nwg) return false;
        int wgid = (int)L; { const int q = nwg / NXCD, r = nwg % NXCD, xcd = wgid % NXCD, off = wgid / NXCD; wgid = (xcd < r ? xcd * (q + 1) : r * (q + 1) + (xcd - r) * q) + off; }
        const int nig = WGM * nN, gid = wgid / nig, fm = gid * WGM, gsz = (nM - fm) < WGM ? (nM - fm) : WGM;
        u.pm = fm + ((wgid % nig) % gsz); u.pn = (wgid % nig) / gsz; return true;
    }
    __device__ __forceinline__ void a_ready(const Unit&) const {}
    __device__ __forceinline__ void done(const Unit&) const {}
};

typedef float f32x2c_t __attribute__((ext_vector_type(2))); typedef __bf16 bf16x2c_t __attribute__((ext_vector_type(2)));
__device__ __forceinline__ unsigned cvt_pk_bf16(float lo, float hi) { f32x2c_t v = {lo, hi}; bf16x2c_t b = __builtin_convertvector(v, bf16x2c_t); return __builtin_bit_cast(unsigned, b); }
typedef float f32x2 __attribute__((ext_vector_type(2)));
typedef unsigned u32x2 __attribute__((ext_vector_type(2)));
__device__ __forceinline__ float bf2f(unsigned short u) { return __uint_as_float(((unsigned)u) << 16); }
__device__ __forceinline__ float fsigmoid(float x) { return __builtin_amdgcn_rcpf(1.0f + __expf(-x)); }
__device__ __forceinline__ float gelu_tanh(float x) { const float u = 1.5957691216057308f * (x + 0.044715f * x * x * x); return x * __builtin_amdgcn_rcpf(1.0f + __expf(-u)); }
__device__ __forceinline__ u32x2 pack4(f32x4 v) { u32x2 w; w.x = cvt_pk_bf16(v[0], v[1]); w.y = cvt_pk_bf16(v[2], v[3]); return w; }
__host__ __device__ __forceinline__ int dim_of_pos(int p) { const int pi = p >> 1, wh = p & 1; return (pi >> 5) * 64 + wh * 32 + (pi & 31); }
__host__ __device__ __forceinline__ int pos_of_dim(int d) { const int ax = d >> 6, wh = (d >> 5) & 1, i = d & 31; return 2 * (ax * 32 + i) + wh; }

constexpr int NTOK = 16384, NCTX = 8192, DM = 1024;
constexpr float EPSN = 1e-6f;


template <bool PERMC>
__device__ __forceinline__ void prenorm_apply(f32x4 (&acc)[2][2][4][2], const Unit& u, int wr, int wc, int fr, int fq, const float* ssq, const float* sw, int ncols, PG8_LAS float* rs) {
    const int rowt = wr * 64 + fr, colw = u.pn * 256 + wc * 32 + (PERMC ? 8 : 4) * fq;
    const int cond = u.pm < 32 ? 0 : 1 + ((u.pm - 32) >> 3);
    const float* swp = sw + (size_t)cond * ncols + colw;
    const int t = (wr * 4 + wc) * 64 + fq * 16 + fr;
    const bool rebuild = ((const PG8_LAS int*)rs)[256] != u.pm;
    if (rebuild && t < 256) {
        const float* sp = ssq + (size_t)(u.pm * 256 + t) * 16;
        const f32x4 s0 = *(const f32x4*)sp, s1 = *(const f32x4*)(sp + 4), s2 = *(const f32x4*)(sp + 8), s3 = *(const f32x4*)(sp + 12);
        const f32x4 st = (s0 + s1) + (s2 + s3);
        rs[t] = __builtin_amdgcn_rsqf(((st[0] + st[1]) + (st[2] + st[3])) * (1.0f / 1024.0f) + EPSN);
    }
    f32x4 sv[2][2];
#pragma unroll
    for (int bj = 0; bj < 2; ++bj)
#pragma unroll
        for (int n = 0; n < 2; ++n) sv[bj][n] = *(const f32x4*)(swp + bj * 128 + (PERMC ? 4 : 16) * n);
    if (rebuild) {
        asm volatile("s_waitcnt lgkmcnt(0)" ::: "memory"); __builtin_amdgcn_s_barrier(); asm volatile("" ::: "memory");
        if (t == 0) ((PG8_LAS int*)rs)[256] = u.pm;
    }
#pragma unroll
    for (int ai = 0; ai < 2; ++ai)
#pragma unroll
        for (int m = 0; m < 4; ++m) {
            const float rstd = rs[ai * 128 + m * 16 + rowt];
#pragma unroll
            for (int bj = 0; bj < 2; ++bj)
#pragma unroll
                for (int n = 0; n < 2; ++n) acc[ai][bj][m][n] = acc[ai][bj][m][n] * rstd + sv[bj][n];
        }
}

struct EpiIn {
    static constexpr bool PERM = true, AFTER_DRAIN = false, HAS_MID = false;
    bf16_t *Q, *KB, *VB, *XR, *GXB, *G; float *outk, *outv; const float *qw, *kw, *rope; PG8_LAS float* red; int layer; const float *ssq, *sw;
    __device__ __forceinline__ void operator()(f32x4 (&acc)[2][2][4][2], const Unit& u, int wr, int wc, int fr, int fq) const {
        asm volatile("" : "+v"(fr), "+v"(fq));
        prenorm_apply<true>(acc, u, wr, wc, fr, fq, ssq, sw, 5632, red + 2048 + 64);
        const int pn = u.pn, pm = u.pm;
        const int rowt = wr * 64 + fr, colw = wc * 32 + 8 * fq;
        const bool latent = pm >= 32;
        if (pn < 5) {
#pragma unroll
            for (int ai = 0; ai < 2; ++ai)
#pragma unroll
                for (int m = 0; m < 4; ++m)
#pragma unroll
                    for (int bj = 0; bj < 2; ++bj) {
                        float s = 0.f;
#pragma unroll
                        for (int n = 0; n < 2; ++n) { const f32x4 x = acc[ai][bj][m][n]; s += (x[0] * x[0] + x[1] * x[1]) + (x[2] * x[2] + x[3] * x[3]); }
                        s += __shfl_xor(s, 16); s += __shfl_xor(s, 32);
                        if (fq == 0) red[((ai * 128 + m * 16 + rowt) * 2 + bj) * 4 + wc] = s;
                    }
            asm volatile("s_waitcnt lgkmcnt(0)" ::: "memory"); __builtin_amdgcn_s_barrier(); asm volatile("" ::: "memory");
            const float* nw = pn < 4 ? qw : kw;
            f32x4 wv[2];
#pragma unroll
            for (int n = 0; n < 2; ++n)
#pragma unroll
                for (int e = 0; e < 4; ++e) wv[n][e] = nw[dim_of_pos(colw + 4 * n + e)];
#pragma unroll
            for (int ai = 0; ai < 2; ++ai)
#pragma unroll
                for (int m = 0; m < 4; ++m) {
                    const int rl = ai * 128 + m * 16 + rowt, row = pm * 256 + rl;
#pragma unroll
                    for (int bj = 0; bj < 2; ++bj) {
                        const f32x4 pr = *(const PG8_LAS f32x4*)(red + (rl * 2 + bj) * 4);
                        const float rstd = __builtin_amdgcn_rsqf(((pr[0] + pr[1]) + (pr[2] + pr[3])) * (1.0f / 128.0f) + EPSN);
                        u32x2 pk[2]; float kx[2][2], ky[2][2];
#pragma unroll
                        for (int n = 0; n < 2; ++n) {
                            f32x4 v = acc[ai][bj][m][n] * rstd * wv[n];
                            const int p = colw + 4 * n;
                            if (!latent && pn == 4) { kx[n][0] = v[0]; kx[n][1] = v[2]; ky[n][0] = v[1]; ky[n][1] = v[3]; }
                            if (latent) {
                                const int t = (row - NCTX) & 2047;
                                const f32x4 cs = *(const f32x4*)(rope + ((size_t)t * 64 + (p >> 1)) * 2);
                                f32x4 o; o[0] = v[0] * cs[0] - v[1] * cs[1]; o[1] = v[1] * cs[0] + v[0] * cs[1]; o[2] = v[2] * cs[2] - v[3] * cs[3]; o[3] = v[3] * cs[2] + v[2] * cs[3];
                                v = o;
                            }
                            pk[n] = pack4(v);
                        }
                        if (!latent && pn == 4) {
                            float* o = outk + ((size_t)((pm * 4 + layer) * 256 + rl) * 2 + bj) * 128 + dim_of_pos(colw);
                            *(f32x4*)o = (f32x4){kx[0][0], kx[0][1], kx[1][0], kx[1][1]}; *(f32x4*)(o + 32) = (f32x4){ky[0][0], ky[0][1], ky[1][0], ky[1][1]};
                        }
                        bf16_t* dst = (pn < 4) ? Q + (size_t)row * 1024 + pn * 256 + bj * 128 + colw : KB + (size_t)row * 256 + bj * 128 + colw;
                        u32x4 w; w.x = pk[0].x; w.y = pk[0].y; w.z = pk[1].x; w.w = pk[1].y;
                        *(u32x4*)dst = w;
                    }
                }
        } else {
#pragma unroll
            for (int ai = 0; ai < 2; ++ai)
#pragma unroll
                for (int m = 0; m < 4; ++m) {
                    const int rl = ai * 128 + m * 16 + rowt, row = pm * 256 + rl;
#pragma unroll
                    for (int bj = 0; bj < 2; ++bj) {
                        f32x4 v0 = acc[ai][bj][m][0], v1 = acc[ai][bj][m][1];
                        const int c = bj * 128 + colw;
                        bf16_t* dst;
                        if (pn == 5) {
                            if (!latent) { float* o = outv + ((size_t)((pm * 4 + layer) * 256 + rl)) * 256 + c; *(f32x4*)o = v0; *(f32x4*)(o + 4) = v1; }
                            dst = VB + (size_t)row * 256 + c;
                        } else if (pn < 10) {
                            dst = XR + (size_t)row * 1024 + (pn - 6) * 256 + c;
                        } else if (pn < 14) {
#pragma unroll
                            for (int e = 0; e < 4; ++e) { v0[e] = gelu_tanh(v0[e]); v1[e] = gelu_tanh(v1[e]); }
                            dst = GXB + (size_t)row * 1024 + (pn - 10) * 256 + c;
                        } else {
#pragma unroll
                            for (int e = 0; e < 4; ++e) { v0[e] = fsigmoid(v0[e]); v1[e] = fsigmoid(v1[e]); }
                            dst = G + (size_t)row * 2048 + (pn - 14) * 256 + c;
                        }
                        const u32x2 p0 = pack4(v0), p1 = pack4(v1);
                        u32x4 w; w.x = p0.x; w.y = p0.y; w.z = p1.x; w.w = p1.y;
                        *(u32x4*)dst = w;
                    }
                }
        }
    }
};

struct EpiMerge {
    static constexpr bool PERM = true, AFTER_DRAIN = false, HAS_MID = true;
    const bf16_t* G; bf16_t* O;
    __device__ __forceinline__ static f32x4 lo4(u32x4 g) { f32x4 r; r[0] = __uint_as_float(g.x << 16); r[1] = __uint_as_float(g.x & 0xffff0000u); r[2] = __uint_as_float(g.y << 16); r[3] = __uint_as_float(g.y & 0xffff0000u); return r; }
    __device__ __forceinline__ static f32x4 hi4(u32x4 g) { f32x4 r; r[0] = __uint_as_float(g.z << 16); r[1] = __uint_as_float(g.z & 0xffff0000u); r[2] = __uint_as_float(g.w << 16); r[3] = __uint_as_float(g.w & 0xffff0000u); return r; }
    __device__ __forceinline__ static f32x4 rcp4(f32x4 x) { f32x4 r; r[0] = __builtin_amdgcn_rcpf(fmaxf(x[0], 1e-20f)); r[1] = __builtin_amdgcn_rcpf(fmaxf(x[1], 1e-20f)); r[2] = __builtin_amdgcn_rcpf(fmaxf(x[2], 1e-20f)); r[3] = __builtin_amdgcn_rcpf(fmaxf(x[3], 1e-20f)); return r; }
    __device__ __forceinline__ void mid(f32x4 (&acc)[2][2][4][2], const Unit& u, int wr, int wc, int fr, int fq) const {
        asm volatile("" : "+v"(fr), "+v"(fq));
        const int rowt = wr * 64 + fr, colw = u.pn * 256 + wc * 32 + 8 * fq;
#pragma unroll
        for (int ai = 0; ai < 2; ++ai)
#pragma unroll
            for (int m = 0; m < 4; ++m) {
                const bf16_t* gr = G + (size_t)(u.pm * 256 + ai * 128 + m * 16 + rowt) * 2048 + colw;
#pragma unroll
                for (int bj = 0; bj < 2; ++bj) {
                    const u32x4 a = *(const u32x4*)(gr + bj * 128), l = *(const u32x4*)(gr + 1024 + bj * 128);
                    acc[ai][bj][m][0] *= lo4(a) * rcp4(lo4(l));
                    acc[ai][bj][m][1] *= hi4(a) * rcp4(hi4(l));
                }
            }
    }
    __device__ __forceinline__ void operator()(f32x4 (&acc)[2][2][4][2], const Unit& u, int wr, int wc, int fr, int fq) const {
        asm volatile("" : "+v"(fr), "+v"(fq));
        const int rowt = wr * 64 + fr, colw = u.pn * 256 + wc * 32 + 8 * fq;
#pragma unroll
        for (int ai = 0; ai < 2; ++ai)
#pragma unroll
            for (int m = 0; m < 4; ++m) {
                const size_t row = (size_t)(u.pm * 256 + ai * 128 + m * 16 + rowt);
                const bf16_t* gr = G + row * 2048 + 1024 + colw;
#pragma unroll
                for (int bj = 0; bj < 2; ++bj) {
                    const u32x4 l = *(const u32x4*)(gr + bj * 128);
                    const u32x2 p0 = pack4(acc[ai][bj][m][0] * lo4(l)), p1 = pack4(acc[ai][bj][m][1] * hi4(l));
                    u32x4 w; w.x = p0.x; w.y = p0.y; w.z = p1.x; w.w = p1.y;
                    *(u32x4*)(O + row * 1024 + colw + bj * 128) = w;
                }
            }
    }
};

struct EpiRes {
    static constexpr bool PERM = true, AFTER_DRAIN = false, HAS_MID = false;
    const float* xin0; const float* xin1; const bf16_t* xs16; bf16_t* x16o; float* yout; const float* gate; bf16_t* Hn; const float* wmod; float* ssq;
    __device__ __forceinline__ void operator()(f32x4 (&acc)[2][2][4][2], const Unit& u, int wr, int wc, int fr, int fq) const {
        asm volatile("" : "+v"(fr), "+v"(fq));
        const int rowt = wr * 64 + fr, colw = u.pn * 256 + wc * 32 + 8 * fq;
        const int cond = u.pm < 32 ? 0 : 1 + ((u.pm - 32) >> 3);
        const float* xin = u.pm < 32 ? xin0 : xin1;
        f32x4 gv[2][2], wv[2][2];
#pragma unroll
        for (int bj = 0; bj < 2; ++bj)
#pragma unroll
            for (int n = 0; n < 2; ++n) { gv[bj][n] = *(const f32x4*)(gate + cond * 6144 + colw + bj * 128 + 4 * n);
                wv[bj][n] = Hn ? *(const f32x4*)(wmod + cond * 1024 + colw + bj * 128 + 4 * n) : (f32x4){0.f, 0.f, 0.f, 0.f}; }
#pragma unroll
        for (int ai = 0; ai < 2; ++ai)
#pragma unroll
            for (int m = 0; m < 4; ++m) {
                const int row = u.pm * 256 + ai * 128 + m * 16 + rowt;
                const size_t off = (size_t)row * 1024 + colw;
                float sq = 0.f;
#pragma unroll
                for (int bj = 0; bj < 2; ++bj) {
                    f32x4 x0, x1;
                    if (xin0) { x0 = *(const f32x4*)(xin + off + bj * 128); x1 = *(const f32x4*)(xin + off + bj * 128 + 4); }
                    else { const u32x4 xb = *(const u32x4*)(xs16 + off + bj * 128);
                        x0[0] = __uint_as_float(xb.x << 16); x0[1] = __uint_as_float(xb.x & 0xffff0000u); x0[2] = __uint_as_float(xb.y << 16); x0[3] = __uint_as_float(xb.y & 0xffff0000u);
                        x1[0] = __uint_as_float(xb.z << 16); x1[1] = __uint_as_float(xb.z & 0xffff0000u); x1[2] = __uint_as_float(xb.w << 16); x1[3] = __uint_as_float(xb.w & 0xffff0000u); }
                    const f32x4 g0 = gv[bj][0], g1 = gv[bj][1];
                    const f32x4 xn0 = x0 + g0 * acc[ai][bj][m][0], xn1 = x1 + g1 * acc[ai][bj][m][1];
                    if (yout) { *(f32x4*)(yout + off + bj * 128) = xn0; *(f32x4*)(yout + off + bj * 128 + 4) = xn1; }
                    else { const u32x2 p0 = pack4(xn0), p1 = pack4(xn1); u32x4 w; w.x = p0.x; w.y = p0.y; w.z = p1.x; w.w = p1.y; *(u32x4*)(x16o + off + bj * 128) = w; }
                    if (Hn) { const f32x4 w0 = wv[bj][0], w1 = wv[bj][1];
                        const u32x2 p0 = pack4(xn0 * w0), p1 = pack4(xn1 * w1); u32x4 w; w.x = p0.x; w.y = p0.y; w.z = p1.x; w.w = p1.y; *(u32x4*)(Hn + off + bj * 128) = w;
                        sq += ((xn0[0] * xn0[0] + xn0[1] * xn0[1]) + (xn0[2] * xn0[2] + xn0[3] * xn0[3])) + ((xn1[0] * xn1[0] + xn1[1] * xn1[1]) + (xn1[2] * xn1[2] + xn1[3] * xn1[3])); }
                }
                if (Hn) { sq += __shfl_xor(sq, 16); sq += __shfl_xor(sq, 32); if (fq == 0) ssq[(size_t)row * 16 + u.pn * 4 + wc] = sq; }
            }
    }
};

struct EpiUp {
    static constexpr bool PERM = true, AFTER_DRAIN = false, HAS_MID = false;
    bf16_t* U; const float *ssq, *sw; PG8_LAS float* rs;
    __device__ __forceinline__ void operator()(f32x4 (&acc)[2][2][4][2], const Unit& u, int wr, int wc, int fr, int fq) const {
        asm volatile("" : "+v"(fr), "+v"(fq));
        prenorm_apply<true>(acc, u, wr, wc, fr, fq, ssq, sw, 4096, rs);
        const int rowt = wr * 64 + fr, colw = u.pn * 256 + wc * 32 + 8 * fq;
#pragma unroll
        for (int ai = 0; ai < 2; ++ai)
#pragma unroll
            for (int m = 0; m < 4; ++m) {
                bf16_t* rp = U + (size_t)(u.pm * 256 + ai * 128 + m * 16 + rowt) * 4096 + colw;
#pragma unroll
                for (int bj = 0; bj < 2; ++bj) {
                    f32x4 v0 = acc[ai][bj][m][0], v1 = acc[ai][bj][m][1];
#pragma unroll
                    for (int e = 0; e < 4; ++e) { const float r0 = fmaxf(v0[e], 0.f), r1 = fmaxf(v1[e], 0.f); v0[e] = r0 * r0; v1[e] = r1 * r1; }
                    const u32x2 p0 = pack4(v0), p1 = pack4(v1);
                    u32x4 w; w.x = p0.x; w.y = p0.y; w.z = p1.x; w.w = p1.y;
                    *(u32x4*)(rp + bj * 128) = w;
                }
            }
    }
};
template <class Epi, class Sched, bool ALIGN_EPI = false, bool SP2 = false>
__device__ __forceinline__ void gemm_phase(PG8_LAS unsigned char* lds, const Gemm g, const Sched& S, const Epi& E) {
    int tid_l = threadIdx.x; asm volatile("" : "+v"(tid_l));
    const int tid = tid_l, wid = __builtin_amdgcn_readfirstlane(tid >> 6), lane = tid & 63, wr = wid >> 2, wc = wid & 3, fr = lane & 15, fq = lane >> 4;
    const int K = g.K, nt = K / BK;
    unsigned voffA[2], voffB[2];
#pragma unroll
    for (int i = 0; i < 2; ++i) { int R, C; stage_rc(tid * 16 + i * 8192, R, C); const int Rb = Epi::PERM ? ((R & ~31) + perm32(R & 31)) : R;
        voffA[i] = (unsigned)(R * K + C) * 2u; voffB[i] = (unsigned)(Rb * K + C) * 2u; }
    const size_t kstep = (size_t)(BK * 2);
    const size_t hstep = (size_t)HALF * K * 2;
    const size_t tstep = 2 * hstep;
    const unsigned ldsw = (unsigned)wid * 1024u;
    const int aoff = lds_byte(wr * 64 + fr, fq * 8), boff = lds_byte(wc * 32 + fr, fq * 8);
#define PG8_SA(b, h) (((b) * 2 + (h)) * HTB)
#define PG8_SB(b, h) ((4 + (b) * 2 + (h)) * HTB)
#define PG8_STAGE(bufoff, gbase, voff) do { _Pragma("unroll") for (int _i = 0; _i < 2; ++_i) \
        __builtin_amdgcn_global_load_lds((const unsigned*)((const char*)(gbase) + (voff)[_i]), (PG8_LAS unsigned*)(lds + (bufoff) + ldsw + _i * 8192), 16, 0, 0); } while (0)
#define PG8_LDA(dst, b, h) do { _Pragma("unroll") for (int m = 0; m < 4; ++m) _Pragma("unroll") for (int k = 0; k < 2; ++k) dst[m][k] = *(const PG8_LAS bf16x8*)(lds + PG8_SA(b, h) + aoff + m * 2048 + k * 1024); } while (0)
#define PG8_LDB(dst, b, h) do { _Pragma("unroll") for (int n = 0; n < 2; ++n) _Pragma("unroll") for (int k = 0; k < 2; ++k) dst[n][k] = *(const PG8_LAS bf16x8*)(lds + PG8_SB(b, h) + boff + n * 2048 + k * 1024); } while (0)
#define PG8_MMA(ai, bj, At, Bt) do { __builtin_amdgcn_s_setprio(1); _Pragma("unroll") for (int m = 0; m < 4; ++m) _Pragma("unroll") for (int n = 0; n < 2; ++n) _Pragma("unroll") for (int k = 0; k < 2; ++k) \
        acc[ai][bj][m][n] = __builtin_amdgcn_mfma_f32_16x16x32_bf16(Bt[n][k], At[m][k], acc[ai][bj][m][n], 0, 0, 0); __builtin_amdgcn_s_setprio(0); } while (0)
#define PG8_WAIT_V(n) asm volatile("s_waitcnt vmcnt(" #n ")" ::: "memory")
#define PG8_WAIT_L(n) asm volatile("s_waitcnt lgkmcnt(" #n ")" ::: "memory")
#define PG8_BAR __builtin_amdgcn_s_barrier()
#define PG8_SCHED __builtin_amdgcn_sched_barrier(0)
    Unit cur, nxt; int ui = 0;
    if (!S.next(0, cur)) return;
    f32x4 acc[2][2][4][2];
#pragma unroll
    for (int a = 0; a < 2; ++a)
#pragma unroll
        for (int b = 0; b < 2; ++b)
#pragma unroll
            for (int m = 0; m < 4; ++m)
#pragma unroll
                for (int n = 0; n < 2; ++n) acc[a][b][m][n] = (f32x4){0.f, 0.f, 0.f, 0.f};
    bf16x8 At[4][2], B0[2][2], B1[2][2];
    const char* cA = (const char*)g.A + (size_t)cur.pm * tstep; const char* cB = (const char*)g.Bt + (size_t)cur.pn * tstep;
    S.a_ready(cur);
    if constexpr (SP2) {
        PG8_STAGE(PG8_SB(0, 0), cB, voffB); PG8_STAGE(PG8_SB(0, 1), cB + hstep, voffB); PG8_STAGE(PG8_SA(0, 0), cA, voffA); PG8_STAGE(PG8_SA(0, 1), cA + hstep, voffA);
        if (wr == 1) PG8_BAR;
        PG8_WAIT_V(2); PG8_BAR;
        PG8_STAGE(PG8_SB(1, 0), cB + kstep, voffB); PG8_STAGE(PG8_SA(1, 0), cA + kstep, voffA); PG8_STAGE(PG8_SB(1, 1), cB + hstep + kstep, voffB);
        PG8_WAIT_V(6); PG8_BAR;
    } else {
        PG8_STAGE(PG8_SB(0, 0), cB, voffB); PG8_STAGE(PG8_SA(0, 0), cA, voffA); PG8_STAGE(PG8_SB(0, 1), cB + hstep, voffB); PG8_STAGE(PG8_SA(0, 1), cA + hstep, voffA);
        if (wr == 1) PG8_BAR;
        PG8_WAIT_V(4); PG8_BAR;
        PG8_STAGE(PG8_SB(1, 0), cB + kstep, voffB); PG8_STAGE(PG8_SA(1, 0), cA + kstep, voffA); PG8_STAGE(PG8_SB(1, 1), cB + hstep + kstep, voffB);
        PG8_WAIT_V(6); PG8_BAR;
    }
    for (;;) {
        const bool has_next = S.next(ui + 1, nxt);
        const char* nA = has_next ? (const char*)g.A + (size_t)nxt.pm * tstep : cA; const char* nB = has_next ? (const char*)g.Bt + (size_t)nxt.pn * tstep : cB;
        for (int t = 0; t < nt; t += 2) {
            if constexpr (Epi::HAS_MID) { if (t == (nt >> 1)) E.mid(acc, cur, wr, wc, fr, fq); }
            const bool last = (t == nt - 2);
            const char* a1 = cA + (size_t)(t + 1) * kstep;
            const char* a2 = last ? nA : cA + (size_t)(t + 2) * kstep; const char* b2 = last ? nB : cB + (size_t)(t + 2) * kstep;
            const char* a3 = a2 + kstep; const char* b3 = b2 + kstep;
            if (last && has_next) S.a_ready(nxt);
            if constexpr (SP2) {
            PG8_LDB(B0, 0, 0); PG8_LDB(B1, 0, 1); PG8_SCHED; PG8_LDA(At, 0, 0); PG8_STAGE(PG8_SA(1, 1), a1 + hstep, voffA);
            PG8_WAIT_V(8); PG8_WAIT_L(0); PG8_BAR; PG8_MMA(0, 0, At, B0); PG8_MMA(0, 1, At, B1); PG8_BAR; PG8_SCHED;
            PG8_LDA(At, 0, 1); PG8_STAGE(PG8_SB(0, 0), b2, voffB); PG8_STAGE(PG8_SB(0, 1), b2 + hstep, voffB); PG8_STAGE(PG8_SA(0, 0), a2, voffA);
            PG8_WAIT_V(8); PG8_WAIT_L(0); PG8_BAR; PG8_MMA(1, 0, At, B0); PG8_MMA(1, 1, At, B1); PG8_BAR; PG8_SCHED;
            PG8_LDB(B0, 1, 0); PG8_LDB(B1, 1, 1); PG8_SCHED; PG8_LDA(At, 1, 0); PG8_STAGE(PG8_SA(0, 1), a2 + hstep, voffA);
            PG8_WAIT_V(8); PG8_WAIT_L(0); PG8_BAR; PG8_MMA(0, 0, At, B0); PG8_MMA(0, 1, At, B1); PG8_BAR; PG8_SCHED;
            PG8_LDA(At, 1, 1); PG8_STAGE(PG8_SB(1, 0), b3, voffB); PG8_STAGE(PG8_SB(1, 1), b3 + hstep, voffB); PG8_STAGE(PG8_SA(1, 0), a3, voffA);
            PG8_WAIT_V(8); PG8_WAIT_L(0); PG8_BAR; PG8_MMA(1, 0, At, B0); PG8_MMA(1, 1, At, B1); PG8_BAR; PG8_SCHED;
            } else {
            PG8_LDB(B0, 0, 0); PG8_SCHED; PG8_LDA(At, 0, 0); PG8_STAGE(PG8_SA(1, 1), a1 + hstep, voffA);
            PG8_WAIT_L(8); PG8_BAR; PG8_WAIT_L(0); PG8_MMA(0, 0, At, B0); PG8_BAR; PG8_SCHED;
            PG8_LDB(B1, 0, 1); PG8_STAGE(PG8_SB(0, 0), b2, voffB);
            PG8_BAR; PG8_WAIT_L(0); PG8_MMA(0, 1, At, B1); PG8_BAR;
            PG8_LDA(At, 0, 1); PG8_STAGE(PG8_SA(0, 0), a2, voffA);
            PG8_BAR; PG8_WAIT_L(0); PG8_MMA(1, 0, At, B0); PG8_BAR; PG8_SCHED;
            PG8_STAGE(PG8_SB(0, 1), b2 + hstep, voffB);
            PG8_WAIT_V(6); PG8_BAR; PG8_MMA(1, 1, At, B1); PG8_BAR;
            PG8_LDB(B0, 1, 0); PG8_SCHED; PG8_LDA(At, 1, 0); PG8_STAGE(PG8_SA(0, 1), a2 + hstep, voffA);
            PG8_WAIT_L(8); PG8_BAR; PG8_WAIT_L(0); PG8_MMA(0, 0, At, B0); PG8_BAR; PG8_SCHED;
            PG8_LDB(B1, 1, 1); PG8_STAGE(PG8_SB(1, 0), b3, voffB);
            PG8_BAR; PG8_WAIT_L(0); PG8_MMA(0, 1, At, B1); PG8_BAR;
            PG8_LDA(At, 1, 1); PG8_STAGE(PG8_SA(1, 0), a3, voffA);
            PG8_BAR; PG8_WAIT_L(0); PG8_MMA(1, 0, At, B0); PG8_BAR; PG8_SCHED;
            PG8_STAGE(PG8_SB(1, 1), b3 + hstep, voffB);
            PG8_WAIT_V(6); PG8_BAR; PG8_MMA(1, 1, At, B1); PG8_BAR;
            }
        }
        if constexpr (ALIGN_EPI) { if (wr == 0) PG8_BAR; }
        if constexpr (!Epi::AFTER_DRAIN) { E(acc, cur, wr, wc, fr, fq); S.done(cur); }
        if (!has_next) break;
#pragma unroll
        for (int a = 0; a < 2; ++a)
#pragma unroll
            for (int b = 0; b < 2; ++b)
#pragma unroll
                for (int m = 0; m < 4; ++m)
#pragma unroll
                    for (int n = 0; n < 2; ++n) acc[a][b][m][n] = (f32x4){0.f, 0.f, 0.f, 0.f};
        cur = nxt; cA = nA; cB = nB; ++ui;
        if constexpr (ALIGN_EPI) { if (wr == 1) PG8_BAR; }
    }
    PG8_WAIT_V(0);
    if constexpr (!ALIGN_EPI) { if (wr == 0) PG8_BAR; }
    PG8_BAR;
    if constexpr (Epi::AFTER_DRAIN) { E.fused(acc, cur, wr, wc, fr, fq, lds, wid, lane); S.done(cur); }
#undef PG8_SA
#undef PG8_SB
#undef PG8_STAGE
#undef PG8_LDA
#undef PG8_LDB
#undef PG8_MMA
#undef PG8_WAIT_V
#undef PG8_WAIT_L
#undef PG8_BAR
#undef PG8_SCHED
}
}

namespace att {
using bf16 = unsigned short;
using bf16x8 = __attribute__((ext_vector_type(8))) short;
using s16x4  = __attribute__((ext_vector_type(4))) short;
using f32x16 = __attribute__((ext_vector_type(16))) float;
using u32x4  = __attribute__((ext_vector_type(4))) unsigned;
constexpr int D = 128, NW = 8, QBLK = 32, KVBLK = 64;
constexpr float SCALE = 0.088388347648318440f;
constexpr float THR = 8.f;
constexpr int LDQ = 1024, LDK = 256, LDO = 2048;
constexpr size_t SHM_V = KVBLK * D * 2, SHM_K = KVBLK * D * 2, SHM_ATTN = 2 * SHM_V + 2 * SHM_K + NW * 64 * 4;
#define KSWZ(row, colB) ((row) * 256 + ((colB) ^ (((row) & 7) << 4)))
#define SBAR() __builtin_amdgcn_sched_barrier(0)
__device__ __forceinline__ int crow(int r, int hi) { return (r & 3) + 8 * (r >> 2) + 4 * hi; }
typedef float f32x2a_t __attribute__((ext_vector_type(2))); typedef __bf16 bf16x2a_t __attribute__((ext_vector_type(2)));
__device__ __forceinline__ unsigned cvtpk(float lo, float hi) { f32x2a_t v = {lo, hi}; bf16x2a_t b = __builtin_convertvector(v, bf16x2a_t); return __builtin_bit_cast(unsigned, b); }
__device__ __forceinline__ void partialSM(f32x16& p0, f32x16& p1, float& m_reg, float& mn, float& alpha) {
  constexpr float C = SCALE * 1.4426950408889634f;
  float pmax = p0[0]; for (int r = 1; r < 16; ++r) pmax = fmaxf(pmax, p0[r]); for (int r = 0; r < 16; ++r) pmax = fmaxf(pmax, p1[r]);
  { auto rr = __builtin_amdgcn_permlane32_swap(__float_as_uint(pmax), __float_as_uint(pmax), false, false);
    pmax = fmaxf(__uint_as_float(rr[0]), __uint_as_float(rr[1])); }
  if (__builtin_expect(__all(pmax - m_reg <= THR / SCALE), 1)) { mn = m_reg; alpha = 1.f; }
  else { mn = fmaxf(m_reg, pmax); alpha = __builtin_amdgcn_exp2f((m_reg - mn) * C); m_reg = mn; }
  float mnC = -mn * C;
  for (int r = 0; r < 16; ++r) p0[r] = fmaf(p0[r], C, mnC); for (int r = 0; r < 16; ++r) p1[r] = fmaf(p1[r], C, mnC);
  for (int r = 0; r < 16; ++r) p0[r] = __builtin_amdgcn_exp2f(p0[r]);
}
__device__ __forceinline__ void finishSM(f32x16& p0, f32x16& p1, float alpha, float& l_reg, bf16x8& pa0, bf16x8& pa1, bf16x8& pa2, bf16x8& pa3) {
  for (int r = 0; r < 16; ++r) p1[r] = __builtin_amdgcn_exp2f(p1[r]);
  float ps = 0; for (int r = 0; r < 16; ++r) ps += p0[r]; for (int r = 0; r < 16; ++r) ps += p1[r];
  { auto rr = __builtin_amdgcn_permlane32_swap(__float_as_uint(ps), __float_as_uint(ps), false, false);
    ps = __uint_as_float(rr[0]) + __uint_as_float(rr[1]); }
  l_reg = l_reg * alpha + ps;
#define PK4(P, BASE, OUT) do { unsigned a0 = cvtpk(P[BASE + 0], P[BASE + 1]), a1 = cvtpk(P[BASE + 2], P[BASE + 3]);   \
    unsigned b0 = cvtpk(P[BASE + 4], P[BASE + 5]), b1 = cvtpk(P[BASE + 6], P[BASE + 7]);                              \
    auto r0 = __builtin_amdgcn_permlane32_swap(a0, b0, false, false); auto r1 = __builtin_amdgcn_permlane32_swap(a1, b1, false, false); \
    u32x4 w = {r0[0], r1[0], r0[1], r1[1]}; OUT = *reinterpret_cast<bf16x8*>(&w); } while (0)
  PK4(p0, 0, pa0); PK4(p0, 8, pa1); PK4(p1, 0, pa2); PK4(p1, 8, pa3);
#undef PK4
}
__device__ __forceinline__ void qkt(f32x16& p0, f32x16& p1, const bf16* Ks, const bf16x8* qr, int r32, int hi) {
  p0 = f32x16{}; p1 = f32x16{};
  for (int d0 = 0; d0 < 8; ++d0) { int cb = (d0 * 16 + hi * 8) * 2;
    bf16x8 b0 = *reinterpret_cast<const bf16x8*>((const char*)Ks + KSWZ(r32, cb));
    bf16x8 b1 = *reinterpret_cast<const bf16x8*>((const char*)Ks + KSWZ(32 + r32, cb));
    p0 = __builtin_amdgcn_mfma_f32_32x32x16_bf16(b0, qr[d0], p0, 0, 0, 0);
    p1 = __builtin_amdgcn_mfma_f32_32x32x16_bf16(b1, qr[d0], p1, 0, 0, 0); }
}
__device__ __forceinline__ void bandmask(f32x16& p0, f32x16& p1, int dk0, int hi) {
#pragma unroll
  for (int r = 0; r < 16; ++r) { const int dk = dk0 + crow(r, hi);
    if (dk < -128 || dk > 128) p0[r] = -1e30f;
    if (dk + 32 < -128 || dk + 32 > 128) p1[r] = -1e30f; }
}
__device__ __forceinline__ int v_st(int k, int c) { const int kk = (k & ~0xC) | ((k & 4) << 1) | ((k & 8) >> 1); return ((kk >> 3) * 4 + (c >> 5)) * 512 + ((kk & 7) * 32 + (c & 31)) * 2; }
__device__ __forceinline__ int v_rd_base(int lane) { return ((lane & 3) << 3) | (((lane >> 2) & 3) << 6) | (((lane >> 4) & 1) << 5) | (((lane >> 5) & 1) << 8); }
constexpr int v_rd_off(int d0, int ks, int half) { return d0 * 512 + ks * 4096 + half * 2048; }
template <int OFF> __device__ __forceinline__ s16x4 tr_read(int vb) {
  s16x4 r; asm volatile("ds_read_b64_tr_b16 %0, %1 offset:%2" : "=&v"(r) : "v"(vb), "i"(OFF) : "memory"); return r;
}
template <int D0> __device__ __forceinline__ void pv_one(f32x16& od, int vb, bf16x8 pa0, bf16x8 pa1, bf16x8 pa2, bf16x8 pa3) {
  const s16x4 l0 = tr_read<v_rd_off(D0, 0, 0)>(vb), h0 = tr_read<v_rd_off(D0, 0, 1)>(vb), l1 = tr_read<v_rd_off(D0, 1, 0)>(vb), h1 = tr_read<v_rd_off(D0, 1, 1)>(vb);
  const s16x4 l2 = tr_read<v_rd_off(D0, 2, 0)>(vb), h2 = tr_read<v_rd_off(D0, 2, 1)>(vb), l3 = tr_read<v_rd_off(D0, 3, 0)>(vb), h3 = tr_read<v_rd_off(D0, 3, 1)>(vb);
  asm volatile("s_waitcnt lgkmcnt(0)" ::: "memory"); SBAR();
#define PK(L, H) (bf16x8){L[0], L[1], L[2], L[3], H[0], H[1], H[2], H[3]}
  od = __builtin_amdgcn_mfma_f32_32x32x16_bf16(pa0, PK(l0, h0), od, 0, 0, 0);
  od = __builtin_amdgcn_mfma_f32_32x32x16_bf16(pa1, PK(l1, h1), od, 0, 0, 0);
  od = __builtin_amdgcn_mfma_f32_32x32x16_bf16(pa2, PK(l2, h2), od, 0, 0, 0);
  od = __builtin_amdgcn_mfma_f32_32x32x16_bf16(pa3, PK(l3, h3), od, 0, 0, 0);
#undef PK
}
__device__ __forceinline__ void pv_d0(f32x16* o, int vb, bf16x8 pa0, bf16x8 pa1, bf16x8 pa2, bf16x8 pa3) {
  pv_one<0>(o[0], vb, pa0, pa1, pa2, pa3); pv_one<1>(o[1], vb, pa0, pa1, pa2, pa3); pv_one<2>(o[2], vb, pa0, pa1, pa2, pa3); pv_one<3>(o[3], vb, pa0, pa1, pa2, pa3);
}

__device__ __forceinline__ void attn_unit(const bf16* __restrict__ Qb, const bf16* __restrict__ K0, const bf16* __restrict__ V0, int n0,
                                          const bf16* __restrict__ K1, const bf16* __restrict__ V1, int n1, int dq0, float sinkl2,
                                          bf16* __restrict__ Ob, char* lds) {
  int tid_l = threadIdx.x; asm volatile("" : "+v"(tid_l));
  const int tid = tid_l, wid = tid >> 6, lane = tid & 63, r32 = lane & 31, hi = lane >> 5;
  bf16* V_lds = (bf16*)lds; bf16* K_lds = (bf16*)(lds + 2 * SHM_V);
  float* ws = (float*)(lds + 2 * SHM_V + 2 * SHM_K) + wid * 64; float* li_l = ws; float* al_l = ws + 32;
  float m_reg = -1e30f, l_reg = 0; f32x16 o[4] = {}; bf16x8 qr[8];
  const bf16* Qw = Qb + (long)(wid * QBLK + r32) * LDQ + hi * 8;
#pragma unroll
  for (int d0 = 0; d0 < 8; ++d0) qr[d0] = *reinterpret_cast<const bf16x8*>(Qw + d0 * 16);
  const int sr = tid >> 4, sc = (tid & 15) * 8, vst0 = v_st(sr, sc), vst1 = v_st(32 + sr, sc);
  const int vb0 = (int)(uintptr_t)V_lds + v_rd_base(lane);
  const int dql = dq0 - (wid * QBLK + r32);
  struct { bf16x8 vs0, vs1, ks0, ks1; } sr_[2];
#define SLOAD(i, j) do { const int j_ = (j); const bf16* kt_ = j_ < n0 ? K0 + (long)j_ * (KVBLK * LDK) : K1 + (long)(j_ - n0) * (KVBLK * LDK); \
    const bf16* vt_ = j_ < n0 ? V0 + (long)j_ * (KVBLK * LDK) : V1 + (long)(j_ - n0) * (KVBLK * LDK); \
    sr_[i].vs0 = *reinterpret_cast<const bf16x8*>(&vt_[(long)sr * LDK + sc]); sr_[i].vs1 = *reinterpret_cast<const bf16x8*>(&vt_[(long)(32 + sr) * LDK + sc]); \
    sr_[i].ks0 = *reinterpret_cast<const bf16x8*>(&kt_[(long)sr * LDK + sc]); sr_[i].ks1 = *reinterpret_cast<const bf16x8*>(&kt_[(long)(32 + sr) * LDK + sc]); } while (0)
#define SWRITE(b, i) do { *(bf16x8*)((char*)V_lds + (b) * SHM_V + vst0) = sr_[i].vs0;          \
    *(bf16x8*)((char*)V_lds + (b) * SHM_V + vst1) = sr_[i].vs1; int kc = sc * 2;               \
    *(bf16x8*)((char*)K_lds + (b) * SHM_K + KSWZ(sr, kc)) = sr_[i].ks0;                       \
    *(bf16x8*)((char*)K_lds + (b) * SHM_K + KSWZ(32 + sr, kc)) = sr_[i].ks1; } while (0)
#define SWAIT() asm volatile("s_waitcnt vmcnt(4)" ::: "memory")
#define RESC(a) do { if (__any((a) < 1.f)) { if (hi == 0) al_l[r32] = (a); asm volatile("s_waitcnt lgkmcnt(0)" ::: "memory"); \
    for (int d = 0; d < 4; ++d) for (int r = 0; r < 16; ++r) o[d][r] *= al_l[crow(r, hi)]; } } while (0)
#define MASK(P0, P1, j) do { if ((j) >= n0) bandmask(P0, P1, dql + 64 * ((j) - n0), hi); } while (0)
  f32x16 pA0, pA1, pB0, pB1; float mnA, mnB, alA, alB; bf16x8 pa0, pa1, pa2, pa3; const int NT = n0 + n1;
  constexpr int SE = 0, SO = 1;
  SLOAD(SE, 0); SLOAD(SO, 1);
  asm volatile("s_waitcnt vmcnt(4)" ::: "memory"); SWRITE(0, SE); __syncthreads();
  qkt(pA0, pA1, K_lds, qr, r32, hi); partialSM(pA0, pA1, m_reg, mnA, alA);
  if (2 < NT) SLOAD(SE, 2);
  SWAIT(); SWRITE(1, SO); __syncthreads();
  for (int j = 1; j + 1 < NT; j += 2) {
    SBAR(); qkt(pB0, pB1, (bf16*)((char*)K_lds + SHM_K), qr, r32, hi); MASK(pB0, pB1, j);
    finishSM(pA0, pA1, alA, l_reg, pa0, pa1, pa2, pa3); SBAR();
    SLOAD(SO, j + 2); SBAR();
    pv_d0(o, vb0, pa0, pa1, pa2, pa3); partialSM(pB0, pB1, m_reg, mnB, alB);
    __syncthreads(); SWAIT(); SWRITE(0, SE);
    RESC(alB); __syncthreads();
    SBAR(); qkt(pA0, pA1, K_lds, qr, r32, hi); MASK(pA0, pA1, j + 1);
    finishSM(pB0, pB1, alB, l_reg, pa0, pa1, pa2, pa3); SBAR();
    if (j + 3 < NT) SLOAD(SE, j + 3); SBAR();
    pv_d0(o, vb0 + (int)SHM_V, pa0, pa1, pa2, pa3); partialSM(pA0, pA1, m_reg, mnA, alA);
    __syncthreads(); SWAIT(); SWRITE(1, SO);
    RESC(alA); __syncthreads();
  }
  SBAR(); qkt(pB0, pB1, (bf16*)((char*)K_lds + SHM_K), qr, r32, hi); MASK(pB0, pB1, NT - 1);
  finishSM(pA0, pA1, alA, l_reg, pa0, pa1, pa2, pa3); SBAR();
  pv_d0(o, vb0, pa0, pa1, pa2, pa3); partialSM(pB0, pB1, m_reg, mnB, alB);
  __syncthreads(); RESC(alB);
  finishSM(pB0, pB1, alB, l_reg, pa0, pa1, pa2, pa3); SBAR();
  pv_d0(o, vb0 + (int)SHM_V, pa0, pa1, pa2, pa3);
  l_reg += __builtin_amdgcn_exp2f(sinkl2 - m_reg * (SCALE * 1.4426950408889634f));
  if (hi == 0) li_l[r32] = l_reg; asm volatile("s_waitcnt lgkmcnt(0)" ::: "memory");
  float rli[16];
#pragma unroll
  for (int r = 0; r < 16; ++r) rli[r] = __builtin_amdgcn_rcpf(li_l[crow(r, hi)]);
  asm volatile("" ::: "memory");
  { char* stg = lds + 69632 + wid * 8192;
#pragma unroll
    for (int r = 0; r < 16; ++r) { const int orow = crow(r, hi);
#pragma unroll
      for (int d0 = 0; d0 < 4; ++d0) { const float v = o[d0][r] * rli[r]; *(bf16*)(stg + orow * 256 + (d0 * 32 + r32) * 2) = (bf16)cvtpk(v, v); } }
    asm volatile("s_waitcnt lgkmcnt(0)" ::: "memory");
    bf16* Ow = Ob + (long)(wid * QBLK) * LDO;
#pragma unroll
    for (int i = 0; i < 8; ++i) { const int row = i * 4 + (lane >> 4), ch = lane & 15; const u32x4 v = *(const u32x4*)(stg + row * 256 + ch * 16); *(u32x4*)(Ow + (long)row * LDO + ch * 8) = v; } }
  __syncthreads();
#undef SLOAD
#undef SWRITE
#undef SWAIT
#undef RESC
#undef MASK
}
#undef KSWZ
#undef SBAR
}

#define LAS __attribute__((address_space(3)))
typedef unsigned short bf16_t;
typedef unsigned v4u __attribute__((ext_vector_type(4)));
typedef float f32x4 __attribute__((ext_vector_type(4)));
typedef float f32x16 __attribute__((ext_vector_type(16)));
typedef short bf16x8 __attribute__((ext_vector_type(8)));
using pg8::bf2f; using pg8::dim_of_pos; using pg8::pos_of_dim;

constexpr int NL = 4, NINW = 5632, DFF = 4096, NMOD6 = 6144;
constexpr int NTOK = 16384, NCTX = 8192;
constexpr size_t MiB = 1u << 20;
constexpr size_t WS_CTL = 0, WS_MOD = 1 * MiB, WS_ROPE = 2 * MiB, WS_WIN = 3 * MiB, WS_WCAT = 47 * MiB, WS_WOUT = 63 * MiB, WS_W1 = 71 * MiB, WS_W2 = 103 * MiB,
                 WS_CK = 135 * MiB, WS_CV = 139 * MiB, WS_H = 143 * MiB, WS_Q = 175 * MiB, WS_KB = 207 * MiB, WS_VB = 215 * MiB, WS_XR = 223 * MiB, WS_G = 255 * MiB,
                 WS_ACAT = 319 * MiB, WS_PF = 383 * MiB, WS_PB = 399 * MiB, WS_SSQ = 415 * MiB, WS_SWIN = 416 * MiB, WS_SWUP = 416 * MiB + 512 * 1024, WS_WMOD = 417 * MiB, WS_X16 = 418 * MiB, WS_WFR = 450 * MiB, WS_END = 454 * MiB, WS_TOT = 512 * 1024, WS_U = WS_Q, WS_MERGED = WS_Q;
constexpr size_t OUT_K = 16777216, OUT_V = 25165824, OUT_S = 33554432;
constexpr int RING_BYTES = 131072, RED_OFF = 131072, MISC_OFF = RED_OFF + 8192, LDS_BYTES = 147456;
constexpr int CW_DONE = 1024;
constexpr int CW_QUEUE = 64;

#define XB_TMO      128
#define XB_XCNT(j)  (256  + 64 * (j))
#define XB_XSUB(j)  (1280 + 64 * (j))
#define XB_XGEN(j)  (2304 + 64 * (j))
#define XB_TOP      3328
#define XB_TOPGEN   3392
#define XCD_BAR_WORDS 3456
#define XB_SPIN_CAP (1u << 18)

__device__ __forceinline__ unsigned xb_ld(unsigned* p)              { return __hip_atomic_load(p, __ATOMIC_RELAXED, __HIP_MEMORY_SCOPE_AGENT); }
__device__ __forceinline__ unsigned xb_add(unsigned* p, unsigned v) { return __hip_atomic_fetch_add(p, v, __ATOMIC_RELAXED, __HIP_MEMORY_SCOPE_AGENT); }
__device__ __forceinline__ unsigned xb_xcc_id() { return (unsigned)__builtin_amdgcn_s_getreg((3 << 11) | 20) & 0xFu; }
#define XB_SPIN(cond, bar) do { unsigned _sp = 0; while (cond) { __builtin_amdgcn_s_sleep(1); \
    if ((++_sp & 255u) == 0u) { if (xb_ld(&(bar)[XB_TMO])) break; if (_sp > XB_SPIN_CAP) { atomicAdd(&(bar)[XB_TMO], 1u); break; } } } } while (0)

struct XcdBarrier {
    unsigned* bar; unsigned x;
    volatile LAS unsigned* st;
};

__device__ __forceinline__ XcdBarrier xcd_barrier_post(unsigned* bar, volatile LAS unsigned* st) {
    XcdBarrier b; b.bar = bar; b.x = xb_xcc_id(); b.st = st;
    if (threadIdx.x == 0) (void)xb_add(&bar[XB_XCNT(b.x)], 1u);
    return b;
}
__device__ __forceinline__ void xcd_barrier_complete(unsigned* bar, unsigned x, unsigned& nloc, unsigned& nx) {
    const unsigned G = gridDim.x * gridDim.y * gridDim.z;
    unsigned sum, cnt, mine, sp = 0u;
    for (;;) {
        sum = 0u; cnt = 0u; mine = 0u;
#pragma unroll
        for (unsigned j = 0; j < 16; ++j) { const unsigned c = xb_ld(&bar[XB_XCNT(j)]); sum += c; cnt += (c > 0u) ? 1u : 0u; mine = (j == x) ? c : mine; }
        if (sum == G) break;
        __builtin_amdgcn_s_sleep(1);
        if ((++sp & 255u) == 0u) { if (xb_ld(&bar[XB_TMO])) break; if (sp > XB_SPIN_CAP) { atomicAdd(&bar[XB_TMO], 1u); break; } }
    }
    nloc = mine > 0u ? mine : 1u; nx = cnt > 0u ? cnt : 1u;
}

__device__ __forceinline__ void xcd_barrier(const XcdBarrier& b) {
    asm volatile("s_waitcnt vmcnt(0)" ::: "memory");
    __syncthreads();
    if (threadIdx.x == 0) {
        unsigned* bar = b.bar;
        __builtin_amdgcn_s_waitcnt(0);
        unsigned nloc = b.st[0], nx = b.st[1];
        if (nloc == 0u) { xcd_barrier_complete(bar, b.x, nloc, nx); b.st[0] = nloc; b.st[1] = nx; }
        const unsigned old = xb_add(&bar[XB_XSUB(b.x)], 1u);
        const unsigned gen = old / nloc;
        if (old + 1u == (gen + 1u) * nloc) {
            __builtin_amdgcn_fence(__ATOMIC_RELEASE, "agent");
            asm volatile("s_waitcnt vmcnt(0)" ::: "memory");
            const unsigned og = xb_add(&bar[XB_TOP], 1u);
            const unsigned tg = og / nx;
            if (og + 1u == (tg + 1u) * nx) xb_add(&bar[XB_TOPGEN], 1u);
            else XB_SPIN(xb_ld(&bar[XB_TOPGEN]) == tg, bar);
            __builtin_amdgcn_fence(__ATOMIC_ACQUIRE, "agent");
            xb_add(&bar[XB_XGEN(b.x)], 1u);
            asm volatile("s_waitcnt vmcnt(0)" ::: "memory");
        } else {
            XB_SPIN(xb_ld(&bar[XB_XGEN(b.x)]) == gen, bar);
            __builtin_amdgcn_fence(__ATOMIC_ACQUIRE, "agent");
            asm volatile("s_waitcnt vmcnt(0)" ::: "memory");
        }
    }
    __syncthreads();
}

constexpr int CW_BAR = 4096;

__device__ __forceinline__ int opaque_bid() { int b = blockIdx.x; asm volatile("" : "+s"(b)); return b; }
#ifndef XREP_MIX
#define XREP_MIX 1
#endif
struct OneUnit { int pm, pn;
    __device__ __forceinline__ bool next(int i, pg8::Unit& u) const { if (i != 0) return false; u.pm = pm; u.pn = pn; return true; }
    __device__ __forceinline__ void a_ready(const pg8::Unit&) const {}
    __device__ __forceinline__ void done(const pg8::Unit&) const {} };
struct Params { const float* in[27]; float* out; unsigned char* ws; int ph_lo, ph_hi; };

__device__ __forceinline__ unsigned f2bf(float f) { unsigned u = __builtin_bit_cast(unsigned, f); return (u + 0x7fffu + ((u >> 16) & 1u)) >> 16; }
__device__ __forceinline__ unsigned pk2(float lo, float hi) { return att::cvtpk(lo, hi); }
__device__ __forceinline__ unsigned short f2bfh(float x) { return (unsigned short)att::cvtpk(x, x); }
__device__ __forceinline__ float wave_sum(float v) {
#pragma unroll
    for (int o = 1; o < 64; o <<= 1) v += __shfl_xor(v, o);
    return v;
}

template <bool PERMQK>
__device__ __forceinline__ void tr_item(const float* W, int K, int N, bf16_t* WT, int ldk, int koff, LAS float* scr, int item, int lane) {
    const int nblk = N / 32, kb = item / nblk, nb = item % nblk, k0 = 64 * kb, n0 = 32 * nb;
    float tv[32];
#pragma unroll
    for (int i = 0; i < 32; ++i) { const int kk = 2 * i + (lane >> 5); tv[i] = __builtin_nontemporal_load(&W[(size_t)(k0 + kk) * N + n0 + (lane & 31)]); }
#pragma unroll
    for (int i = 0; i < 32; ++i) { const int kk = 2 * i + (lane >> 5); scr[kk * 33 + (lane & 31)] = tv[i]; }
    asm volatile("s_waitcnt lgkmcnt(0)" ::: "memory");
    const int c = lane & 7;
#pragma unroll
    for (int j = 0; j < 4; ++j) { const int n = (lane >> 3) + 8 * j; const LAS float* s = scr + (8 * c) * 33 + n;
        v4u o; o.x = pk2(s[0 * 33], s[1 * 33]); o.y = pk2(s[2 * 33], s[3 * 33]); o.z = pk2(s[4 * 33], s[5 * 33]); o.w = pk2(s[6 * 33], s[7 * 33]);
        int nn = n0 + n; if (PERMQK && nn < 1280) nn = (nn & ~127) | pos_of_dim(nn & 127);
        *(v4u*)(WT + (size_t)nn * ldk + koff + k0 + 8 * c) = o; }
    asm volatile("s_waitcnt lgkmcnt(0)" ::: "memory");
}

__device__ __forceinline__ void norm_row(const float* xrow, const float* nw, const float* sh, const float* sc, bf16_t* orow, int lane) {
    const f32x4* xr = (const f32x4*)xrow + lane;
    f32x4 v[4]; float s = 0.f;
#pragma unroll
    for (int j = 0; j < 4; ++j) { v[j] = xr[64 * j]; s += (v[j][0] * v[j][0] + v[j][1] * v[j][1]) + (v[j][2] * v[j][2] + v[j][3] * v[j][3]); }
    const float rstd = __builtin_amdgcn_rsqf(wave_sum(s) * (1.f / 1024.f) + 1e-6f);
    unsigned long long* o8 = (unsigned long long*)orow + lane;
#pragma unroll
    for (int j = 0; j < 4; ++j) { const f32x4 w = ((const f32x4*)nw)[lane + 64 * j], a = ((const f32x4*)sc)[lane + 64 * j], b = ((const f32x4*)sh)[lane + 64 * j];
        const f32x4 y = v[j] * rstd * w * (1.0f + a) + b;
        o8[64 * j] = (unsigned long long)pk2(y[0], y[1]) | ((unsigned long long)pk2(y[2], y[3]) << 32); }
}
__device__ __forceinline__ void norm_phase(const Params& P, int layer, int which  , bool first) {
    int tid_l = threadIdx.x; asm volatile("" : "+v"(tid_l));
    const int lane = tid_l & 63, wave = tid_l >> 6, gw = blockIdx.x * 8 + wave, NGW = gridDim.x * 8;
    const float* mod = (const float*)(P.ws + WS_MOD) + (size_t)layer * 5 * NMOD6 + which * 3072;
    const float* nw = P.in[which ? 10 : 9] + layer * 1024;
#define RS_RESET() do { __syncthreads(); if (threadIdx.x == 0) ((LAS int*)(lds + RED_OFF))[2048 + 64 + 256] = -1; __syncthreads(); } while (0)
    bf16_t* H = (bf16_t*)(P.ws + WS_H);
    for (int row = gw; row < NTOK; row += NGW) {
        const int cond = row < NCTX ? 0 : 1 + ((row - NCTX) >> 11);
        const float* x = first ? (row < NCTX ? P.in[0] + (size_t)row * 1024 : P.in[1] + (size_t)(row - NCTX) * 1024) : P.out + (size_t)row * 1024;
        norm_row(x, nw, mod + cond * NMOD6, mod + cond * NMOD6 + 1024, H + (size_t)row * 1024, lane);
    }
}

__device__ __forceinline__ void prep_phase(const Params& P, LAS unsigned char* lds) {
    int tid_l = threadIdx.x; asm volatile("" : "+v"(tid_l));
    const int tid = tid_l, lane = tid & 63, wave = tid >> 6, G = gridDim.x, gw = blockIdx.x * 8 + wave, NGW = G * 8;
    const float* MOD = (const float*)(P.ws + WS_MOD);
    for (int i = blockIdx.x * 512 + tid; i < NL * 2 * 5 * 1024; i += G * 512) {
        const int c = i & 1023, cond = (i >> 10) % 5, w = ((i >> 10) / 5) & 1, l = (i >> 10) / 10;
        ((float*)(P.ws + WS_WMOD))[i] = P.in[w ? 10 : 9][l * 1024 + c] * (1.0f + MOD[(size_t)(l * 5 + cond) * NMOD6 + (w ? 4 : 1) * 1024 + c]);
    }
    {
        const int r32 = lane & 31, hi = lane >> 5;
        constexpr int T_IN = NINW / 32, T_UP = DFF / 32, T_L = T_IN + T_UP;
        for (int tix = gw; tix < NL * T_L; tix += NGW) {
            const int l = tix / T_L, r = tix % T_L, w = r >= T_IN, n0 = 32 * (w ? r - T_IN : r), N = w ? DFF : NINW;
            const bf16_t* Wt = (w ? (const bf16_t*)(P.ws + WS_W1) + (size_t)l * DFF * 1024 : (const bf16_t*)(P.ws + WS_WIN) + (size_t)l * NINW * 1024) + (size_t)(n0 + r32) * 1024 + 8 * hi;
            const float* shp = MOD + (size_t)(l * 5 + (r32 < 5 ? r32 : 0)) * NMOD6 + (w ? 3 : 0) * 1024 + 8 * hi;
            f32x16 acc = {};
#pragma unroll 8
            for (int ks = 0; ks < 64; ++ks) {
                const bf16x8 bfr = *(const bf16x8*)(Wt + 16 * ks);
                bf16x8 afr = {0, 0, 0, 0, 0, 0, 0, 0};
                if (r32 < 5) { const f32x4 s0 = *(const f32x4*)(shp + 16 * ks), s1 = *(const f32x4*)(shp + 16 * ks + 4);
                    v4u t; t.x = pk2(s0[0], s0[1]); t.y = pk2(s0[2], s0[3]); t.z = pk2(s1[0], s1[1]); t.w = pk2(s1[2], s1[3]); afr = __builtin_bit_cast(bf16x8, t); }
                acc = __builtin_amdgcn_mfma_f32_32x32x16_bf16(afr, bfr, acc, 0, 0, 0);
            }
            float* SW = w ? (float*)(P.ws + WS_SWUP) + (size_t)l * 5 * DFF : (float*)(P.ws + WS_SWIN) + (size_t)l * 5 * NINW;
            if (hi == 0) { SW[(size_t)0 * N + n0 + r32] = acc[0]; SW[(size_t)1 * N + n0 + r32] = acc[1]; SW[(size_t)2 * N + n0 + r32] = acc[2]; SW[(size_t)3 * N + n0 + r32] = acc[3]; }
            else SW[(size_t)4 * N + n0 + r32] = acc[0];
        }
    }
    bf16_t* H = (bf16_t*)(P.ws + WS_H); float* SSQ = (float*)(P.ws + WS_SSQ);
    for (int row = gw; row < NTOK; row += NGW) {
        const int cond = row < NCTX ? 0 : 1 + ((row - NCTX) >> 11);
        const float* x = row < NCTX ? P.in[0] + (size_t)row * 1024 : P.in[1] + (size_t)(row - NCTX) * 1024;
        const f32x4* xr = (const f32x4*)x + lane; const f32x4* nw = (const f32x4*)P.in[9] + lane; const f32x4* sc = (const f32x4*)(MOD + (size_t)cond * NMOD6 + 1024) + lane;
        unsigned long long* o8 = (unsigned long long*)(H + (size_t)row * 1024) + lane;
        float s = 0.f;
#pragma unroll
        for (int j = 0; j < 4; ++j) { const f32x4 v = xr[64 * j]; s += (v[0] * v[0] + v[1] * v[1]) + (v[2] * v[2] + v[3] * v[3]);
            const f32x4 y = v * nw[64 * j] * (1.0f + sc[64 * j]);
            o8[64 * j] = (unsigned long long)pk2(y[0], y[1]) | ((unsigned long long)pk2(y[2], y[3]) << 32); }
        s = wave_sum(s);
        if (lane < 16) SSQ[(size_t)row * 16 + lane] = lane == 0 ? s : 0.f;
    }
}

__device__ __forceinline__ void prologue(const Params& P, LAS unsigned char* lds) {
    int tid_l = threadIdx.x; asm volatile("" : "+v"(tid_l));
    const int tid = tid_l, lane = tid & 63, wave = tid >> 6, G = gridDim.x;
    const int gw = blockIdx.x * 8 + wave, NGW = G * 8;
    LAS float* scr = (LAS float*)(lds + wave * 16384);
    constexpr int I_IN = 16 * 176, I_O = 16 * 32, I_1 = 16 * 128, I_2 = 64 * 32, I_L = I_IN + 3 * I_O + I_1 + I_2;
    for (int it = gw; it < NL * I_L; it += NGW) {
        const int l = it / I_L; int r = it % I_L;
        if (r < I_IN) { tr_item<true>(P.in[11] + (size_t)l * 1024 * NINW, 1024, NINW, (bf16_t*)(P.ws + WS_WIN) + (size_t)l * NINW * 1024, 1024, 0, scr, r, lane); continue; } r -= I_IN;
        if (r < I_O) { tr_item<false>(P.in[22] + (size_t)l * 1024 * 1024, 1024, 1024, (bf16_t*)(P.ws + WS_WCAT) + (size_t)l * 1024 * 2048, 2048, 0, scr, r, lane); continue; } r -= I_O;
        if (r < I_O) { tr_item<false>(P.in[23] + (size_t)l * 1024 * 1024, 1024, 1024, (bf16_t*)(P.ws + WS_WCAT) + (size_t)l * 1024 * 2048, 2048, 1024, scr, r, lane); continue; } r -= I_O;
        if (r < I_O) { tr_item<false>(P.in[24] + (size_t)l * 1024 * 1024, 1024, 1024, (bf16_t*)(P.ws + WS_WOUT) + (size_t)l * 1024 * 1024, 1024, 0, scr, r, lane); continue; } r -= I_O;
        if (r < I_1) { tr_item<false>(P.in[25] + (size_t)l * 1024 * DFF, 1024, DFF, (bf16_t*)(P.ws + WS_W1) + (size_t)l * DFF * 1024, 1024, 0, scr, r, lane); continue; } r -= I_1;
        tr_item<false>(P.in[26] + (size_t)l * DFF * 1024, DFF, 1024, (bf16_t*)(P.ws + WS_W2) + (size_t)l * 1024 * DFF, DFF, 0, scr, r, lane);
    }
    __syncthreads();
    {
        LAS float* sv = (LAS float*)lds; LAS float* rb = (LAS float*)(lds + 20480);
        for (int i = tid; i < 5120; i += 512) { const int cond = i >> 10, k = i & 1023; const float x = cond == 0 ? P.in[6][k] : P.in[5][(cond - 1) * 1024 + k]; sv[i] = x * __builtin_amdgcn_rcpf(1.0f + __expf(-x)); }
        __syncthreads();
        for (int it = blockIdx.x; it < NL * 96; it += G) {
            const int l = it / 96, cg_ = it % 96;
            const float* W = P.in[7] + ((size_t)l * 1024 + wave * 128) * NMOD6 + cg_ * 64 + lane;
            float a0 = 0.f, a1 = 0.f, a2 = 0.f, a3 = 0.f, a4 = 0.f;
#pragma unroll 16
            for (int k = 0; k < 128; ++k) { const float w = __builtin_nontemporal_load(&W[(size_t)k * NMOD6]); const int kk = wave * 128 + k;
                a0 += sv[kk] * w; a1 += sv[1024 + kk] * w; a2 += sv[2048 + kk] * w; a3 += sv[3072 + kk] * w; a4 += sv[4096 + kk] * w; }
            rb[(wave * 5 + 0) * 64 + lane] = a0; rb[(wave * 5 + 1) * 64 + lane] = a1; rb[(wave * 5 + 2) * 64 + lane] = a2; rb[(wave * 5 + 3) * 64 + lane] = a3; rb[(wave * 5 + 4) * 64 + lane] = a4;
            __syncthreads();
            if (tid < 320) { const int cond = tid >> 6; float s = 0.f;
#pragma unroll
                for (int w = 0; w < 8; ++w) s += rb[(w * 5 + cond) * 64 + lane];
                s += P.in[8][l * NMOD6 + cg_ * 64 + lane];
                ((float*)(P.ws + WS_MOD))[(size_t)(l * 5 + cond) * NMOD6 + cg_ * 64 + lane] = s; }
            __syncthreads();
        }
    }
    const int gt = blockIdx.x * 512 + tid, NGT = G * 512;
#ifdef NANFILL
    { v4u nanv = {0x7FC07FC0u, 0x7FC07FC0u, 0x7FC07FC0u, 0x7FC07FC0u};
      v4u* a = (v4u*)(P.ws + WS_H); const size_t na = (WS_END - WS_H) / 16;
      for (size_t i = gt; i < na; i += NGT) a[i] = nanv;
      v4u* o = (v4u*)P.out; const size_t no = (size_t)(33554432 + 262144) / 4;
      for (size_t i = gt; i < no; i += NGT) o[i] = nanv; }
#endif
    for (int i = gt; i < 4 * 4 * 512 * 256 / 2; i += NGT) {
        const int e = 2 * i, p = e & 127, base = e & ~127;
        const float* ck = P.in[2] + base;
        ((unsigned*)(P.ws + WS_CK))[i] = pk2(ck[dim_of_pos(p)], ck[dim_of_pos(p + 1)]);
        ((unsigned*)(P.ws + WS_CV))[i] = pk2(P.in[3][e], P.in[3][e + 1]);
    }
    for (int i = gt; i < NL * 2 * 8 * 2 * 4 * 8 * 64; i += NGT) {
        const int ln = i & 63, ks = (i >> 6) & 7, w4 = (i >> 9) & 3, gate = (i >> 11) & 1, nb = (i >> 12) & 7, dr = (i >> 15) & 1, l = i >> 16;
        const float* W = (gate ? P.in[20] : P.in[18]) + ((size_t)((l * 2 + dr) * 8 + nb) * 128) * 128 + w4 * 32 + (ln & 31);
        float v[8];
#pragma unroll
        for (int j = 0; j < 8; ++j) v[j] = W[(16 * ks + 8 * (ln >> 5) + j) * 128];
        v4u o; o.x = pk2(v[0], v[1]); o.y = pk2(v[2], v[3]); o.z = pk2(v[4], v[5]); o.w = pk2(v[6], v[7]);
        ((v4u*)(P.ws + WS_WFR))[i] = o;
    }
    for (int i = gt; i < 2048 * 64; i += NGT) {
        const int t = i >> 6, pi = i & 63, ax = pi >> 5, fi = pi & 31;
        const float freq = powf(10000.0f, -(float)(2 * fi) / 64.0f);
        const float ang = (float)(ax == 0 ? (t >> 6) : (t & 63)) * freq;
        float* o = (float*)(P.ws + WS_ROPE) + (size_t)i * 2; o[0] = cosf(ang); o[1] = sinf(ang);
    }
}

__device__ __forceinline__ int crow16(int r, int hi) { return (r & 3) + 8 * (r >> 2) + 4 * hi; }
__device__ __forceinline__ float partner32(float x, int hi) { auto rr = __builtin_amdgcn_permlane32_swap(__float_as_uint(x), __float_as_uint(x), false, false); return __uint_as_float(hi ? rr[0] : rr[1]); }
__device__ __forceinline__ void lru_unit(const Params& P, int layer, int latent, int b, int seg, int nblk, LAS unsigned char* lds) {
    int tid_l = threadIdx.x; asm volatile("" : "+v"(tid_l));
    const int tid = tid_l, lane = tid & 63, r32 = lane & 31, hi = lane >> 5;
    const int wid = __builtin_amdgcn_readfirstlane(tid >> 6), dir = wid >> 2, w4 = wid & 3, gt = tid & 255;
    constexpr int nch = 8;
    const int Tseq = latent ? 2048 : 256, t0seg = seg * 256;
    const int rowseq = latent ? NCTX + b * 2048 : b * 256, rowbase = rowseq + t0seg;
    const int chl = w4 * 32 + r32, ch = nblk * 128 + chl;
    constexpr int TILEB = 32 * 272;
    LAS unsigned char* tiles = lds;
    LAS float* cw = (LAS float*)(lds + 8 * TILEB);
    const bf16_t* XR = (const bf16_t*)(P.ws + WS_XR);
    bf16_t* HT = ((bf16_t*)P.out + (size_t)16777216);
    bf16_t* ACAT = (bf16_t*)(P.ws + WS_ACAT);
    bf16_t* PD = (bf16_t*)(P.ws + (dir ? WS_PB : WS_PF));
    for (int i = tid; i < 640; i += 512) cw[i] = (i < 512) ? P.in[15][((size_t)layer * 4 + (i >> 7)) * 1024 + nblk * 128 + (i & 127)] : P.in[16][layer * 1024 + nblk * 128 + (i & 127)];
    bf16x8 bR[8], bI0;
    LAS unsigned char* wib = lds + 72704 + wid * 7168 + lane * 16;
    {
        const v4u* fr = (const v4u*)(P.ws + WS_WFR) + ((size_t)(((layer * 2 + dir) * 8 + nblk) * 2) * 4 + w4) * 512 + lane;
#pragma unroll
        for (int ks = 0; ks < 8; ++ks) { const v4u a = fr[ks * 64], g = fr[2048 + ks * 64];
            bR[ks] = __builtin_bit_cast(bf16x8, a); if (ks == 0) bI0 = __builtin_bit_cast(bf16x8, g); else *(LAS v4u*)(wib + (ks - 1) * 1024) = g; }
    }
    const float ba = P.in[19][(layer * 2 + dir) * 1024 + ch], bi = P.in[21][(layer * 2 + dir) * 1024 + ch];
    const float lam = P.in[17][(layer * 2 + dir) * 1024 + ch];
    const float clam = -8.0f * 1.4426950408889634f * log1pf(__expf(-lam));
    float h = 0.f, p = 1.f;
    const int st = 2 * (gt >> 4), c8 = (gt & 15) * 8;
    const int strow = 8 * ((st & 15) >> 2) + 4 * (st >> 4) + (st & 3);
    v4u pre[5];
#define LRU_LOAD(ck_) do { const int ck__ = (ck_); _Pragma("unroll") for (int i = 0; i < 5; ++i) { \
        const int tt = t0seg + ck__ * 32 + st + i - 2; \
        pre[i] = (tt >= 0 && tt < Tseq) ? *(const v4u*)(XR + (size_t)(rowseq + tt) * 1024 + nblk * 128 + c8) : (v4u){0u, 0u, 0u, 0u}; } } while (0)
#define LRU_CONV(buf_) do { float y0[8], y1[8]; { const f32x4 b0 = *(const LAS f32x4*)(cw + 512 + c8), b1 = *(const LAS f32x4*)(cw + 512 + c8 + 4); \
            _Pragma("unroll") for (int j = 0; j < 4; ++j) { y0[j] = b0[j]; y0[4 + j] = b1[j]; y1[j] = b0[j]; y1[4 + j] = b1[j]; } } \
        _Pragma("unroll") for (int k = 0; k < 4; ++k) { const f32x4 w0 = *(const LAS f32x4*)(cw + k * 128 + c8), w1 = *(const LAS f32x4*)(cw + k * 128 + c8 + 4); \
            const v4u xa = pre[k], xb = pre[k + 1]; \
            _Pragma("unroll") for (int q = 0; q < 4; ++q) { const float wlo = q < 2 ? w0[2 * q] : w1[2 * q - 4], whi = q < 2 ? w0[2 * q + 1] : w1[2 * q - 3]; \
                y0[2 * q] += wlo * __uint_as_float(xa[q] << 16); y0[2 * q + 1] += whi * __uint_as_float(xa[q] & 0xffff0000u); \
                y1[2 * q] += wlo * __uint_as_float(xb[q] << 16); y1[2 * q + 1] += whi * __uint_as_float(xb[q] & 0xffff0000u); } } \
        v4u o; o.x = pk2(y0[0], y0[1]); o.y = pk2(y0[2], y0[3]); o.z = pk2(y0[4], y0[5]); o.w = pk2(y0[6], y0[7]); \
        *(LAS v4u*)(tiles + (buf_) * TILEB + strow * 272 + c8 * 2) = o; \
        o.x = pk2(y1[0], y1[1]); o.y = pk2(y1[2], y1[3]); o.z = pk2(y1[4], y1[5]); o.w = pk2(y1[6], y1[7]); \
        *(LAS v4u*)(tiles + (buf_) * TILEB + (strow + 1) * 272 + c8 * 2) = o; } while (0)
    LRU_LOAD(dir ? nch - 1 : 0);
    __syncthreads();
    LRU_CONV(dir ? nch - 1 : 0);
    __syncthreads();
    for (int k = 0; k < nch; ++k) {
        const int ck = dir ? nch - 1 - k : k;
        const LAS unsigned char* tile = tiles + ck * TILEB;
        f32x16 aR = {}, aI = {};
#pragma unroll
        for (int ks = 0; ks < 8; ++ks) { const bf16x8 af = *(const LAS bf16x8*)(tile + r32 * 272 + (16 * ks + 8 * hi) * 2);
            aR = __builtin_amdgcn_mfma_f32_32x32x16_bf16(af, bR[ks], aR, 0, 0, 0);
            aI = __builtin_amdgcn_mfma_f32_32x32x16_bf16(af, ks == 0 ? bI0 : *(const LAS bf16x8*)(wib + (ks - 1) * 1024), aI, 0, 0, 0); }
        float av[16], bv[16];
#pragma unroll
        for (int r = 0; r < 16; ++r) { const int t = crow16(r, hi);
            const float x = bf2f(*(const LAS unsigned short*)(tile + t * 272 + chl * 2));
            const float eu = 1.0f + __builtin_amdgcn_exp2f(-1.4426950408889634f * (aR[r] + ba)), ev = 1.0f + __builtin_amdgcn_exp2f(-1.4426950408889634f * (aI[r] + bi));
            const float inv = __builtin_amdgcn_rcpf(eu * ev);
            const float rr = ev * inv, ii = eu * inv;
            const float a = __builtin_amdgcn_exp2f(clam * rr);
            av[r] = a; bv[r] = __builtin_amdgcn_sqrtf(fmaxf(fmaf(-a, a, 1.0f), 0.f)) * (ii * x); }
        if (k < 3) LRU_LOAD(dir ? nch - 2 - k : k + 1);
        if (dir == 0) {
#pragma unroll
            for (int r = 1; r < 16; ++r) { bv[r] = fmaf(av[r], bv[r - 1], bv[r]); av[r] *= av[r - 1]; }
            const float ho = fmaf(av[15], h, bv[15]), po = av[15] * p;
            const float nh = partner32(ho, hi), np = partner32(po, hi);
            const float hin = hi ? nh : h, pin = hi ? np : p;
#pragma unroll
            for (int r = 0; r < 16; ++r) { bv[r] = fmaf(av[r], hin, bv[r]); av[r] *= pin; }
            const float eh = partner32(bv[15], hi), ep = partner32(av[15], hi);
            h = hi ? bv[15] : eh; p = hi ? av[15] : ep;
        } else {
#pragma unroll
            for (int r = 14; r >= 0; --r) { bv[r] = fmaf(av[r], bv[r + 1], bv[r]); av[r] *= av[r + 1]; }
            const float ho = fmaf(av[0], h, bv[0]), po = av[0] * p;
            const float nh = partner32(ho, hi), np = partner32(po, hi);
            const float hin = hi ? h : nh, pin = hi ? p : np;
#pragma unroll
            for (int r = 0; r < 16; ++r) { bv[r] = fmaf(av[r], hin, bv[r]); av[r] *= pin; }
            const float eh = partner32(bv[0], hi), ep = partner32(av[0], hi);
            h = hi ? eh : bv[0]; p = hi ? ep : av[0];
        }
        {
            char* hb_ = dir ? (char*)ACAT + (size_t)(rowbase + ck * 32) * 4096 + 2048 : (char*)HT + (size_t)(rowbase + ck * 32) * 2048;
            const unsigned rs_ = dir ? 4096u : 2048u;
            const unsigned lo1 = (unsigned)(16 * hi) * rs_ + (unsigned)(ch * 2);
#pragma unroll
            for (int r = 0; r < 16; ++r) *(bf16_t*)(hb_ + (lo1 + (unsigned)r * rs_)) = f2bfh(bv[r]);
            if (latent) {
                char* pdb = (char*)PD + (size_t)(rowbase - NCTX + ck * 32) * 2048;
                const unsigned lo2 = (unsigned)((16 * hi) * 2048 + ch * 2);
#pragma unroll
                for (int r = 0; r < 16; ++r) *(bf16_t*)(pdb + (lo2 + (unsigned)(r * 2048))) = f2bfh(av[r]);
            }
        }
        if (k < 3) LRU_CONV(dir ? nch - 2 - k : k + 1);
        asm volatile("s_waitcnt lgkmcnt(0)\n\ts_barrier" ::: "memory");
    }
    if (hi == 0) {
        if (latent) { float* tot = (float*)(P.ws + WS_TOT) + ((size_t)(((b * 8 + nblk) * 8 + seg) * 2 + dir) * 2) * 128 + chl; tot[0] = p; tot[128] = h; }
        else P.out[OUT_S + ((size_t)(b * 4 + layer) * 2 + dir) * 1024 + ch] = h;
    }
    asm volatile("s_waitcnt vmcnt(0)" ::: "memory"); __syncthreads();
    if (!latent) {
        const bf16_t* GXB = ((const bf16_t*)P.out);
#pragma unroll
        for (int hb4 = 0; hb4 < 2; ++hb4) {
            v4u hf[4], hb[4], gx[4];
#pragma unroll
            for (int i = 0; i < 4; ++i) { const int it = tid + (hb4 * 4 + i) * 512; const size_t row = (size_t)rowbase + (it >> 4); const int col = nblk * 128 + (it & 15) * 8;
                hf[i] = *(const v4u*)(HT + row * 1024 + col); hb[i] = *(const v4u*)(ACAT + row * 2048 + 1024 + col); gx[i] = *(const v4u*)(GXB + row * 1024 + col); }
#pragma unroll
            for (int i = 0; i < 4; ++i) { const int it = tid + (hb4 * 4 + i) * 512; const size_t row = (size_t)rowbase + (it >> 4); const int col = nblk * 128 + (it & 15) * 8;
                v4u o;
#pragma unroll
                for (int q = 0; q < 4; ++q) {
                    const float ylo = (__uint_as_float(hf[i][q] << 16) + __uint_as_float(hb[i][q] << 16)) * __uint_as_float(gx[i][q] << 16);
                    const float yhi = (__uint_as_float(hf[i][q] & 0xffff0000u) + __uint_as_float(hb[i][q] & 0xffff0000u)) * __uint_as_float(gx[i][q] & 0xffff0000u);
                    o[q] = pk2(ylo, yhi); }
                *(v4u*)(ACAT + row * 2048 + 1024 + col) = o; }
        }
    }
    if (latent) {
        if (tid == 0) { __builtin_amdgcn_fence(__ATOMIC_RELEASE, "agent"); asm volatile("s_waitcnt vmcnt(0)" ::: "memory");
            __hip_atomic_fetch_add((unsigned*)(P.ws + WS_CTL) + CW_DONE + ((layer * 4 + b) * 8 + nblk) * 16, 1u, __ATOMIC_RELAXED, __HIP_MEMORY_SCOPE_AGENT); }
    }
#undef LRU_LOAD
#undef LRU_CONV
}

__device__ __forceinline__ void lru_fix_unit(const Params& P, int layer, int u, LAS unsigned char* lds) {
    int tid_l = threadIdx.x; asm volatile("" : "+v"(tid_l));
    const int tid = tid_l;
    LAS float* carr = (LAS float*)lds;
    const bf16_t* HT = ((const bf16_t*)P.out + (size_t)16777216); const bf16_t* PF = (const bf16_t*)(P.ws + WS_PF); const bf16_t* PB = (const bf16_t*)(P.ws + WS_PB);
    bf16_t* ACAT = (bf16_t*)(P.ws + WS_ACAT);
    {
        const int b = u >> 6, n = (u >> 3) & 7, seg = u & 7;
        if (tid == 0) {
            unsigned* dn = (unsigned*)(P.ws + WS_CTL) + CW_DONE + ((layer * 4 + b) * 8 + n) * 16; unsigned spins = 0;
            while (__hip_atomic_load(dn, __ATOMIC_RELAXED, __HIP_MEMORY_SCOPE_AGENT) < 8u && ++spins < (1u << 22)) __builtin_amdgcn_s_sleep(4);
            __builtin_amdgcn_fence(__ATOMIC_ACQUIRE, "agent"); asm volatile("s_waitcnt vmcnt(0)" ::: "memory");
        }
        __syncthreads();
        if (tid < 256) {
            const int dir = tid >> 7, c = tid & 127;
            float cy = P.in[4][((size_t)(b * 4 + layer) * 2 + dir) * 1024 + n * 128 + c];
            const float* tot = (const float*)(P.ws + WS_TOT) + ((size_t)((b * 8 + n) * 8) * 2 + dir) * 2 * 128 + c;
            float tp[8], th[8];
#pragma unroll
            for (int j = 0; j < 8; ++j) { tp[j] = tot[j * 512]; th[j] = tot[j * 512 + 128]; }
            if (dir == 0) {
#pragma unroll
                for (int j = 0; j < 7; ++j) if (j < seg) cy = fmaf(tp[j], cy, th[j]);
            } else {
#pragma unroll
                for (int j = 7; j > 0; --j) if (j > seg) cy = fmaf(tp[j], cy, th[j]);
            }
            carr[tid] = cy;
        }
        __syncthreads();
        const size_t row0 = (size_t)NCTX + b * 2048 + seg * 256;
#pragma unroll
        for (int hb4 = 0; hb4 < 2; ++hb4) {
            v4u s[4], s2[4], pf[4], pb[4], gx[4];
#pragma unroll
            for (int i = 0; i < 4; ++i) { const int it = tid + (hb4 * 4 + i) * 512; const size_t row = row0 + (it >> 4); const int col = n * 128 + (it & 15) * 8;
                s[i] = *(const v4u*)(HT + row * 1024 + col); s2[i] = *(const v4u*)(ACAT + row * 2048 + 1024 + col);
                pf[i] = *(const v4u*)(PF + (row - NCTX) * 1024 + col); pb[i] = *(const v4u*)(PB + (row - NCTX) * 1024 + col);
                gx[i] = *(const v4u*)((const bf16_t*)P.out + row * 1024 + col); }
#pragma unroll
            for (int i = 0; i < 4; ++i) { const int it = tid + (hb4 * 4 + i) * 512; const size_t row = row0 + (it >> 4); const int c8 = (it & 15) * 8, col = n * 128 + c8;
                const f32x4 cf0 = *(const LAS f32x4*)(carr + c8), cf1 = *(const LAS f32x4*)(carr + c8 + 4), cb0 = *(const LAS f32x4*)(carr + 128 + c8), cb1 = *(const LAS f32x4*)(carr + 128 + c8 + 4);
                v4u o;
#pragma unroll
                for (int q = 0; q < 4; ++q) { const float cfl = q < 2 ? cf0[2 * q] : cf1[2 * q - 4], cfh = q < 2 ? cf0[2 * q + 1] : cf1[2 * q - 3], cbl = q < 2 ? cb0[2 * q] : cb1[2 * q - 4], cbh = q < 2 ? cb0[2 * q + 1] : cb1[2 * q - 3];
                    const float ylo = (__uint_as_float(s[i][q] << 16) + __uint_as_float(s2[i][q] << 16) + __uint_as_float(pf[i][q] << 16) * cfl + __uint_as_float(pb[i][q] << 16) * cbl) * __uint_as_float(gx[i][q] << 16);
                    const float yhi = (__uint_as_float(s[i][q] & 0xffff0000u) + __uint_as_float(s2[i][q] & 0xffff0000u) + __uint_as_float(pf[i][q] & 0xffff0000u) * cfh + __uint_as_float(pb[i][q] & 0xffff0000u) * cbh) * __uint_as_float(gx[i][q] & 0xffff0000u);
                    o[q] = pk2(ylo, yhi); }
                *(v4u*)(ACAT + row * 2048 + 1024 + col) = o; }
        }
        __syncthreads();
    }
}

__device__ __forceinline__ void mixer_phase(const Params& P, int layer, unsigned char* lds_generic, LAS unsigned char* lds, int rep, const pg8::EpiIn& EI) {
    unsigned* ctr = (unsigned*)(P.ws + WS_CTL) + CW_QUEUE + 64 * (layer + 4 * rep);
    volatile LAS unsigned* misc = (volatile LAS unsigned*)(lds + MISC_OFF);
    const bf16_t* Q = (const bf16_t*)(P.ws + WS_Q); const bf16_t* KB = (const bf16_t*)(P.ws + WS_KB); const bf16_t* VB = (const bf16_t*)(P.ws + WS_VB);
    const bf16_t* CK = (const bf16_t*)(P.ws + WS_CK); const bf16_t* CV = (const bf16_t*)(P.ws + WS_CV);
    bf16_t* ACAT = (bf16_t*)(P.ws + WS_ACAT);
    if (threadIdx.x == 0) misc[0] = __hip_atomic_fetch_add(ctr, 1u, __ATOMIC_RELAXED, __HIP_MEMORY_SCOPE_AGENT);
    for (int it = 0;; ++it) {
        __syncthreads();
        unsigned nxt = 0u;
        if (threadIdx.x == 0) nxt = __hip_atomic_fetch_add(ctr, 1u, __ATOMIC_RELAXED, __HIP_MEMORY_SCOPE_AGENT);
        const int tk = __builtin_amdgcn_readfirstlane((int)misc[it & 1]);
        if (tk >= 1408) break;
        const int idx = tk < 768 ? tk : (tk < 896 ? tk - 896 : tk - 128);
        if (idx < 0) {
            const int u = idx + 128;
            pg8::Gemm g{(const bf16_t*)(P.ws + WS_H), (const bf16_t*)(P.ws + WS_WIN) + (size_t)layer * NINW * 1024, NTOK, NINW, 1024};
            if (threadIdx.x == 0) ((LAS int*)(lds + RED_OFF))[2048 + 64 + 256] = -1;
            __syncthreads();
            OneUnit S1{u & 63, 20 + (u >> 6)};
            pg8::gemm_phase<pg8::EpiIn, OneUnit, true, true>(lds, g, S1, EI);
        }
        else if (idx >= 1024) { lru_fix_unit(P, layer, idx - 1024, lds); }
        else if (idx >= 256 && idx < 768) {
#ifndef NO_LRU
            const int j = idx - 256, latent = j < 256, jj = j & 255;
            lru_unit(P, layer, latent, latent ? (jj >> 6) : (jj >> 3), latent ? ((jj >> 3) & 7) : 0, jj & 7, lds);
#endif
        } else {
#ifndef NO_ATT
            const bool latent = idx < 256;
            const int j = latent ? idx : idx - 768;
            const int b = latent ? (j >> 6) : (j >> 3), hh = latent ? ((j >> 3) & 7) : (j & 7), qb = latent ? (j & 7) : 0, kvh = hh >> 2;
            const int q0 = qb * 256, ks = q0 - 128 < 0 ? 0 : q0 - 128, ke = q0 + 384 > 2048 ? 2048 : q0 + 384;
            const size_t rq = latent ? (size_t)NCTX + b * 2048 + q0 : (size_t)b * 256;
            const size_t rk = (size_t)NCTX + b * 2048 + ks, ck0 = (size_t)(b * 4 + layer) * 512;
            const bf16_t* K0 = latent ? CK + ck0 * 256 + kvh * 128 : KB + rq * 256 + kvh * 128;
            const bf16_t* V0 = latent ? CV + ck0 * 256 + kvh * 128 : VB + rq * 256 + kvh * 128;
            att::attn_unit(Q + rq * 1024 + hh * 128, K0, V0, latent ? 8 : 4,
                           KB + rk * 256 + kvh * 128, VB + rk * 256 + kvh * 128, latent ? (ke - ks) / 64 : 0, ks - q0,
                           P.in[14][layer * 8 + hh] * 1.4426950408889634f, ACAT + rq * 2048 + hh * 128, (char*)lds_generic);
#endif
        }
        if (threadIdx.x == 0) misc[(it + 1) & 1] = nxt;
    }
}

__global__ void __launch_bounds__(512, 2) fwd_megakernel(Params P) {
    extern __shared__ __attribute__((aligned(16))) unsigned char lds_raw[];
    LAS unsigned char* lds = (LAS unsigned char*)lds_raw;
    cg::grid_group grid = cg::this_grid();
    const int lo = P.ph_lo, hi = P.ph_hi, G = gridDim.x;
    int ph = 0;
    { volatile LAS unsigned* m = (volatile LAS unsigned*)(lds + MISC_OFF); if (threadIdx.x < 16) m[threadIdx.x] = 0u; }
    __syncthreads();
    XcdBarrier bar = xcd_barrier_post((unsigned*)(P.ws + WS_CTL) + CW_BAR, (volatile LAS unsigned*)(lds + MISC_OFF) + 8);
#define PHASE(...) do { if (ph >= lo && ph < hi) { __VA_ARGS__; if (ph + 1 < hi) { if (lo < 0) grid.sync(); else xcd_barrier(bar); } } ++ph; } while (0)
    bf16_t* H = (bf16_t*)(P.ws + WS_H);
#ifndef NO_PRO
    PHASE(prologue(P, lds));
#endif
    PHASE(prep_phase(P, lds));
#ifdef XSYNC
    if (hi > 1) { for (int i = 0; i < XSYNC; ++i) grid.sync(); }
#endif
    for (int l = 0; l < NL; ++l) {
        const float* mod = (const float*)(P.ws + WS_MOD) + (size_t)l * 5 * NMOD6;
        const pg8::EpiIn EI{(bf16_t*)(P.ws + WS_Q), (bf16_t*)(P.ws + WS_KB), (bf16_t*)(P.ws + WS_VB), (bf16_t*)(P.ws + WS_XR), ((bf16_t*)P.out), (bf16_t*)(P.ws + WS_G),
                         P.out + OUT_K, P.out + OUT_V, P.in[12] + l * 128, P.in[13] + l * 128, (const float*)(P.ws + WS_ROPE), (LAS float*)(lds + RED_OFF), l,
                         (const float*)(P.ws + WS_SSQ), (const float*)(P.ws + WS_SWIN) + (size_t)l * 5 * NINW};
        PHASE({ RS_RESET(); pg8::Gemm g{H, (const bf16_t*)(P.ws + WS_WIN) + (size_t)l * NINW * 1024, NTOK, NINW, 1024}; pg8::StaticOrder S; S.init(NTOK, 5120, G, opaque_bid());
            pg8::gemm_phase<pg8::EpiIn, pg8::StaticOrder, true, true>(lds, g, S, EI); });
        PHASE({ _Pragma("nounroll") for (int rep = 0; rep < XREP_MIX; ++rep) { mixer_phase(P, l, lds_raw, lds, rep, EI); if (rep + 1 < XREP_MIX) xcd_barrier(bar); } });
        PHASE({ pg8::Gemm g{(const bf16_t*)(P.ws + WS_ACAT), (const bf16_t*)(P.ws + WS_WCAT) + (size_t)l * 1024 * 2048, NTOK, 1024, 2048}; pg8::StaticOrder S; S.init(NTOK, 1024, G, opaque_bid());
            pg8::EpiMerge E{(const bf16_t*)(P.ws + WS_G), (bf16_t*)(P.ws + WS_MERGED)};

#ifndef NO_G2
 pg8::gemm_phase<pg8::EpiMerge, pg8::StaticOrder, true, true>(lds, g, S, E);
#endif
 });
        PHASE({ pg8::Gemm g{(const bf16_t*)(P.ws + WS_MERGED), (const bf16_t*)(P.ws + WS_WOUT) + (size_t)l * 1024 * 1024, NTOK, 1024, 1024}; pg8::StaticOrder S; S.init(NTOK, 1024, G, opaque_bid());
            pg8::EpiRes E{l == 0 ? P.in[0] : (const float*)nullptr, P.in[1] - (size_t)NCTX * 1024, (const bf16_t*)(P.ws + WS_X16), (bf16_t*)(P.ws + WS_X16), (float*)nullptr, mod + 2048, H, (const float*)(P.ws + WS_WMOD) + (size_t)(l * 2 + 1) * 5 * 1024, (float*)(P.ws + WS_SSQ)};

#ifndef NO_G3
 pg8::gemm_phase<pg8::EpiRes, pg8::StaticOrder, true, true>(lds, g, S, E);
#endif
 });
        PHASE({ RS_RESET(); pg8::Gemm g{H, (const bf16_t*)(P.ws + WS_W1) + (size_t)l * DFF * 1024, NTOK, DFF, 1024}; pg8::StaticOrder S; S.init(NTOK, DFF, G, opaque_bid());
            pg8::EpiUp E{(bf16_t*)(P.ws + WS_U), (const float*)(P.ws + WS_SSQ), (const float*)(P.ws + WS_SWUP) + (size_t)l * 5 * DFF, (LAS float*)(lds + RED_OFF) + 2048 + 64};

#ifndef NO_G4
 pg8::gemm_phase<pg8::EpiUp, pg8::StaticOrder, true, true>(lds, g, S, E);
#endif
 });
        PHASE({ pg8::Gemm g{(const bf16_t*)(P.ws + WS_U), (const bf16_t*)(P.ws + WS_W2) + (size_t)l * 1024 * DFF, NTOK, 1024, DFF}; pg8::StaticOrder S; S.init(NTOK, 1024, G, opaque_bid());
            pg8::EpiRes E{(const float*)nullptr, (const float*)nullptr, (const bf16_t*)(P.ws + WS_X16), (bf16_t*)(P.ws + WS_X16), l + 1 < NL ? (float*)nullptr : P.out, mod + 5 * 1024, l + 1 < NL ? H : (bf16_t*)nullptr, (const float*)(P.ws + WS_WMOD) + (size_t)((l + 1) * 2) * 5 * 1024, (float*)(P.ws + WS_SSQ)};

#ifndef NO_G3
 pg8::gemm_phase<pg8::EpiRes, pg8::StaticOrder, true, true>(lds, g, S, E);
#endif
 });
    }
#undef PHASE
#ifdef DUMP_PH
    grid.sync();
    { const v4u* src = (const v4u*)(P.ws + (size_t)DUMP_OFF * MiB); v4u* dst = (v4u*)P.out; const size_t n = (size_t)(33554432 + 262144) / 4;
      const size_t nl = (size_t)DUMP_LEN * MiB / 16; const v4u z = {0u, 0u, 0u, 0u};
      for (size_t i = (size_t)blockIdx.x * 512 + threadIdx.x; i < n; i += (size_t)gridDim.x * 512) dst[i] = i < nl ? src[i] : z; }
#endif
}

extern "C" void kernel_launch(void* const* d_in, const int* in_sizes, int n_in, void* d_out, int out_size, void* d_ws, size_t ws_size, hipStream_t stream) {
    static int grid = 0;
    if (grid == 0) {
        if (n_in != 27 || ws_size < WS_END) { fprintf(stderr, "kernel_launch: unexpected n_in %d / ws_size %zu (need %zu)\n", n_in, ws_size, (size_t)WS_END); grid = -1; return; }
        int dev = 0, cus = 0, per_cu = 0;
        (void)hipGetDevice(&dev); (void)hipDeviceGetAttribute(&cus, hipDeviceAttributeMultiprocessorCount, dev);
        if (hipFuncSetAttribute((const void*)fwd_megakernel, hipFuncAttributeMaxDynamicSharedMemorySize, LDS_BYTES) != hipSuccess) { fprintf(stderr, "kernel_launch: hipFuncSetAttribute failed\n"); grid = -1; return; }
        if (hipOccupancyMaxActiveBlocksPerMultiprocessor(&per_cu, (const void*)fwd_megakernel, 512, LDS_BYTES) != hipSuccess || per_cu < 1) { fprintf(stderr, "kernel_launch: occupancy query says %d\n", per_cu); per_cu = 1; }
        (void)hipGetLastError();
        grid = cus * 1;
        if (grid <= 0) grid = 256;
    }
    if (grid < 0) return;
    (void)hipMemsetAsync((char*)d_ws + WS_CTL, 0, 65536, stream);
    Params p{};
    for (int i = 0; i < 27; ++i) p.in[i] = (const float*)d_in[i];
    p.out = (float*)d_out; p.ws = (unsigned char*)d_ws;
#ifndef MK_SPLIT
#ifdef DUMP_PH
    p.ph_lo = 0; p.ph_hi = DUMP_PH;
#else
    p.ph_lo = 0; p.ph_hi = 1000;
#endif
    void* args[] = {&p};
    hipError_t e = hipLaunchCooperativeKernel((const void*)fwd_megakernel, dim3(grid), dim3(512), args, LDS_BYTES, stream);
    if (e != hipSuccess) fprintf(stderr, "cooperative launch failed: %s (grid %d)\n", hipGetErrorString(e), grid);
#else
    const int nph = 2 + NL * 6;
    for (int k = 0; k < nph; ++k) { p.ph_lo = k; p.ph_hi = k + 1; hipLaunchKernelGGL(fwd_megakernel, dim3(grid), dim3(512), LDS_BYTES, stream, p); }
#endif
}
```

```cpp
#include <hip/hip_runtime.h>
#include <hip/hip_cooperative_groups.h>
#include <hip/hip_bf16.h>
#include <cstdio>
#include <cstdint>
namespace cg = cooperative_groups;
namespace pg8 {
#define PG8_LAS __attribute__((address_space(3)))
typedef unsigned short bf16_t;
typedef short bf16x8 __attribute__((ext_vector_type(8)));
typedef float f32x4 __attribute__((ext_vector_type(4)));
typedef unsigned u32x4 __attribute__((ext_vector_type(4)));
constexpr int BM = 256, BK = 64, HALF = 128, HTB = HALF * BK * 2  , STAGE_BYTES = 8 * HTB, NXCD = 8, WGM = 8;

__host__ __device__ __forceinline__ int lds_byte(int r, int c) { const int st = (r >> 4) * 2 + (c >> 5), rr = r & 15, cc = c & 31, ob = rr * 64 + cc * 2; return st * 1024 + (ob ^ (((ob >> 9) & 1) << 5)); }
__host__ __device__ __forceinline__ void stage_rc(int b, int& R, int& C) { const int st = b / 1024, sb = b % 1024, swz = sb ^ (((sb >> 9) & 1) << 5); R = (st >> 1) * 16 + swz / 64; C = (st & 1) * 32 + (swz % 64) / 2; }
__host__ __device__ __forceinline__ int perm32(int rho) { const int n = rho >> 4, i = rho & 15; return 8 * (i >> 2) + 4 * n + (i & 3); }

struct Unit { int pm, pn; };
struct Gemm { const bf16_t* A; const bf16_t* Bt; int M, N, K; };

struct StaticOrder {
    int nM, nN, nwg, G, c;
    __host__ __device__ void init(int M, int N, int G_, int c_) { nM = M / BM; nN = N / BM; nwg = nM * nN; G = G_; c = c_; }
    __host__ __device__ bool next(int i, Unit& u) const {
        const long L = (long)i * G + c; if (L >= nwg) return false;
        int wgid = (int)L; { const int q = nwg / NXCD, r = nwg % NXCD, xcd = wgid % NXCD, off = wgid / NXCD; wgid = (xcd < r ? xcd * (q + 1) : r * (q + 1) + (xcd - r) * q) + off; }
        const int nig = WGM * nN, gid = wgid / nig, fm = gid * WGM, gsz = (nM - fm) < WGM ? (nM - fm) : WGM;
        u.pm = fm + ((wgid % nig) % gsz); u.pn = (wgid % nig) / gsz; return true;
    }
    __device__ __forceinline__ void a_ready(const Unit&) const {}
    __device__ __forceinline__ void done(const Unit&) const {}
};

typedef float f32x2c_t __attribute__((ext_vector_type(2))); typedef __bf16 bf16x2c_t __attribute__((ext_vector_type(2)));
__device__ __forceinline__ unsigned cvt_pk_bf16(float lo, float hi) { f32x2c_t v = {lo, hi}; bf16x2c_t b = __builtin_convertvector(v, bf16x2c_t); return __builtin_bit_cast(unsigned, b); }
typedef float f32x2 __attribute__((ext_vector_type(2)));
typedef unsigned u32x2 __attribute__((ext_vector_type(2)));
__device__ __forceinline__ float bf2f(unsigned short u) { return __uint_as_float(((unsigned)u) << 16); }
__device__ __forceinline__ float fsigmoid(float x) { return __builtin_amdgcn_rcpf(1.0f + __expf(-x)); }
__device__ __forceinline__ float gelu_tanh(float x) { const float u = 1.5957691216057308f * (x + 0.044715f * x * x * x); return x * __builtin_amdgcn_rcpf(1.0f + __expf(-u)); }
__device__ __forceinline__ u32x2 pack4(f32x4 v) { u32x2 w; w.x = cvt_pk_bf16(v[0], v[1]); w.y = cvt_pk_bf16(v[2], v[3]); return w; }
__host__ __device__ __forceinline__ int dim_of_pos(int p) { const int pi = p >> 1, wh = p & 1; return (pi >> 5) * 64 + wh * 32 + (pi & 31); }
__host__ __device__ __forceinline__ int pos_of_dim(int d) { const int ax = d >> 6, wh = (d >> 5) & 1, i = d & 31; return 2 * (ax * 32 + i) + wh; }

constexpr int NTOK = 16384, NCTX = 8192, DM = 1024;
constexpr float EPSN = 1e-6f;


template <bool PERMC>
__device__ __forceinline__ void prenorm_apply(f32x4 (&acc)[2][2][4][2], const Unit& u, int wr, int wc, int fr, int fq, const float* ssq, const float* sw, int ncols, PG8_LAS float* rs) {
    const int rowt = wr * 64 + fr, colw = u.pn * 256 + wc * 32 + (PERMC ? 8 : 4) * fq;
    const int cond = u.pm < 32 ? 0 : 1 + ((u.pm - 32) >> 3);
    const float* swp = sw + (size_t)cond * ncols + colw;
    const int t = (wr * 4 + wc) * 64 + fq * 16 + fr;
    const bool rebuild = ((const PG8_LAS int*)rs)[256] != u.pm;
    if (rebuild && t < 256) {
        const float* sp = ssq + (size_t)(u.pm * 256 + t) * 16;
        const f32x4 s0 = *(const f32x4*)sp, s1 = *(const f32x4*)(sp + 4), s2 = *(const f32x4*)(sp + 8), s3 = *(const f32x4*)(sp + 12);
        const f32x4 st = (s0 + s1) + (s2 + s3);
        rs[t] = __builtin_amdgcn_rsqf(((st[0] + st[1]) + (st[2] + st[3])) * (1.0f / 1024.0f) + EPSN);
    }
    f32x4 sv[2][2];
#pragma unroll
    for (int bj = 0; bj < 2; ++bj)
#pragma unroll
        for (int n = 0; n < 2; ++n) sv[bj][n] = *(const f32x4*)(swp + bj * 128 + (PERMC ? 4 : 16) * n);
    if (rebuild) {
        asm volatile("s_waitcnt lgkmcnt(0)" ::: "memory"); __builtin_amdgcn_s_barrier(); asm volatile("" ::: "memory");
        if (t == 0) ((PG8_LAS int*)rs)[256] = u.pm;
    }
#pragma unroll
    for (int ai = 0; ai < 2; ++ai)
#pragma unroll
        for (int m = 0; m < 4; ++m) {
            const float rstd = rs[ai * 128 + m * 16 + rowt];
#pragma unroll
            for (int bj = 0; bj < 2; ++bj)
#pragma unroll
                for (int n = 0; n < 2; ++n) acc[ai][bj][m][n] = acc[ai][bj][m][n] * rstd + sv[bj][n];
        }
}

struct EpiIn {
    static constexpr bool PERM = true, AFTER_DRAIN = false, HAS_MID = false;
    bf16_t *Q, *KB, *VB, *XR, *GXB, *G; float *outk, *outv; const float *qw, *kw, *rope; PG8_LAS float* red; int layer; const float *ssq, *sw;
    __device__ __forceinline__ void operator()(f32x4 (&acc)[2][2][4][2], const Unit& u, int wr, int wc, int fr, int fq) const {
        asm volatile("" : "+v"(fr), "+v"(fq));
        prenorm_apply<true>(acc, u, wr, wc, fr, fq, ssq, sw, 5632, red + 2048 + 64);
        const int pn = u.pn, pm = u.pm;
        const int rowt = wr * 64 + fr, colw = wc * 32 + 8 * fq;
        const bool latent = pm >= 32;
        if (pn < 5) {
#pragma unroll
            for (int ai = 0; ai < 2; ++ai)
#pragma unroll
                for (int m = 0; m < 4; ++m)
#pragma unroll
                    for (int bj = 0; bj < 2; ++bj) {
                        float s = 0.f;
#pragma unroll
                        for (int n = 0; n < 2; ++n) { const f32x4 x = acc[ai][bj][m][n]; s += (x[0] * x[0] + x[1] * x[1]) + (x[2] * x[2] + x[3] * x[3]); }
                        s += __shfl_xor(s, 16); s += __shfl_xor(s, 32);
                        if (fq == 0) red[((ai * 128 + m * 16 + rowt) * 2 + bj) * 4 + wc] = s;
                    }
            asm volatile("s_waitcnt lgkmcnt(0)" ::: "memory"); __builtin_amdgcn_s_barrier(); asm volatile("" ::: "memory");
            const float* nw = pn < 4 ? qw : kw;
            f32x4 wv[2];
#pragma unroll
            for (int n = 0; n < 2; ++n)
#pragma unroll
                for (int e = 0; e < 4; ++e) wv[n][e] = nw[dim_of_pos(colw + 4 * n + e)];
#pragma unroll
            for (int ai = 0; ai < 2; ++ai)
#pragma unroll
                for (int m = 0; m < 4; ++m) {
                    const int rl = ai * 128 + m * 16 + rowt, row = pm * 256 + rl;
#pragma unroll
                    for (int bj = 0; bj < 2; ++bj) {
                        const f32x4 pr = *(const PG8_LAS f32x4*)(red + (rl * 2 + bj) * 4);
                        const float rstd = __builtin_amdgcn_rsqf(((pr[0] + pr[1]) + (pr[2] + pr[3])) * (1.0f / 128.0f) + EPSN);
                        u32x2 pk[2]; float kx[2][2], ky[2][2];
#pragma unroll
                        for (int n = 0; n < 2; ++n) {
                            f32x4 v = acc[ai][bj][m][n] * rstd * wv[n];
                            const int p = colw + 4 * n;
                            if (!latent && pn == 4) { kx[n][0] = v[0]; kx[n][1] = v[2]; ky[n][0] = v[1]; ky[n][1] = v[3]; }
                            if (latent) {
                                const int t = (row - NCTX) & 2047;
                                const f32x4 cs = *(const f32x4*)(rope + ((size_t)t * 64 + (p >> 1)) * 2);
                                f32x4 o; o[0] = v[0] * cs[0] - v[1] * cs[1]; o[1] = v[1] * cs[0] + v[0] * cs[1]; o[2] = v[2] * cs[2] - v[3] * cs[3]; o[3] = v[3] * cs[2] + v[2] * cs[3];
                                v = o;
                            }
                            pk[n] = pack4(v);
                        }
                        if (!latent && pn == 4) {
                            float* o = outk + ((size_t)((pm * 4 + layer) * 256 + rl) * 2 + bj) * 128 + dim_of_pos(colw);
                            *(f32x4*)o = (f32x4){kx[0][0], kx[0][1], kx[1][0], kx[1][1]}; *(f32x4*)(o + 32) = (f32x4){ky[0][0], ky[0][1], ky[1][0], ky[1][1]};
                        }
                        bf16_t* dst = (pn < 4) ? Q + (size_t)row * 1024 + pn * 256 + bj * 128 + colw : KB + (size_t)row * 256 + bj * 128 + colw;
                        u32x4 w; w.x = pk[0].x; w.y = pk[0].y; w.z = pk[1].x; w.w = pk[1].y;
                        *(u32x4*)dst = w;
                    }
                }
        } else {
#pragma unroll
            for (int ai = 0; ai < 2; ++ai)
#pragma unroll
                for (int m = 0; m < 4; ++m) {
                    const int rl = ai * 128 + m * 16 + rowt, row = pm * 256 + rl;
#pragma unroll
                    for (int bj = 0; bj < 2; ++bj) {
                        f32x4 v0 = acc[ai][bj][m][0], v1 = acc[ai][bj][m][1];
                        const int c = bj * 128 + colw;
                        bf16_t* dst;
                        if (pn == 5) {
                            if (!latent) { float* o = outv + ((size_t)((pm * 4 + layer) * 256 + rl)) * 256 + c; *(f32x4*)o = v0; *(f32x4*)(o + 4) = v1; }
                            dst = VB + (size_t)row * 256 + c;
                        } else if (pn < 10) {
                            dst = XR + (size_t)row * 1024 + (pn - 6) * 256 + c;
                        } else if (pn < 14) {
#pragma unroll
                            for (int e = 0; e < 4; ++e) { v0[e] = gelu_tanh(v0[e]); v1[e] = gelu_tanh(v1[e]); }
                            dst = GXB + (size_t)row * 1024 + (pn - 10) * 256 + c;
                        } else {
#pragma unroll
                            for (int e = 0; e < 4; ++e) { v0[e] = fsigmoid(v0[e]); v1[e] = fsigmoid(v1[e]); }
                            dst = G + (size_t)row * 2048 + (pn - 14) * 256 + c;
                        }
                        const u32x2 p0 = pack4(v0), p1 = pack4(v1);
                        u32x4 w; w.x = p0.x; w.y = p0.y; w.z = p1.x; w.w = p1.y;
                        *(u32x4*)dst = w;
                    }
                }
        }
    }
};

struct EpiMerge {
    static constexpr bool PERM = true, AFTER_DRAIN = false, HAS_MID = true;
    const bf16_t* G; bf16_t* O;
    __device__ __forceinline__ static f32x4 lo4(u32x4 g) { f32x4 r; r[0] = __uint_as_float(g.x << 16); r[1] = __uint_as_float(g.x & 0xffff0000u); r[2] = __uint_as_float(g.y << 16); r[3] = __uint_as_float(g.y & 0xffff0000u); return r; }
    __device__ __forceinline__ static f32x4 hi4(u32x4 g) { f32x4 r; r[0] = __uint_as_float(g.z << 16); r[1] = __uint_as_float(g.z & 0xffff0000u); r[2] = __uint_as_float(g.w << 16); r[3] = __uint_as_float(g.w & 0xffff0000u); return r; }
    __device__ __forceinline__ static f32x4 rcp4(f32x4 x) { f32x4 r; r[0] = __builtin_amdgcn_rcpf(fmaxf(x[0], 1e-20f)); r[1] = __builtin_amdgcn_rcpf(fmaxf(x[1], 1e-20f)); r[2] = __builtin_amdgcn_rcpf(fmaxf(x[2], 1e-20f)); r[3] = __builtin_amdgcn_rcpf(fmaxf(x[3], 1e-20f)); return r; }
    __device__ __forceinline__ void mid(f32x4 (&acc)[2][2][4][2], const Unit& u, int wr, int wc, int fr, int fq) const {
        asm volatile("" : "+v"(fr), "+v"(fq));
        const int rowt = wr * 64 + fr, colw = u.pn * 256 + wc * 32 + 8 * fq;
#pragma unroll
        for (int ai = 0; ai < 2; ++ai)
#pragma unroll
            for (int m = 0; m < 4; ++m) {
                const bf16_t* gr = G + (size_t)(u.pm * 256 + ai * 128 + m * 16 + rowt) * 2048 + colw;
#pragma unroll
                for (int bj = 0; bj < 2; ++bj) {
                    const u32x4 a = *(const u32x4*)(gr + bj * 128), l = *(const u32x4*)(gr + 1024 + bj * 128);
                    acc[ai][bj][m][0] *= lo4(a) * rcp4(lo4(l));
                    acc[ai][bj][m][1] *= hi4(a) * rcp4(hi4(l));
                }
            }
    }
    __device__ __forceinline__ void operator()(f32x4 (&acc)[2][2][4][2], const Unit& u, int wr, int wc, int fr, int fq) const {
        asm volatile("" : "+v"(fr), "+v"(fq));
        const int rowt = wr * 64 + fr, colw = u.pn * 256 + wc * 32 + 8 * fq;
#pragma unroll
        for (int ai = 0; ai < 2; ++ai) {
            u32x4 lpre[4][2];
#pragma unroll
            for (int m = 0; m < 4; ++m)
#pragma unroll
                for (int bj = 0; bj < 2; ++bj) lpre[m][bj] = *(const u32x4*)(G + (size_t)(u.pm * 256 + ai * 128 + m * 16 + rowt) * 2048 + 1024 + colw + bj * 128);
            asm volatile("" ::: "memory");
#pragma unroll
            for (int m = 0; m < 4; ++m) {
                const size_t row = (size_t)(u.pm * 256 + ai * 128 + m * 16 + rowt);
#pragma unroll
                for (int bj = 0; bj < 2; ++bj) {
                    const u32x4 l = lpre[m][bj];
                    const u32x2 p0 = pack4(acc[ai][bj][m][0] * lo4(l)), p1 = pack4(acc[ai][bj][m][1] * hi4(l));
                    u32x4 w; w.x = p0.x; w.y = p0.y; w.z = p1.x; w.w = p1.y;
                    *(u32x4*)(O + row * 1024 + colw + bj * 128) = w;
                }
            }
        }
    }
};

struct EpiRes {
    static constexpr bool PERM = true, AFTER_DRAIN = false, HAS_MID = false;
    const float* xin0; const float* xin1; const bf16_t* xs16; bf16_t* x16o; float* yout; const float* gate; bf16_t* Hn; const float* wmod; float* ssq;
    __device__ __forceinline__ void operator()(f32x4 (&acc)[2][2][4][2], const Unit& u, int wr, int wc, int fr, int fq) const {
        asm volatile("" : "+v"(fr), "+v"(fq));
        const int rowt = wr * 64 + fr, colw = u.pn * 256 + wc * 32 + 8 * fq;
        const int cond = u.pm < 32 ? 0 : 1 + ((u.pm - 32) >> 3);
        const float* xin = u.pm < 32 ? xin0 : xin1;
        f32x4 gv[2][2], wv[2][2];
#pragma unroll
        for (int bj = 0; bj < 2; ++bj)
#pragma unroll
            for (int n = 0; n < 2; ++n) { gv[bj][n] = *(const f32x4*)(gate + cond * 6144 + colw + bj * 128 + 4 * n);
                wv[bj][n] = Hn ? *(const f32x4*)(wmod + cond * 1024 + colw + bj * 128 + 4 * n) : (f32x4){0.f, 0.f, 0.f, 0.f}; }
#pragma unroll
        for (int ai = 0; ai < 2; ++ai) {
            u32x4 xpre[4][2];
            if (!xin0) {
#pragma unroll
                for (int m = 0; m < 4; ++m)
#pragma unroll
                    for (int bj = 0; bj < 2; ++bj) xpre[m][bj] = *(const u32x4*)(xs16 + (size_t)(u.pm * 256 + ai * 128 + m * 16 + rowt) * 1024 + colw + bj * 128);
            }
            asm volatile("" ::: "memory");
#pragma unroll
            for (int m = 0; m < 4; ++m) {
                const int row = u.pm * 256 + ai * 128 + m * 16 + rowt;
                const size_t off = (size_t)row * 1024 + colw;
                float sq = 0.f;
#pragma unroll
                for (int bj = 0; bj < 2; ++bj) {
                    f32x4 x0, x1;
                    if (xin0) { x0 = *(const f32x4*)(xin + off + bj * 128); x1 = *(const f32x4*)(xin + off + bj * 128 + 4); }
                    else { const u32x4 xb = xpre[m][bj];
                        x0[0] = __uint_as_float(xb.x << 16); x0[1] = __uint_as_float(xb.x & 0xffff0000u); x0[2] = __uint_as_float(xb.y << 16); x0[3] = __uint_as_float(xb.y & 0xffff0000u);
                        x1[0] = __uint_as_float(xb.z << 16); x1[1] = __uint_as_float(xb.z & 0xffff0000u); x1[2] = __uint_as_float(xb.w << 16); x1[3] = __uint_as_float(xb.w & 0xffff0000u); }
                    const f32x4 g0 = gv[bj][0], g1 = gv[bj][1];
                    const f32x4 xn0 = x0 + g0 * acc[ai][bj][m][0], xn1 = x1 + g1 * acc[ai][bj][m][1];
                    if (yout) { *(f32x4*)(yout + off + bj * 128) = xn0; *(f32x4*)(yout + off + bj * 128 + 4) = xn1; }
                    else { const u32x2 p0 = pack4(xn0), p1 = pack4(xn1); u32x4 w; w.x = p0.x; w.y = p0.y; w.z = p1.x; w.w = p1.y; *(u32x4*)(x16o + off + bj * 128) = w; }
                    if (Hn) { const f32x4 w0 = wv[bj][0], w1 = wv[bj][1];
                        const u32x2 p0 = pack4(xn0 * w0), p1 = pack4(xn1 * w1); u32x4 w; w.x = p0.x; w.y = p0.y; w.z = p1.x; w.w = p1.y; *(u32x4*)(Hn + off + bj * 128) = w;
                        sq += ((xn0[0] * xn0[0] + xn0[1] * xn0[1]) + (xn0[2] * xn0[2] + xn0[3] * xn0[3])) + ((xn1[0] * xn1[0] + xn1[1] * xn1[1]) + (xn1[2] * xn1[2] + xn1[3] * xn1[3])); }
                }
                if (Hn) { sq += __shfl_xor(sq, 16); sq += __shfl_xor(sq, 32); if (fq == 0) ssq[(size_t)row * 16 + u.pn * 4 + wc] = sq; }
            }
        }
    }
};

struct EpiUp {
    static constexpr bool PERM = true, AFTER_DRAIN = false, HAS_MID = false;
    bf16_t* U; const float *ssq, *sw; PG8_LAS float* rs;
    __device__ __forceinline__ void operator()(f32x4 (&acc)[2][2][4][2], const Unit& u, int wr, int wc, int fr, int fq) const {
        asm volatile("" : "+v"(fr), "+v"(fq));
        prenorm_apply<true>(acc, u, wr, wc, fr, fq, ssq, sw, 4096, rs);
        const int rowt = wr * 64 + fr, colw = u.pn * 256 + wc * 32 + 8 * fq;
#pragma unroll
        for (int ai = 0; ai < 2; ++ai)
#pragma unroll
            for (int m = 0; m < 4; ++m) {
                bf16_t* rp = U + (size_t)(u.pm * 256 + ai * 128 + m * 16 + rowt) * 4096 + colw;
#pragma unroll
                for (int bj = 0; bj < 2; ++bj) {
                    f32x4 v0 = acc[ai][bj][m][0], v1 = acc[ai][bj][m][1];
#pragma unroll
                    for (int e = 0; e < 4; ++e) { const float r0 = fmaxf(v0[e], 0.f), r1 = fmaxf(v1[e], 0.f); v0[e] = r0 * r0; v1[e] = r1 * r1; }
                    const u32x2 p0 = pack4(v0), p1 = pack4(v1);
                    u32x4 w; w.x = p0.x; w.y = p0.y; w.z = p1.x; w.w = p1.y;
                    *(u32x4*)(rp + bj * 128) = w;
                }
            }
    }
};
template <class Epi, class Sched, bool ALIGN_EPI = false, bool SP2 = false>
__device__ __forceinline__ void gemm_phase(PG8_LAS unsigned char* lds, const Gemm g, const Sched& S, const Epi& E) {
    int tid_l = threadIdx.x; asm volatile("" : "+v"(tid_l));
    const int tid = tid_l, wid = __builtin_amdgcn_readfirstlane(tid >> 6), lane = tid & 63, wr = wid >> 2, wc = wid & 3, fr = lane & 15, fq = lane >> 4;
    const int K = g.K, nt = K / BK;
    unsigned voffA[2], voffB[2];
#pragma unroll
    for (int i = 0; i < 2; ++i) { int R, C; stage_rc(tid * 16 + i * 8192, R, C); const int Rb = Epi::PERM ? ((R & ~31) + perm32(R & 31)) : R;
        voffA[i] = (unsigned)(R * K + C) * 2u; voffB[i] = (unsigned)(Rb * K + C) * 2u; }
    const size_t kstep = (size_t)(BK * 2);
    const size_t hstep = (size_t)HALF * K * 2;
    const size_t tstep = 2 * hstep;
    const unsigned ldsw = (unsigned)wid * 1024u;
    const int aoff = lds_byte(wr * 64 + fr, fq * 8), boff = lds_byte(wc * 32 + fr, fq * 8);
#define PG8_SA(b, h) (((b) * 2 + (h)) * HTB)
#define PG8_SB(b, h) ((4 + (b) * 2 + (h)) * HTB)
#define PG8_STAGE(bufoff, gbase, voff) do { _Pragma("unroll") for (int _i = 0; _i < 2; ++_i) \
        __builtin_amdgcn_global_load_lds((const unsigned*)((const char*)(gbase) + (voff)[_i]), (PG8_LAS unsigned*)(lds + (bufoff) + ldsw + _i * 8192), 16, 0, 0); } while (0)
#define PG8_LDA(dst, b, h) do { _Pragma("unroll") for (int m = 0; m < 4; ++m) _Pragma("unroll") for (int k = 0; k < 2; ++k) dst[m][k] = *(const PG8_LAS bf16x8*)(lds + PG8_SA(b, h) + aoff + m * 2048 + k * 1024); } while (0)
#define PG8_LDB(dst, b, h) do { _Pragma("unroll") for (int n = 0; n < 2; ++n) _Pragma("unroll") for (int k = 0; k < 2; ++k) dst[n][k] = *(const PG8_LAS bf16x8*)(lds + PG8_SB(b, h) + boff + n * 2048 + k * 1024); } while (0)
#define PG8_MMA(ai, bj, At, Bt) do { __builtin_amdgcn_s_setprio(1); _Pragma("unroll") for (int m = 0; m < 4; ++m) _Pragma("unroll") for (int n = 0; n < 2; ++n) _Pragma("unroll") for (int k = 0; k < 2; ++k) \
        acc[ai][bj][m][n] = __builtin_amdgcn_mfma_f32_16x16x32_bf16(Bt[n][k], At[m][k], acc[ai][bj][m][n], 0, 0, 0); __builtin_amdgcn_s_setprio(0); } while (0)
#define PG8_WAIT_V(n) asm volatile("s_waitcnt vmcnt(" #n ")" ::: "memory")
#define PG8_WAIT_L(n) asm volatile("s_waitcnt lgkmcnt(" #n ")" ::: "memory")
#define PG8_BAR __builtin_amdgcn_s_barrier()
#define PG8_SCHED __builtin_amdgcn_sched_barrier(0)
    Unit cur, nxt; int ui = 0;
    if (!S.next(0, cur)) return;
    f32x4 acc[2][2][4][2];
#pragma unroll
    for (int a = 0; a < 2; ++a)
#pragma unroll
        for (int b = 0; b < 2; ++b)
#pragma unroll
            for (int m = 0; m < 4; ++m)
#pragma unroll
                for (int n = 0; n < 2; ++n) acc[a][b][m][n] = (f32x4){0.f, 0.f, 0.f, 0.f};
    bf16x8 At[4][2], B0[2][2], B1[2][2];
    const char* cA = (const char*)g.A + (size_t)cur.pm * tstep; const char* cB = (const char*)g.Bt + (size_t)cur.pn * tstep;
    S.a_ready(cur);
    if constexpr (SP2) {
        PG8_STAGE(PG8_SB(0, 0), cB, voffB); PG8_STAGE(PG8_SB(0, 1), cB + hstep, voffB); PG8_STAGE(PG8_SA(0, 0), cA, voffA); PG8_STAGE(PG8_SA(0, 1), cA + hstep, voffA);
        if (wr == 1) PG8_BAR;
        PG8_WAIT_V(2); PG8_BAR;
        PG8_STAGE(PG8_SB(1, 0), cB + kstep, voffB); PG8_STAGE(PG8_SA(1, 0), cA + kstep, voffA); PG8_STAGE(PG8_SB(1, 1), cB + hstep + kstep, voffB);
        PG8_WAIT_V(6); PG8_BAR;
    } else {
        PG8_STAGE(PG8_SB(0, 0), cB, voffB); PG8_STAGE(PG8_SA(0, 0), cA, voffA); PG8_STAGE(PG8_SB(0, 1), cB + hstep, voffB); PG8_STAGE(PG8_SA(0, 1), cA + hstep, voffA);
        if (wr == 1) PG8_BAR;
        PG8_WAIT_V(4); PG8_BAR;
        PG8_STAGE(PG8_SB(1, 0), cB + kstep, voffB); PG8_STAGE(PG8_SA(1, 0), cA + kstep, voffA); PG8_STAGE(PG8_SB(1, 1), cB + hstep + kstep, voffB);
        PG8_WAIT_V(6); PG8_BAR;
    }
    for (;;) {
        const bool has_next = S.next(ui + 1, nxt);
        const char* nA = has_next ? (const char*)g.A + (size_t)nxt.pm * tstep : cA; const char* nB = has_next ? (const char*)g.Bt + (size_t)nxt.pn * tstep : cB;
        for (int t = 0; t < nt; t += 2) {
            if constexpr (Epi::HAS_MID) { if (t == (nt >> 1)) E.mid(acc, cur, wr, wc, fr, fq); }
            const bool last = (t == nt - 2);
            const char* a1 = cA + (size_t)(t + 1) * kstep;
            const char* a2 = last ? nA : cA + (size_t)(t + 2) * kstep; const char* b2 = last ? nB : cB + (size_t)(t + 2) * kstep;
            const char* a3 = a2 + kstep; const char* b3 = b2 + kstep;
            if (last && has_next) S.a_ready(nxt);
            if constexpr (SP2) {
            PG8_LDB(B0, 0, 0); PG8_LDB(B1, 0, 1); PG8_SCHED; PG8_LDA(At, 0, 0); PG8_STAGE(PG8_SA(1, 1), a1 + hstep, voffA);
            PG8_WAIT_V(8); PG8_WAIT_L(0); PG8_BAR; PG8_MMA(0, 0, At, B0); PG8_MMA(0, 1, At, B1); PG8_BAR; PG8_SCHED;
            PG8_LDA(At, 0, 1); PG8_STAGE(PG8_SB(0, 0), b2, voffB); PG8_STAGE(PG8_SB(0, 1), b2 + hstep, voffB); PG8_STAGE(PG8_SA(0, 0), a2, voffA);
            PG8_WAIT_V(8); PG8_WAIT_L(0); PG8_BAR; PG8_MMA(1, 0, At, B0); PG8_MMA(1, 1, At, B1); PG8_BAR; PG8_SCHED;
            PG8_LDB(B0, 1, 0); PG8_LDB(B1, 1, 1); PG8_SCHED; PG8_LDA(At, 1, 0); PG8_STAGE(PG8_SA(0, 1), a2 + hstep, voffA);
            PG8_WAIT_V(8); PG8_WAIT_L(0); PG8_BAR; PG8_MMA(0, 0, At, B0); PG8_MMA(0, 1, At, B1); PG8_BAR; PG8_SCHED;
            PG8_LDA(At, 1, 1); PG8_STAGE(PG8_SB(1, 0), b3, voffB); PG8_STAGE(PG8_SB(1, 1), b3 + hstep, voffB); PG8_STAGE(PG8_SA(1, 0), a3, voffA);
            PG8_WAIT_V(8); PG8_WAIT_L(0); PG8_BAR; PG8_MMA(1, 0, At, B0); PG8_MMA(1, 1, At, B1); PG8_BAR; PG8_SCHED;
            } else {
            PG8_LDB(B0, 0, 0); PG8_SCHED; PG8_LDA(At, 0, 0); PG8_STAGE(PG8_SA(1, 1), a1 + hstep, voffA);
            PG8_WAIT_L(8); PG8_BAR; PG8_WAIT_L(0); PG8_MMA(0, 0, At, B0); PG8_BAR; PG8_SCHED;
            PG8_LDB(B1, 0, 1); PG8_STAGE(PG8_SB(0, 0), b2, voffB);
            PG8_BAR; PG8_WAIT_L(0); PG8_MMA(0, 1, At, B1); PG8_BAR;
            PG8_LDA(At, 0, 1); PG8_STAGE(PG8_SA(0, 0), a2, voffA);
            PG8_BAR; PG8_WAIT_L(0); PG8_MMA(1, 0, At, B0); PG8_BAR; PG8_SCHED;
            PG8_STAGE(PG8_SB(0, 1), b2 + hstep, voffB);
            PG8_WAIT_V(6); PG8_BAR; PG8_MMA(1, 1, At, B1); PG8_BAR;
            PG8_LDB(B0, 1, 0); PG8_SCHED; PG8_LDA(At, 1, 0); PG8_STAGE(PG8_SA(0, 1), a2 + hstep, voffA);
            PG8_WAIT_L(8); PG8_BAR; PG8_WAIT_L(0); PG8_MMA(0, 0, At, B0); PG8_BAR; PG8_SCHED;
            PG8_LDB(B1, 1, 1); PG8_STAGE(PG8_SB(1, 0), b3, voffB);
            PG8_BAR; PG8_WAIT_L(0); PG8_MMA(0, 1, At, B1); PG8_BAR;
            PG8_LDA(At, 1, 1); PG8_STAGE(PG8_SA(1, 0), a3, voffA);
            PG8_BAR; PG8_WAIT_L(0); PG8_MMA(1, 0, At, B0); PG8_BAR; PG8_SCHED;
            PG8_STAGE(PG8_SB(1, 1), b3 + hstep, voffB);
            PG8_WAIT_V(6); PG8_BAR; PG8_MMA(1, 1, At, B1); PG8_BAR;
            }
        }
        if constexpr (ALIGN_EPI) { if (wr == 0) PG8_BAR; }
        if constexpr (!Epi::AFTER_DRAIN) { E(acc, cur, wr, wc, fr, fq); S.done(cur); }
        if (!has_next) break;
#pragma unroll
        for (int a = 0; a < 2; ++a)
#pragma unroll
            for (int b = 0; b < 2; ++b)
#pragma unroll
                for (int m = 0; m < 4; ++m)
#pragma unroll
                    for (int n = 0; n < 2; ++n) acc[a][b][m][n] = (f32x4){0.f, 0.f, 0.f, 0.f};
        cur = nxt; cA = nA; cB = nB; ++ui;
        if constexpr (ALIGN_EPI) { if (wr == 1) PG8_BAR; }
    }
    PG8_WAIT_V(0);
    if constexpr (!ALIGN_EPI) { if (wr == 0) PG8_BAR; }
    PG8_BAR;
    if constexpr (Epi::AFTER_DRAIN) { E.fused(acc, cur, wr, wc, fr, fq, lds, wid, lane); S.done(cur); }
#undef PG8_SA
#undef PG8_SB
#undef PG8_STAGE
#undef PG8_LDA
#undef PG8_LDB
#undef PG8_MMA
#undef PG8_WAIT_V
#undef PG8_WAIT_L
#undef PG8_BAR
#undef PG8_SCHED
}
}

namespace att {
using bf16 = unsigned short;
using bf16x8 = __attribute__((ext_vector_type(8))) short;
using s16x4  = __attribute__((ext_vector_type(4))) short;
using f32x16 = __attribute__((ext_vector_type(16))) float;
using u32x4  = __attribute__((ext_vector_type(4))) unsigned;
constexpr int D = 128, NW = 8, QBLK = 32, KVBLK = 64;
constexpr float SCALE = 0.088388347648318440f;
constexpr float THR = 8.f;
constexpr int LDQ = 1024, LDK = 256, LDO = 2048;
constexpr size_t SHM_V = KVBLK * D * 2, SHM_K = KVBLK * D * 2, SHM_ATTN = 2 * SHM_V + 2 * SHM_K + NW * 64 * 4;
#define KSWZ(row, colB) ((row) * 256 + ((colB) ^ (((row) & 7) << 4)))
#define SBAR() __builtin_amdgcn_sched_barrier(0)
__device__ __forceinline__ int crow(int r, int hi) { return (r & 3) + 8 * (r >> 2) + 4 * hi; }
typedef float f32x2a_t __attribute__((ext_vector_type(2))); typedef __bf16 bf16x2a_t __attribute__((ext_vector_type(2)));
__device__ __forceinline__ unsigned cvtpk(float lo, float hi) { f32x2a_t v = {lo, hi}; bf16x2a_t b = __builtin_convertvector(v, bf16x2a_t); return __builtin_bit_cast(unsigned, b); }
__device__ __forceinline__ void partialSM(f32x16& p0, f32x16& p1, float& m_reg, float& mn, float& alpha) {
  constexpr float C = SCALE * 1.4426950408889634f;
  float pmax = p0[0]; for (int r = 1; r < 16; ++r) pmax = fmaxf(pmax, p0[r]); for (int r = 0; r < 16; ++r) pmax = fmaxf(pmax, p1[r]);
  { auto rr = __builtin_amdgcn_permlane32_swap(__float_as_uint(pmax), __float_as_uint(pmax), false, false);
    pmax = fmaxf(__uint_as_float(rr[0]), __uint_as_float(rr[1])); }
  if (__builtin_expect(__all(pmax - m_reg <= THR / SCALE), 1)) { mn = m_reg; alpha = 1.f; }
  else { mn = fmaxf(m_reg, pmax); alpha = __builtin_amdgcn_exp2f((m_reg - mn) * C); m_reg = mn; }
  float mnC = -mn * C;
  for (int r = 0; r < 16; ++r) p0[r] = fmaf(p0[r], C, mnC); for (int r = 0; r < 16; ++r) p1[r] = fmaf(p1[r], C, mnC);
  for (int r = 0; r < 16; ++r) p0[r] = __builtin_amdgcn_exp2f(p0[r]);
}
__device__ __forceinline__ void finishSM(f32x16& p0, f32x16& p1, float alpha, float& l_reg, bf16x8& pa0, bf16x8& pa1, bf16x8& pa2, bf16x8& pa3) {
  for (int r = 0; r < 16; ++r) p1[r] = __builtin_amdgcn_exp2f(p1[r]);
  float ps = 0; for (int r = 0; r < 16; ++r) ps += p0[r]; for (int r = 0; r < 16; ++r) ps += p1[r];
  { auto rr = __builtin_amdgcn_permlane32_swap(__float_as_uint(ps), __float_as_uint(ps), false, false);
    ps = __uint_as_float(rr[0]) + __uint_as_float(rr[1]); }
  l_reg = l_reg * alpha + ps;
#define PK4(P, BASE, OUT) do { unsigned a0 = cvtpk(P[BASE + 0], P[BASE + 1]), a1 = cvtpk(P[BASE + 2], P[BASE + 3]);   \
    unsigned b0 = cvtpk(P[BASE + 4], P[BASE + 5]), b1 = cvtpk(P[BASE + 6], P[BASE + 7]);                              \
    auto r0 = __builtin_amdgcn_permlane32_swap(a0, b0, false, false); auto r1 = __builtin_amdgcn_permlane32_swap(a1, b1, false, false); \
    u32x4 w = {r0[0], r1[0], r0[1], r1[1]}; OUT = *reinterpret_cast<bf16x8*>(&w); } while (0)
  PK4(p0, 0, pa0); PK4(p0, 8, pa1); PK4(p1, 0, pa2); PK4(p1, 8, pa3);
#undef PK4
}
__device__ __forceinline__ void qkt(f32x16& p0, f32x16& p1, const bf16* Ks, const bf16x8* qr, int r32, int hi) {
  p0 = f32x16{}; p1 = f32x16{};
  for (int d0 = 0; d0 < 8; ++d0) { int cb = (d0 * 16 + hi * 8) * 2;
    bf16x8 b0 = *reinterpret_cast<const bf16x8*>((const char*)Ks + KSWZ(r32, cb));
    bf16x8 b1 = *reinterpret_cast<const bf16x8*>((const char*)Ks + KSWZ(32 + r32, cb));
    p0 = __builtin_amdgcn_mfma_f32_32x32x16_bf16(b0, qr[d0], p0, 0, 0, 0);
    p1 = __builtin_amdgcn_mfma_f32_32x32x16_bf16(b1, qr[d0], p1, 0, 0, 0); }
}
__device__ __forceinline__ void bandmask(f32x16& p0, f32x16& p1, int dk0, int hi) {
#pragma unroll
  for (int r = 0; r < 16; ++r) { const int dk = dk0 + crow(r, hi);
    if (dk < -128 || dk > 128) p0[r] = -1e30f;
    if (dk + 32 < -128 || dk + 32 > 128) p1[r] = -1e30f; }
}
__device__ __forceinline__ int v_st(int k, int c) { const int kk = (k & ~0xC) | ((k & 4) << 1) | ((k & 8) >> 1); return ((kk >> 3) * 4 + (c >> 5)) * 512 + ((kk & 7) * 32 + (c & 31)) * 2; }
__device__ __forceinline__ int v_rd_base(int lane) { return ((lane & 3) << 3) | (((lane >> 2) & 3) << 6) | (((lane >> 4) & 1) << 5) | (((lane >> 5) & 1) << 8); }
constexpr int v_rd_off(int d0, int ks, int half) { return d0 * 512 + ks * 4096 + half * 2048; }
template <int OFF> __device__ __forceinline__ s16x4 tr_read(int vb) {
  s16x4 r; asm volatile("ds_read_b64_tr_b16 %0, %1 offset:%2" : "=&v"(r) : "v"(vb), "i"(OFF) : "memory"); return r;
}
template <int D0> __device__ __forceinline__ void pv_one(f32x16& od, int vb, bf16x8 pa0, bf16x8 pa1, bf16x8 pa2, bf16x8 pa3) {
  const s16x4 l0 = tr_read<v_rd_off(D0, 0, 0)>(vb), h0 = tr_read<v_rd_off(D0, 0, 1)>(vb), l1 = tr_read<v_rd_off(D0, 1, 0)>(vb), h1 = tr_read<v_rd_off(D0, 1, 1)>(vb);
  const s16x4 l2 = tr_read<v_rd_off(D0, 2, 0)>(vb), h2 = tr_read<v_rd_off(D0, 2, 1)>(vb), l3 = tr_read<v_rd_off(D0, 3, 0)>(vb), h3 = tr_read<v_rd_off(D0, 3, 1)>(vb);
  asm volatile("s_waitcnt lgkmcnt(0)" ::: "memory"); SBAR();
#define PK(L, H) (bf16x8){L[0], L[1], L[2], L[3], H[0], H[1], H[2], H[3]}
  od = __builtin_amdgcn_mfma_f32_32x32x16_bf16(pa0, PK(l0, h0), od, 0, 0, 0);
  od = __builtin_amdgcn_mfma_f32_32x32x16_bf16(pa1, PK(l1, h1), od, 0, 0, 0);
  od = __builtin_amdgcn_mfma_f32_32x32x16_bf16(pa2, PK(l2, h2), od, 0, 0, 0);
  od = __builtin_amdgcn_mfma_f32_32x32x16_bf16(pa3, PK(l3, h3), od, 0, 0, 0);
#undef PK
}
__device__ __forceinline__ void pv_d0(f32x16* o, int vb, bf16x8 pa0, bf16x8 pa1, bf16x8 pa2, bf16x8 pa3) {
  pv_one<0>(o[0], vb, pa0, pa1, pa2, pa3); pv_one<1>(o[1], vb, pa0, pa1, pa2, pa3); pv_one<2>(o[2], vb, pa0, pa1, pa2, pa3); pv_one<3>(o[3], vb, pa0, pa1, pa2, pa3);
}

__device__ __forceinline__ void attn_unit(const bf16* __restrict__ Qb, const bf16* __restrict__ K0, const bf16* __restrict__ V0, int n0,
                                          const bf16* __restrict__ K1, const bf16* __restrict__ V1, int n1, int dq0, float sinkl2,
                                          bf16* __restrict__ Ob, char* lds) {
  int tid_l = threadIdx.x; asm volatile("" : "+v"(tid_l));
  const int tid = tid_l, wid = tid >> 6, lane = tid & 63, r32 = lane & 31, hi = lane >> 5;
  bf16* V_lds = (bf16*)lds; bf16* K_lds = (bf16*)(lds + 2 * SHM_V);
  float* ws = (float*)(lds + 2 * SHM_V + 2 * SHM_K) + wid * 64; float* li_l = ws; float* al_l = ws + 32;
  float m_reg = -1e30f, l_reg = 0; f32x16 o[4] = {}; bf16x8 qr[8];
  const bf16* Qw = Qb + (long)(wid * QBLK + r32) * LDQ + hi * 8;
#pragma unroll
  for (int d0 = 0; d0 < 8; ++d0) qr[d0] = *reinterpret_cast<const bf16x8*>(Qw + d0 * 16);
  const int sr = tid >> 4, sc = (tid & 15) * 8, vst0 = v_st(sr, sc), vst1 = v_st(32 + sr, sc);
  const int vb0 = (int)(uintptr_t)V_lds + v_rd_base(lane);
  const int dql = dq0 - (wid * QBLK + r32);
  struct { bf16x8 vs0, vs1, ks0, ks1; } sr_[2];
#define SLOAD(i, j) do { const int j_ = (j); const bf16* kt_ = j_ < n0 ? K0 + (long)j_ * (KVBLK * LDK) : K1 + (long)(j_ - n0) * (KVBLK * LDK); \
    const bf16* vt_ = j_ < n0 ? V0 + (long)j_ * (KVBLK * LDK) : V1 + (long)(j_ - n0) * (KVBLK * LDK); \
    sr_[i].vs0 = *reinterpret_cast<const bf16x8*>(&vt_[(long)sr * LDK + sc]); sr_[i].vs1 = *reinterpret_cast<const bf16x8*>(&vt_[(long)(32 + sr) * LDK + sc]); \
    sr_[i].ks0 = *reinterpret_cast<const bf16x8*>(&kt_[(long)sr * LDK + sc]); sr_[i].ks1 = *reinterpret_cast<const bf16x8*>(&kt_[(long)(32 + sr) * LDK + sc]); } while (0)
#define SWRITE(b, i) do { *(bf16x8*)((char*)V_lds + (b) * SHM_V + vst0) = sr_[i].vs0;          \
    *(bf16x8*)((char*)V_lds + (b) * SHM_V + vst1) = sr_[i].vs1; int kc = sc * 2;               \
    *(bf16x8*)((char*)K_lds + (b) * SHM_K + KSWZ(sr, kc)) = sr_[i].ks0;                       \
    *(bf16x8*)((char*)K_lds + (b) * SHM_K + KSWZ(32 + sr, kc)) = sr_[i].ks1; } while (0)
#define SWAIT() asm volatile("s_waitcnt vmcnt(4)" ::: "memory")
#define RESC(a) do { if (__any((a) < 1.f)) { if (hi == 0) al_l[r32] = (a); asm volatile("s_waitcnt lgkmcnt(0)" ::: "memory"); \
    for (int d = 0; d < 4; ++d) for (int r = 0; r < 16; ++r) o[d][r] *= al_l[crow(r, hi)]; } } while (0)
#define MASK(P0, P1, j) do { if ((j) >= n0) bandmask(P0, P1, dql + 64 * ((j) - n0), hi); } while (0)
  f32x16 pA0, pA1, pB0, pB1; float mnA, mnB, alA, alB; bf16x8 pa0, pa1, pa2, pa3; const int NT = n0 + n1;
  constexpr int SE = 0, SO = 1;
  SLOAD(SE, 0); SLOAD(SO, 1);
  asm volatile("s_waitcnt vmcnt(4)" ::: "memory"); SWRITE(0, SE); __syncthreads();
  qkt(pA0, pA1, K_lds, qr, r32, hi); partialSM(pA0, pA1, m_reg, mnA, alA);
  if (2 < NT) SLOAD(SE, 2);
  SWAIT(); SWRITE(1, SO); __syncthreads();
  for (int j = 1; j + 1 < NT; j += 2) {
    SBAR(); qkt(pB0, pB1, (bf16*)((char*)K_lds + SHM_K), qr, r32, hi); MASK(pB0, pB1, j);
    finishSM(pA0, pA1, alA, l_reg, pa0, pa1, pa2, pa3); SBAR();
    SLOAD(SO, j + 2); SBAR();
    pv_d0(o, vb0, pa0, pa1, pa2, pa3); partialSM(pB0, pB1, m_reg, mnB, alB);
    __syncthreads(); SWAIT(); SWRITE(0, SE);
    RESC(alB); __syncthreads();
    SBAR(); qkt(pA0, pA1, K_lds, qr, r32, hi); MASK(pA0, pA1, j + 1);
    finishSM(pB0, pB1, alB, l_reg, pa0, pa1, pa2, pa3); SBAR();
    if (j + 3 < NT) SLOAD(SE, j + 3); SBAR();
    pv_d0(o, vb0 + (int)SHM_V, pa0, pa1, pa2, pa3); partialSM(pA0, pA1, m_reg, mnA, alA);
    __syncthreads(); SWAIT(); SWRITE(1, SO);
    RESC(alA); __syncthreads();
  }
  SBAR(); qkt(pB0, pB1, (bf16*)((char*)K_lds + SHM_K), qr, r32, hi); MASK(pB0, pB1, NT - 1);
  finishSM(pA0, pA1, alA, l_reg, pa0, pa1, pa2, pa3); SBAR();
  pv_d0(o, vb0, pa0, pa1, pa2, pa3); partialSM(pB0, pB1, m_reg, mnB, alB);
  __syncthreads(); RESC(alB);
  finishSM(pB0, pB1, alB, l_reg, pa0, pa1, pa2, pa3); SBAR();
  pv_d0(o, vb0 + (int)SHM_V, pa0, pa1, pa2, pa3);
  l_reg += __builtin_amdgcn_exp2f(sinkl2 - m_reg * (SCALE * 1.4426950408889634f));
  if (hi == 0) li_l[r32] = l_reg; asm volatile("s_waitcnt lgkmcnt(0)" ::: "memory");
  float rli[16];
#pragma unroll
  for (int r = 0; r < 16; ++r) rli[r] = __builtin_amdgcn_rcpf(li_l[crow(r, hi)]);
  asm volatile("" ::: "memory");
  { char* stg = lds + 69632 + wid * 8192;
#pragma unroll
    for (int r = 0; r < 16; ++r) { const int orow = crow(r, hi);
#pragma unroll
      for (int d0 = 0; d0 < 4; ++d0) { const float v = o[d0][r] * rli[r]; *(bf16*)(stg + orow * 256 + (d0 * 32 + r32) * 2) = (bf16)cvtpk(v, v); } }
    asm volatile("s_waitcnt lgkmcnt(0)" ::: "memory");
    bf16* Ow = Ob + (long)(wid * QBLK) * LDO;
#pragma unroll
    for (int i = 0; i < 8; ++i) { const int row = i * 4 + (lane >> 4), ch = lane & 15; const u32x4 v = *(const u32x4*)(stg + row * 256 + ch * 16); *(u32x4*)(Ow + (long)row * LDO + ch * 8) = v; } }
  __syncthreads();
#undef SLOAD
#undef SWRITE
#undef SWAIT
#undef RESC
#undef MASK
}
#undef KSWZ
#undef SBAR
}

#define LAS __attribute__((address_space(3)))
typedef unsigned short bf16_t;
typedef unsigned v4u __attribute__((ext_vector_type(4)));
typedef float f32x4 __attribute__((ext_vector_type(4)));
typedef float f32x16 __attribute__((ext_vector_type(16)));
typedef short bf16x8 __attribute__((ext_vector_type(8)));
using pg8::bf2f; using pg8::dim_of_pos; using pg8::pos_of_dim;

constexpr int NL = 4, NINW = 5632, DFF = 4096, NMOD6 = 6144;
constexpr int NTOK = 16384, NCTX = 8192;
constexpr size_t MiB = 1u << 20;
constexpr size_t WS_CTL = 0, WS_MOD = 1 * MiB, WS_ROPE = 2 * MiB, WS_WIN = 3 * MiB, WS_WCAT = 47 * MiB, WS_WOUT = 63 * MiB, WS_W1 = 71 * MiB, WS_W2 = 103 * MiB,
                 WS_CK = 135 * MiB, WS_CV = 139 * MiB, WS_H = 143 * MiB, WS_Q = 175 * MiB, WS_KB = 207 * MiB, WS_VB = 215 * MiB, WS_XR = 223 * MiB, WS_G = 255 * MiB,
                 WS_ACAT = 319 * MiB, WS_PF = 383 * MiB, WS_PB = 399 * MiB, WS_SSQ = 415 * MiB, WS_SWIN = 416 * MiB, WS_SWUP = 416 * MiB + 512 * 1024, WS_WMOD = 417 * MiB, WS_X16 = 418 * MiB, WS_WFR = 450 * MiB, WS_END = 454 * MiB, WS_TOT = 512 * 1024, WS_U = WS_Q, WS_MERGED = WS_Q;
constexpr size_t OUT_K = 16777216, OUT_V = 25165824, OUT_S = 33554432;
constexpr int RING_BYTES = 131072, RED_OFF = 131072, MISC_OFF = RED_OFF + 8192, LDS_BYTES = 147456;
constexpr int CW_DONE = 1024;
constexpr int CW_QUEUE = 64;

#define XB_TMO      128
#define XB_XCNT(j)  (256  + 64 * (j))
#define XB_XSUB(j)  (1280 + 64 * (j))
#define XB_XGEN(j)  (2304 + 64 * (j))
#define XB_TOP      3328
#define XB_TOPGEN   3392
#define XCD_BAR_WORDS 3456
#define XB_SPIN_CAP (1u << 18)

__device__ __forceinline__ unsigned xb_ld(unsigned* p)              { return __hip_atomic_load(p, __ATOMIC_RELAXED, __HIP_MEMORY_SCOPE_AGENT); }
__device__ __forceinline__ unsigned xb_add(unsigned* p, unsigned v) { return __hip_atomic_fetch_add(p, v, __ATOMIC_RELAXED, __HIP_MEMORY_SCOPE_AGENT); }
__device__ __forceinline__ unsigned xb_xcc_id() { return (unsigned)__builtin_amdgcn_s_getreg((3 << 11) | 20) & 0xFu; }
#define XB_SPIN(cond, bar) do { unsigned _sp = 0; while (cond) { __builtin_amdgcn_s_sleep(1); \
    if ((++_sp & 255u) == 0u) { if (xb_ld(&(bar)[XB_TMO])) break; if (_sp > XB_SPIN_CAP) { atomicAdd(&(bar)[XB_TMO], 1u); break; } } } } while (0)

struct XcdBarrier {
    unsigned* bar; unsigned x;
    volatile LAS unsigned* st;
};

__device__ __forceinline__ XcdBarrier xcd_barrier_post(unsigned* bar, volatile LAS unsigned* st) {
    XcdBarrier b; b.bar = bar; b.x = xb_xcc_id(); b.st = st;
    if (threadIdx.x == 0) (void)xb_add(&bar[XB_XCNT(b.x)], 1u);
    return b;
}
__device__ __forceinline__ void xcd_barrier_complete(unsigned* bar, unsigned x, unsigned& nloc, unsigned& nx) {
    const unsigned G = gridDim.x * gridDim.y * gridDim.z;
    unsigned sum, cnt, mine, sp = 0u;
    for (;;) {
        sum = 0u; cnt = 0u; mine = 0u;
#pragma unroll
        for (unsigned j = 0; j < 16; ++j) { const unsigned c = xb_ld(&bar[XB_XCNT(j)]); sum += c; cnt += (c > 0u) ? 1u : 0u; mine = (j == x) ? c : mine; }
        if (sum == G) break;
        __builtin_amdgcn_s_sleep(1);
        if ((++sp & 255u) == 0u) { if (xb_ld(&bar[XB_TMO])) break; if (sp > XB_SPIN_CAP) { atomicAdd(&bar[XB_TMO], 1u); break; } }
    }
    nloc = mine > 0u ? mine : 1u; nx = cnt > 0u ? cnt : 1u;
}

__device__ __forceinline__ void xcd_barrier(const XcdBarrier& b) {
    asm volatile("s_waitcnt vmcnt(0)" ::: "memory");
    __syncthreads();
    if (threadIdx.x == 0) {
        unsigned* bar = b.bar;
        __builtin_amdgcn_s_waitcnt(0);
        unsigned nloc = b.st[0], nx = b.st[1];
        if (nloc == 0u) { xcd_barrier_complete(bar, b.x, nloc, nx); b.st[0] = nloc; b.st[1] = nx; }
        const unsigned old = xb_add(&bar[XB_XSUB(b.x)], 1u);
        const unsigned gen = old / nloc;
        if (old + 1u == (gen + 1u) * nloc) {
            __builtin_amdgcn_fence(__ATOMIC_RELEASE, "agent");
            asm volatile("s_waitcnt vmcnt(0)" ::: "memory");
            const unsigned og = xb_add(&bar[XB_TOP], 1u);
            const unsigned tg = og / nx;
            if (og + 1u == (tg + 1u) * nx) xb_add(&bar[XB_TOPGEN], 1u);
            else XB_SPIN(xb_ld(&bar[XB_TOPGEN]) == tg, bar);
            __builtin_amdgcn_fence(__ATOMIC_ACQUIRE, "agent");
            xb_add(&bar[XB_XGEN(b.x)], 1u);
            asm volatile("s_waitcnt vmcnt(0)" ::: "memory");
        } else {
            XB_SPIN(xb_ld(&bar[XB_XGEN(b.x)]) == gen, bar);
            __builtin_amdgcn_fence(__ATOMIC_ACQUIRE, "agent");
            asm volatile("s_waitcnt vmcnt(0)" ::: "memory");
        }
    }
    __syncthreads();
}

constexpr int CW_BAR = 4096;

__device__ __forceinline__ int opaque_bid() { int b = blockIdx.x; asm volatile("" : "+s"(b)); return b; }
#ifndef XREP_MIX
#define XREP_MIX 1
#endif
struct OneUnit { int pm, pn;
    __device__ __forceinline__ bool next(int i, pg8::Unit& u) const { if (i != 0) return false; u.pm = pm; u.pn = pn; return true; }
    __device__ __forceinline__ void a_ready(const pg8::Unit&) const {}
    __device__ __forceinline__ void done(const pg8::Unit&) const {} };
struct Params { const float* in[27]; float* out; unsigned char* ws; int ph_lo, ph_hi; };

__device__ __forceinline__ unsigned f2bf(float f) { unsigned u = __builtin_bit_cast(unsigned, f); return (u + 0x7fffu + ((u >> 16) & 1u)) >> 16; }
__device__ __forceinline__ unsigned pk2(float lo, float hi) { return att::cvtpk(lo, hi); }
__device__ __forceinline__ unsigned short f2bfh(float x) { return (unsigned short)att::cvtpk(x, x); }
__device__ __forceinline__ float wave_sum(float v) {
#pragma unroll
    for (int o = 1; o < 64; o <<= 1) v += __shfl_xor(v, o);
    return v;
}

template <bool PERMQK>
__device__ __forceinline__ void tr_item(const float* W, int K, int N, bf16_t* WT, int ldk, int koff, LAS float* scr, int item, int lane) {
    const int nblk = N / 32, kb = item / nblk, nb = item % nblk, k0 = 64 * kb, n0 = 32 * nb;
    float tv[32];
#pragma unroll
    for (int i = 0; i < 32; ++i) { const int kk = 2 * i + (lane >> 5); tv[i] = __builtin_nontemporal_load(&W[(size_t)(k0 + kk) * N + n0 + (lane & 31)]); }
#pragma unroll
    for (int i = 0; i < 32; ++i) { const int kk = 2 * i + (lane >> 5); scr[kk * 33 + (lane & 31)] = tv[i]; }
    asm volatile("s_waitcnt lgkmcnt(0)" ::: "memory");
    const int c = lane & 7;
#pragma unroll
    for (int j = 0; j < 4; ++j) { const int n = (lane >> 3) + 8 * j; const LAS float* s = scr + (8 * c) * 33 + n;
        v4u o; o.x = pk2(s[0 * 33], s[1 * 33]); o.y = pk2(s[2 * 33], s[3 * 33]); o.z = pk2(s[4 * 33], s[5 * 33]); o.w = pk2(s[6 * 33], s[7 * 33]);
        int nn = n0 + n; if (PERMQK && nn < 1280) nn = (nn & ~127) | pos_of_dim(nn & 127);
        *(v4u*)(WT + (size_t)nn * ldk + koff + k0 + 8 * c) = o; }
    asm volatile("s_waitcnt lgkmcnt(0)" ::: "memory");
}

__device__ __forceinline__ void norm_row(const float* xrow, const float* nw, const float* sh, const float* sc, bf16_t* orow, int lane) {
    const f32x4* xr = (const f32x4*)xrow + lane;
    f32x4 v[4]; float s = 0.f;
#pragma unroll
    for (int j = 0; j < 4; ++j) { v[j] = xr[64 * j]; s += (v[j][0] * v[j][0] + v[j][1] * v[j][1]) + (v[j][2] * v[j][2] + v[j][3] * v[j][3]); }
    const float rstd = __builtin_amdgcn_rsqf(wave_sum(s) * (1.f / 1024.f) + 1e-6f);
    unsigned long long* o8 = (unsigned long long*)orow + lane;
#pragma unroll
    for (int j = 0; j < 4; ++j) { const f32x4 w = ((const f32x4*)nw)[lane + 64 * j], a = ((const f32x4*)sc)[lane + 64 * j], b = ((const f32x4*)sh)[lane + 64 * j];
        const f32x4 y = v[j] * rstd * w * (1.0f + a) + b;
        o8[64 * j] = (unsigned long long)pk2(y[0], y[1]) | ((unsigned long long)pk2(y[2], y[3]) << 32); }
}
__device__ __forceinline__ void norm_phase(const Params& P, int layer, int which  , bool first) {
    int tid_l = threadIdx.x; asm volatile("" : "+v"(tid_l));
    const int lane = tid_l & 63, wave = tid_l >> 6, gw = blockIdx.x * 8 + wave, NGW = gridDim.x * 8;
    const float* mod = (const float*)(P.ws + WS_MOD) + (size_t)layer * 5 * NMOD6 + which * 3072;
    const float* nw = P.in[which ? 10 : 9] + layer * 1024;
#define RS_RESET() do { __syncthreads(); if (threadIdx.x == 0) ((LAS int*)(lds + RED_OFF))[2048 + 64 + 256] = -1; __syncthreads(); } while (0)
    bf16_t* H = (bf16_t*)(P.ws + WS_H);
    for (int row = gw; row < NTOK; row += NGW) {
        const int cond = row < NCTX ? 0 : 1 + ((row - NCTX) >> 11);
        const float* x = first ? (row < NCTX ? P.in[0] + (size_t)row * 1024 : P.in[1] + (size_t)(row - NCTX) * 1024) : P.out + (size_t)row * 1024;
        norm_row(x, nw, mod + cond * NMOD6, mod + cond * NMOD6 + 1024, H + (size_t)row * 1024, lane);
    }
}

__device__ __forceinline__ void prep_phase(const Params& P, LAS unsigned char* lds) {
    int tid_l = threadIdx.x; asm volatile("" : "+v"(tid_l));
    const int tid = tid_l, lane = tid & 63, wave = tid >> 6, G = gridDim.x, gw = blockIdx.x * 8 + wave, NGW = G * 8;
    const float* MOD = (const float*)(P.ws + WS_MOD);
    for (int i = blockIdx.x * 512 + tid; i < NL * 2 * 5 * 1024; i += G * 512) {
        const int c = i & 1023, cond = (i >> 10) % 5, w = ((i >> 10) / 5) & 1, l = (i >> 10) / 10;
        ((float*)(P.ws + WS_WMOD))[i] = P.in[w ? 10 : 9][l * 1024 + c] * (1.0f + MOD[(size_t)(l * 5 + cond) * NMOD6 + (w ? 4 : 1) * 1024 + c]);
    }
    {
        const int r32 = lane & 31, hi = lane >> 5;
        constexpr int T_IN = NINW / 32, T_UP = DFF / 32, T_L = T_IN + T_UP;
        for (int tix = gw; tix < NL * T_L; tix += NGW) {
            const int l = tix / T_L, r = tix % T_L, w = r >= T_IN, n0 = 32 * (w ? r - T_IN : r), N = w ? DFF : NINW;
            const bf16_t* Wt = (w ? (const bf16_t*)(P.ws + WS_W1) + (size_t)l * DFF * 1024 : (const bf16_t*)(P.ws + WS_WIN) + (size_t)l * NINW * 1024) + (size_t)(n0 + r32) * 1024 + 8 * hi;
            const float* shp = MOD + (size_t)(l * 5 + (r32 < 5 ? r32 : 0)) * NMOD6 + (w ? 3 : 0) * 1024 + 8 * hi;
            f32x16 acc = {};
#pragma unroll 8
            for (int ks = 0; ks < 64; ++ks) {
                const bf16x8 bfr = *(const bf16x8*)(Wt + 16 * ks);
                bf16x8 afr = {0, 0, 0, 0, 0, 0, 0, 0};
                if (r32 < 5) { const f32x4 s0 = *(const f32x4*)(shp + 16 * ks), s1 = *(const f32x4*)(shp + 16 * ks + 4);
                    v4u t; t.x = pk2(s0[0], s0[1]); t.y = pk2(s0[2], s0[3]); t.z = pk2(s1[0], s1[1]); t.w = pk2(s1[2], s1[3]); afr = __builtin_bit_cast(bf16x8, t); }
                acc = __builtin_amdgcn_mfma_f32_32x32x16_bf16(afr, bfr, acc, 0, 0, 0);
            }
            float* SW = w ? (float*)(P.ws + WS_SWUP) + (size_t)l * 5 * DFF : (float*)(P.ws + WS_SWIN) + (size_t)l * 5 * NINW;
            if (hi == 0) { SW[(size_t)0 * N + n0 + r32] = acc[0]; SW[(size_t)1 * N + n0 + r32] = acc[1]; SW[(size_t)2 * N + n0 + r32] = acc[2]; SW[(size_t)3 * N + n0 + r32] = acc[3]; }
            else SW[(size_t)4 * N + n0 + r32] = acc[0];
        }
    }
    bf16_t* H = (bf16_t*)(P.ws + WS_H); float* SSQ = (float*)(P.ws + WS_SSQ);
    for (int row = gw; row < NTOK; row += NGW) {
        const int cond = row < NCTX ? 0 : 1 + ((row - NCTX) >> 11);
        const float* x = row < NCTX ? P.in[0] + (size_t)row * 1024 : P.in[1] + (size_t)(row - NCTX) * 1024;
        const f32x4* xr = (const f32x4*)x + lane; const f32x4* nw = (const f32x4*)P.in[9] + lane; const f32x4* sc = (const f32x4*)(MOD + (size_t)cond * NMOD6 + 1024) + lane;
        unsigned long long* o8 = (unsigned long long*)(H + (size_t)row * 1024) + lane;
        float s = 0.f;
#pragma unroll
        for (int j = 0; j < 4; ++j) { const f32x4 v = xr[64 * j]; s += (v[0] * v[0] + v[1] * v[1]) + (v[2] * v[2] + v[3] * v[3]);
            const f32x4 y = v * nw[64 * j] * (1.0f + sc[64 * j]);
            o8[64 * j] = (unsigned long long)pk2(y[0], y[1]) | ((unsigned long long)pk2(y[2], y[3]) << 32); }
        s = wave_sum(s);
        if (lane < 16) SSQ[(size_t)row * 16 + lane] = lane == 0 ? s : 0.f;
    }
}

__device__ __forceinline__ void prologue(const Params& P, LAS unsigned char* lds) {
    int tid_l = threadIdx.x; asm volatile("" : "+v"(tid_l));
    const int tid = tid_l, lane = tid & 63, wave = tid >> 6, G = gridDim.x;
    const int gw = blockIdx.x * 8 + wave, NGW = G * 8;
    LAS float* scr = (LAS float*)(lds + wave * 16384);
    constexpr int I_IN = 16 * 176, I_O = 16 * 32, I_1 = 16 * 128, I_2 = 64 * 32, I_L = I_IN + 3 * I_O + I_1 + I_2;
    for (int it = gw; it < NL * I_L; it += NGW) {
        const int l = it / I_L; int r = it % I_L;
        if (r < I_IN) { tr_item<true>(P.in[11] + (size_t)l * 1024 * NINW, 1024, NINW, (bf16_t*)(P.ws + WS_WIN) + (size_t)l * NINW * 1024, 1024, 0, scr, r, lane); continue; } r -= I_IN;
        if (r < I_O) { tr_item<false>(P.in[22] + (size_t)l * 1024 * 1024, 1024, 1024, (bf16_t*)(P.ws + WS_WCAT) + (size_t)l * 1024 * 2048, 2048, 0, scr, r, lane); continue; } r -= I_O;
        if (r < I_O) { tr_item<false>(P.in[23] + (size_t)l * 1024 * 1024, 1024, 1024, (bf16_t*)(P.ws + WS_WCAT) + (size_t)l * 1024 * 2048, 2048, 1024, scr, r, lane); continue; } r -= I_O;
        if (r < I_O) { tr_item<false>(P.in[24] + (size_t)l * 1024 * 1024, 1024, 1024, (bf16_t*)(P.ws + WS_WOUT) + (size_t)l * 1024 * 1024, 1024, 0, scr, r, lane); continue; } r -= I_O;
        if (r < I_1) { tr_item<false>(P.in[25] + (size_t)l * 1024 * DFF, 1024, DFF, (bf16_t*)(P.ws + WS_W1) + (size_t)l * DFF * 1024, 1024, 0, scr, r, lane); continue; } r -= I_1;
        tr_item<false>(P.in[26] + (size_t)l * DFF * 1024, DFF, 1024, (bf16_t*)(P.ws + WS_W2) + (size_t)l * 1024 * DFF, DFF, 0, scr, r, lane);
    }
    __syncthreads();
    {
        LAS float* sv = (LAS float*)lds; LAS float* rb = (LAS float*)(lds + 20480);
        for (int i = tid; i < 5120; i += 512) { const int cond = i >> 10, k = i & 1023; const float x = cond == 0 ? P.in[6][k] : P.in[5][(cond - 1) * 1024 + k]; sv[i] = x * __builtin_amdgcn_rcpf(1.0f + __expf(-x)); }
        __syncthreads();
        for (int it = blockIdx.x; it < NL * 96; it += G) {
            const int l = it / 96, cg_ = it % 96;
            const float* W = P.in[7] + ((size_t)l * 1024 + wave * 128) * NMOD6 + cg_ * 64 + lane;
            float a0 = 0.f, a1 = 0.f, a2 = 0.f, a3 = 0.f, a4 = 0.f;
#pragma unroll 16
            for (int k = 0; k < 128; ++k) { const float w = __builtin_nontemporal_load(&W[(size_t)k * NMOD6]); const int kk = wave * 128 + k;
                a0 += sv[kk] * w; a1 += sv[1024 + kk] * w; a2 += sv[2048 + kk] * w; a3 += sv[3072 + kk] * w; a4 += sv[4096 + kk] * w; }
            rb[(wave * 5 + 0) * 64 + lane] = a0; rb[(wave * 5 + 1) * 64 + lane] = a1; rb[(wave * 5 + 2) * 64 + lane] = a2; rb[(wave * 5 + 3) * 64 + lane] = a3; rb[(wave * 5 + 4) * 64 + lane] = a4;
            __syncthreads();
            if (tid < 320) { const int cond = tid >> 6; float s = 0.f;
#pragma unroll
                for (int w = 0; w < 8; ++w) s += rb[(w * 5 + cond) * 64 + lane];
                s += P.in[8][l * NMOD6 + cg_ * 64 + lane];
                ((float*)(P.ws + WS_MOD))[(size_t)(l * 5 + cond) * NMOD6 + cg_ * 64 + lane] = s; }
            __syncthreads();
        }
    }
    const int gt = blockIdx.x * 512 + tid, NGT = G * 512;
#ifdef NANFILL
    { v4u nanv = {0x7FC07FC0u, 0x7FC07FC0u, 0x7FC07FC0u, 0x7FC07FC0u};
      v4u* a = (v4u*)(P.ws + WS_H); const size_t na = (WS_END - WS_H) / 16;
      for (size_t i = gt; i < na; i += NGT) a[i] = nanv;
      v4u* o = (v4u*)P.out; const size_t no = (size_t)(33554432 + 262144) / 4;
      for (size_t i = gt; i < no; i += NGT) o[i] = nanv; }
#endif
    for (int i = gt; i < 4 * 4 * 512 * 256 / 2; i += NGT) {
        const int e = 2 * i, p = e & 127, base = e & ~127;
        const float* ck = P.in[2] + base;
        ((unsigned*)(P.ws + WS_CK))[i] = pk2(ck[dim_of_pos(p)], ck[dim_of_pos(p + 1)]);
        ((unsigned*)(P.ws + WS_CV))[i] = pk2(P.in[3][e], P.in[3][e + 1]);
    }
    for (int i = gt; i < NL * 2 * 8 * 2 * 4 * 8 * 64; i += NGT) {
        const int ln = i & 63, ks = (i >> 6) & 7, w4 = (i >> 9) & 3, gate = (i >> 11) & 1, nb = (i >> 12) & 7, dr = (i >> 15) & 1, l = i >> 16;
        const float* W = (gate ? P.in[20] : P.in[18]) + ((size_t)((l * 2 + dr) * 8 + nb) * 128) * 128 + w4 * 32 + (ln & 31);
        float v[8];
#pragma unroll
        for (int j = 0; j < 8; ++j) v[j] = W[(16 * ks + 8 * (ln >> 5) + j) * 128];
        v4u o; o.x = pk2(v[0], v[1]); o.y = pk2(v[2], v[3]); o.z = pk2(v[4], v[5]); o.w = pk2(v[6], v[7]);
        ((v4u*)(P.ws + WS_WFR))[i] = o;
    }
    for (int i = gt; i < 2048 * 64; i += NGT) {
        const int t = i >> 6, pi = i & 63, ax = pi >> 5, fi = pi & 31;
        const float freq = powf(10000.0f, -(float)(2 * fi) / 64.0f);
        const float ang = (float)(ax == 0 ? (t >> 6) : (t & 63)) * freq;
        float* o = (float*)(P.ws + WS_ROPE) + (size_t)i * 2; o[0] = cosf(ang); o[1] = sinf(ang);
    }
}

__device__ __forceinline__ int crow16(int r, int hi) { return (r & 3) + 8 * (r >> 2) + 4 * hi; }
__device__ __forceinline__ float partner32(float x, int hi) { auto rr = __builtin_amdgcn_permlane32_swap(__float_as_uint(x), __float_as_uint(x), false, false); return __uint_as_float(hi ? rr[0] : rr[1]); }
__device__ __forceinline__ void lru_unit(const Params& P, int layer, int latent, int b, int seg, int nblk, LAS unsigned char* lds) {
    int tid_l = threadIdx.x; asm volatile("" : "+v"(tid_l));
    const int tid = tid_l, lane = tid & 63, r32 = lane & 31, hi = lane >> 5;
    const int wid = __builtin_amdgcn_readfirstlane(tid >> 6), dir = wid >> 2, w4 = wid & 3, gt = tid & 255;
    constexpr int nch = 8;
    const int Tseq = latent ? 2048 : 256, t0seg = seg * 256;
    const int rowseq = latent ? NCTX + b * 2048 : b * 256, rowbase = rowseq + t0seg;
    const int chl = w4 * 32 + r32, ch = nblk * 128 + chl;
    constexpr int TILEB = 32 * 272;
    LAS unsigned char* tiles = lds;
    LAS float* cw = (LAS float*)(lds + 8 * TILEB);
    const bf16_t* XR = (const bf16_t*)(P.ws + WS_XR);
    bf16_t* HT = ((bf16_t*)P.out + (size_t)16777216);
    bf16_t* ACAT = (bf16_t*)(P.ws + WS_ACAT);
    bf16_t* PD = (bf16_t*)(P.ws + (dir ? WS_PB : WS_PF));
    for (int i = tid; i < 640; i += 512) cw[i] = (i < 512) ? P.in[15][((size_t)layer * 4 + (i >> 7)) * 1024 + nblk * 128 + (i & 127)] : P.in[16][layer * 1024 + nblk * 128 + (i & 127)];
    bf16x8 bR[8], bI0;
    LAS unsigned char* wib = lds + 72704 + wid * 7168 + lane * 16;
    {
        const v4u* fr = (const v4u*)(P.ws + WS_WFR) + ((size_t)(((layer * 2 + dir) * 8 + nblk) * 2) * 4 + w4) * 512 + lane;
#pragma unroll
        for (int ks = 0; ks < 8; ++ks) { const v4u a = fr[ks * 64], g = fr[2048 + ks * 64];
            bR[ks] = __builtin_bit_cast(bf16x8, a); if (ks == 0) bI0 = __builtin_bit_cast(bf16x8, g); else *(LAS v4u*)(wib + (ks - 1) * 1024) = g; }
    }
    const float ba = P.in[19][(layer * 2 + dir) * 1024 + ch], bi = P.in[21][(layer * 2 + dir) * 1024 + ch];
    const float lam = P.in[17][(layer * 2 + dir) * 1024 + ch];
    const float clam = -8.0f * 1.4426950408889634f * log1pf(__expf(-lam));
    float h = 0.f, p = 1.f;
    const int st = 2 * (gt >> 4), c8 = (gt & 15) * 8;
    const int strow = 8 * ((st & 15) >> 2) + 4 * (st >> 4) + (st & 3);
    v4u pre[5];
#define LRU_LOAD(ck_) do { const int ck__ = (ck_); _Pragma("unroll") for (int i = 0; i < 5; ++i) { \
        const int tt = t0seg + ck__ * 32 + st + i - 2; \
        pre[i] = (tt >= 0 && tt < Tseq) ? *(const v4u*)(XR + (size_t)(rowseq + tt) * 1024 + nblk * 128 + c8) : (v4u){0u, 0u, 0u, 0u}; } } while (0)
#define LRU_CONV(buf_) do { float y0[8], y1[8]; { const f32x4 b0 = *(const LAS f32x4*)(cw + 512 + c8), b1 = *(const LAS f32x4*)(cw + 512 + c8 + 4); \
            _Pragma("unroll") for (int j = 0; j < 4; ++j) { y0[j] = b0[j]; y0[4 + j] = b1[j]; y1[j] = b0[j]; y1[4 + j] = b1[j]; } } \
        _Pragma("unroll") for (int k = 0; k < 4; ++k) { const f32x4 w0 = *(const LAS f32x4*)(cw + k * 128 + c8), w1 = *(const LAS f32x4*)(cw + k * 128 + c8 + 4); \
            const v4u xa = pre[k], xb = pre[k + 1]; \
            _Pragma("unroll") for (int q = 0; q < 4; ++q) { const float wlo = q < 2 ? w0[2 * q] : w1[2 * q - 4], whi = q < 2 ? w0[2 * q + 1] : w1[2 * q - 3]; \
                y0[2 * q] += wlo * __uint_as_float(xa[q] << 16); y0[2 * q + 1] += whi * __uint_as_float(xa[q] & 0xffff0000u); \
                y1[2 * q] += wlo * __uint_as_float(xb[q] << 16); y1[2 * q + 1] += whi * __uint_as_float(xb[q] & 0xffff0000u); } } \
        v4u o; o.x = pk2(y0[0], y0[1]); o.y = pk2(y0[2], y0[3]); o.z = pk2(y0[4], y0[5]); o.w = pk2(y0[6], y0[7]); \
        *(LAS v4u*)(tiles + (buf_) * TILEB + strow * 272 + c8 * 2) = o; \
        o.x = pk2(y1[0], y1[1]); o.y = pk2(y1[2], y1[3]); o.z = pk2(y1[4], y1[5]); o.w = pk2(y1[6], y1[7]); \
        *(LAS v4u*)(tiles + (buf_) * TILEB + (strow + 1) * 272 + c8 * 2) = o; } while (0)
    LRU_LOAD(dir ? nch - 1 : 0);
    __syncthreads();
    LRU_CONV(dir ? nch - 1 : 0);
    __syncthreads();
    for (int k = 0; k < nch; ++k) {
        const int ck = dir ? nch - 1 - k : k;
        const LAS unsigned char* tile = tiles + ck * TILEB;
        f32x16 aR = {}, aI = {};
#pragma unroll
        for (int ks = 0; ks < 8; ++ks) { const bf16x8 af = *(const LAS bf16x8*)(tile + r32 * 272 + (16 * ks + 8 * hi) * 2);
            aR = __builtin_amdgcn_mfma_f32_32x32x16_bf16(af, bR[ks], aR, 0, 0, 0);
            aI = __builtin_amdgcn_mfma_f32_32x32x16_bf16(af, ks == 0 ? bI0 : *(const LAS bf16x8*)(wib + (ks - 1) * 1024), aI, 0, 0, 0); }
        float av[16], bv[16];
#pragma unroll
        for (int r = 0; r < 16; ++r) { const int t = crow16(r, hi);
            const float x = bf2f(*(const LAS unsigned short*)(tile + t * 272 + chl * 2));
            const float eu = 1.0f + __builtin_amdgcn_exp2f(-1.4426950408889634f * (aR[r] + ba)), ev = 1.0f + __builtin_amdgcn_exp2f(-1.4426950408889634f * (aI[r] + bi));
            const float inv = __builtin_amdgcn_rcpf(eu * ev);
            const float rr = ev * inv, ii = eu * inv;
            const float a = __builtin_amdgcn_exp2f(clam * rr);
            av[r] = a; bv[r] = __builtin_amdgcn_sqrtf(fmaxf(fmaf(-a, a, 1.0f), 0.f)) * (ii * x); }
        if (k < 3) LRU_LOAD(dir ? nch - 2 - k : k + 1);
        if (dir == 0) {
#pragma unroll
            for (int r = 1; r < 16; ++r) { bv[r] = fmaf(av[r], bv[r - 1], bv[r]); av[r] *= av[r - 1]; }
            const float ho = fmaf(av[15], h, bv[15]), po = av[15] * p;
            const float nh = partner32(ho, hi), np = partner32(po, hi);
            const float hin = hi ? nh : h, pin = hi ? np : p;
#pragma unroll
            for (int r = 0; r < 16; ++r) { bv[r] = fmaf(av[r], hin, bv[r]); av[r] *= pin; }
            const float eh = partner32(bv[15], hi), ep = partner32(av[15], hi);
            h = hi ? bv[15] : eh; p = hi ? av[15] : ep;
        } else {
#pragma unroll
            for (int r = 14; r >= 0; --r) { bv[r] = fmaf(av[r], bv[r + 1], bv[r]); av[r] *= av[r + 1]; }
            const float ho = fmaf(av[0], h, bv[0]), po = av[0] * p;
            const float nh = partner32(ho, hi), np = partner32(po, hi);
            const float hin = hi ? h : nh, pin = hi ? p : np;
#pragma unroll
            for (int r = 0; r < 16; ++r) { bv[r] = fmaf(av[r], hin, bv[r]); av[r] *= pin; }
            const float eh = partner32(bv[0], hi), ep = partner32(av[0], hi);
            h = hi ? eh : bv[0]; p = hi ? ep : av[0];
        }
        {
            char* hb_ = dir ? (char*)ACAT + (size_t)(rowbase + ck * 32) * 4096 + 2048 : (char*)HT + (size_t)(rowbase + ck * 32) * 2048;
            const unsigned rs_ = dir ? 4096u : 2048u;
            const unsigned lo1 = (unsigned)(16 * hi) * rs_ + (unsigned)(ch * 2);
#pragma unroll
            for (int r = 0; r < 16; ++r) *(bf16_t*)(hb_ + (lo1 + (unsigned)r * rs_)) = f2bfh(bv[r]);
            if (latent) {
                char* pdb = (char*)PD + (size_t)(rowbase - NCTX + ck * 32) * 2048;
                const unsigned lo2 = (unsigned)((16 * hi) * 2048 + ch * 2);
#pragma unroll
                for (int r = 0; r < 16; ++r) *(bf16_t*)(pdb + (lo2 + (unsigned)(r * 2048))) = f2bfh(av[r]);
            }
        }
        if (k < 3) LRU_CONV(dir ? nch - 2 - k : k + 1);
        asm volatile("s_waitcnt lgkmcnt(0)\n\ts_barrier" ::: "memory");
    }
    if (hi == 0) {
        if (latent) { float* tot = (float*)(P.ws + WS_TOT) + ((size_t)(((b * 8 + nblk) * 8 + seg) * 2 + dir) * 2) * 128 + chl; tot[0] = p; tot[128] = h; }
        else P.out[OUT_S + ((size_t)(b * 4 + layer) * 2 + dir) * 1024 + ch] = h;
    }
    asm volatile("s_waitcnt vmcnt(0)" ::: "memory"); __syncthreads();
    if (!latent) {
        const bf16_t* GXB = ((const bf16_t*)P.out);
#pragma unroll
        for (int hb4 = 0; hb4 < 2; ++hb4) {
            v4u hf[4], hb[4], gx[4];
#pragma unroll
            for (int i = 0; i < 4; ++i) { const int it = tid + (hb4 * 4 + i) * 512; const size_t row = (size_t)rowbase + (it >> 4); const int col = nblk * 128 + (it & 15) * 8;
                hf[i] = *(const v4u*)(HT + row * 1024 + col); hb[i] = *(const v4u*)(ACAT + row * 2048 + 1024 + col); gx[i] = *(const v4u*)(GXB + row * 1024 + col); }
#pragma unroll
            for (int i = 0; i < 4; ++i) { const int it = tid + (hb4 * 4 + i) * 512; const size_t row = (size_t)rowbase + (it >> 4); const int col = nblk * 128 + (it & 15) * 8;
                v4u o;
#pragma unroll
                for (int q = 0; q < 4; ++q) {
                    const float ylo = (__uint_as_float(hf[i][q] << 16) + __uint_as_float(hb[i][q] << 16)) * __uint_as_float(gx[i][q] << 16);
                    const float yhi = (__uint_as_float(hf[i][q] & 0xffff0000u) + __uint_as_float(hb[i][q] & 0xffff0000u)) * __uint_as_float(gx[i][q] & 0xffff0000u);
                    o[q] = pk2(ylo, yhi); }
                *(v4u*)(ACAT + row * 2048 + 1024 + col) = o; }
        }
    }
    if (latent) {
        if (tid == 0) { __builtin_amdgcn_fence(__ATOMIC_RELEASE, "agent"); asm volatile("s_waitcnt vmcnt(0)" ::: "memory");
            __hip_atomic_fetch_add((unsigned*)(P.ws + WS_CTL) + CW_DONE + ((layer * 4 + b) * 8 + nblk) * 16, 1u, __ATOMIC_RELAXED, __HIP_MEMORY_SCOPE_AGENT); }
    }
#undef LRU_LOAD
#undef LRU_CONV
}

__device__ __forceinline__ void lru_fix_unit(const Params& P, int layer, int u, LAS unsigned char* lds) {
    int tid_l = threadIdx.x; asm volatile("" : "+v"(tid_l));
    const int tid = tid_l;
    LAS float* carr = (LAS float*)lds;
    const bf16_t* HT = ((const bf16_t*)P.out + (size_t)16777216); const bf16_t* PF = (const bf16_t*)(P.ws + WS_PF); const bf16_t* PB = (const bf16_t*)(P.ws + WS_PB);
    bf16_t* ACAT = (bf16_t*)(P.ws + WS_ACAT);
    {
        const int b = u >> 6, n = (u >> 3) & 7, seg = u & 7;
        if (tid == 0) {
            unsigned* dn = (unsigned*)(P.ws + WS_CTL) + CW_DONE + ((layer * 4 + b) * 8 + n) * 16; unsigned spins = 0;
            while (__hip_atomic_load(dn, __ATOMIC_RELAXED, __HIP_MEMORY_SCOPE_AGENT) < 8u && ++spins < (1u << 22)) __builtin_amdgcn_s_sleep(4);
            __builtin_amdgcn_fence(__ATOMIC_ACQUIRE, "agent"); asm volatile("s_waitcnt vmcnt(0)" ::: "memory");
        }
        __syncthreads();
        if (tid < 256) {
            const int dir = tid >> 7, c = tid & 127;
            float cy = P.in[4][((size_t)(b * 4 + layer) * 2 + dir) * 1024 + n * 128 + c];
            const float* tot = (const float*)(P.ws + WS_TOT) + ((size_t)((b * 8 + n) * 8) * 2 + dir) * 2 * 128 + c;
            float tp[8], th[8];
#pragma unroll
            for (int j = 0; j < 8; ++j) { tp[j] = tot[j * 512]; th[j] = tot[j * 512 + 128]; }
            if (dir == 0) {
#pragma unroll
                for (int j = 0; j < 7; ++j) if (j < seg) cy = fmaf(tp[j], cy, th[j]);
            } else {
#pragma unroll
                for (int j = 7; j > 0; --j) if (j > seg) cy = fmaf(tp[j], cy, th[j]);
            }
            carr[tid] = cy;
        }
        __syncthreads();
        const size_t row0 = (size_t)NCTX + b * 2048 + seg * 256;
#pragma unroll
        for (int hb4 = 0; hb4 < 2; ++hb4) {
            v4u s[4], s2[4], pf[4], pb[4], gx[4];
#pragma unroll
            for (int i = 0; i < 4; ++i) { const int it = tid + (hb4 * 4 + i) * 512; const size_t row = row0 + (it >> 4); const int col = n * 128 + (it & 15) * 8;
                s[i] = *(const v4u*)(HT + row * 1024 + col); s2[i] = *(const v4u*)(ACAT + row * 2048 + 1024 + col);
                pf[i] = *(const v4u*)(PF + (row - NCTX) * 1024 + col); pb[i] = *(const v4u*)(PB + (row - NCTX) * 1024 + col);
                gx[i] = *(const v4u*)((const bf16_t*)P.out + row * 1024 + col); }
#pragma unroll
            for (int i = 0; i < 4; ++i) { const int it = tid + (hb4 * 4 + i) * 512; const size_t row = row0 + (it >> 4); const int c8 = (it & 15) * 8, col = n * 128 + c8;
                const f32x4 cf0 = *(const LAS f32x4*)(carr + c8), cf1 = *(const LAS f32x4*)(carr + c8 + 4), cb0 = *(const LAS f32x4*)(carr + 128 + c8), cb1 = *(const LAS f32x4*)(carr + 128 + c8 + 4);
                v4u o;
#pragma unroll
                for (int q = 0; q < 4; ++q) { const float cfl = q < 2 ? cf0[2 * q] : cf1[2 * q - 4], cfh = q < 2 ? cf0[2 * q + 1] : cf1[2 * q - 3], cbl = q < 2 ? cb0[2 * q] : cb1[2 * q - 4], cbh = q < 2 ? cb0[2 * q + 1] : cb1[2 * q - 3];
                    const float ylo = (__uint_as_float(s[i][q] << 16) + __uint_as_float(s2[i][q] << 16) + __uint_as_float(pf[i][q] << 16) * cfl + __uint_as_float(pb[i][q] << 16) * cbl) * __uint_as_float(gx[i][q] << 16);
                    const float yhi = (__uint_as_float(s[i][q] & 0xffff0000u) + __uint_as_float(s2[i][q] & 0xffff0000u) + __uint_as_float(pf[i][q] & 0xffff0000u) * cfh + __uint_as_float(pb[i][q] & 0xffff0000u) * cbh) * __uint_as_float(gx[i][q] & 0xffff0000u);
                    o[q] = pk2(ylo, yhi); }
                *(v4u*)(ACAT + row * 2048 + 1024 + col) = o; }
        }
        __syncthreads();
    }
}

__device__ __forceinline__ void mixer_phase(const Params& P, int layer, unsigned char* lds_generic, LAS unsigned char* lds, int rep, const pg8::EpiIn& EI) {
    unsigned* ctr = (unsigned*)(P.ws + WS_CTL) + CW_QUEUE + 64 * (layer + 4 * rep);
    volatile LAS unsigned* misc = (volatile LAS unsigned*)(lds + MISC_OFF);
    const bf16_t* Q = (const bf16_t*)(P.ws + WS_Q); const bf16_t* KB = (const bf16_t*)(P.ws + WS_KB); const bf16_t* VB = (const bf16_t*)(P.ws + WS_VB);
    const bf16_t* CK = (const bf16_t*)(P.ws + WS_CK); const bf16_t* CV = (const bf16_t*)(P.ws + WS_CV);
    bf16_t* ACAT = (bf16_t*)(P.ws + WS_ACAT);
    if (threadIdx.x == 0) misc[0] = __hip_atomic_fetch_add(ctr, 1u, __ATOMIC_RELAXED, __HIP_MEMORY_SCOPE_AGENT);
    for (int it = 0;; ++it) {
        __syncthreads();
        unsigned nxt = 0u;
        if (threadIdx.x == 0) nxt = __hip_atomic_fetch_add(ctr, 1u, __ATOMIC_RELAXED, __HIP_MEMORY_SCOPE_AGENT);
        const int tk = __builtin_amdgcn_readfirstlane((int)misc[it & 1]);
        if (tk >= 1408) break;
        const int idx = tk < 768 ? tk : (tk < 896 ? tk - 896 : tk - 128);
        if (idx < 0) {
            const int u = idx + 128;
            pg8::Gemm g{(const bf16_t*)(P.ws + WS_H), (const bf16_t*)(P.ws + WS_WIN) + (size_t)layer * NINW * 1024, NTOK, NINW, 1024};
            if (threadIdx.x == 0) ((LAS int*)(lds + RED_OFF))[2048 + 64 + 256] = -1;
            __syncthreads();
            OneUnit S1{u & 63, 20 + (u >> 6)};
            pg8::gemm_phase<pg8::EpiIn, OneUnit, true, true>(lds, g, S1, EI);
        }
        else if (idx >= 1024) { lru_fix_unit(P, layer, idx - 1024, lds); }
        else if (idx >= 256 && idx < 768) {
#ifndef NO_LRU
            const int j = idx - 256, latent = j < 256, jj = j & 255;
            lru_unit(P, layer, latent, latent ? (jj >> 6) : (jj >> 3), latent ? ((jj >> 3) & 7) : 0, jj & 7, lds);
#endif
        } else {
#ifndef NO_ATT
            const bool latent = idx < 256;
            const int j = latent ? idx : idx - 768;
            const int b = latent ? (j >> 6) : (j >> 3), hh = latent ? ((j >> 3) & 7) : (j & 7), qb = latent ? (j & 7) : 0, kvh = hh >> 2;
            const int q0 = qb * 256, ks = q0 - 128 < 0 ? 0 : q0 - 128, ke = q0 + 384 > 2048 ? 2048 : q0 + 384;
            const size_t rq = latent ? (size_t)NCTX + b * 2048 + q0 : (size_t)b * 256;
            const size_t rk = (size_t)NCTX + b * 2048 + ks, ck0 = (size_t)(b * 4 + layer) * 512;
            const bf16_t* K0 = latent ? CK + ck0 * 256 + kvh * 128 : KB + rq * 256 + kvh * 128;
            const bf16_t* V0 = latent ? CV + ck0 * 256 + kvh * 128 : VB + rq * 256 + kvh * 128;
            att::attn_unit(Q + rq * 1024 + hh * 128, K0, V0, latent ? 8 : 4,
                           KB + rk * 256 + kvh * 128, VB + rk * 256 + kvh * 128, latent ? (ke - ks) / 64 : 0, ks - q0,
                           P.in[14][layer * 8 + hh] * 1.4426950408889634f, ACAT + rq * 2048 + hh * 128, (char*)lds_generic);
#endif
        }
        if (threadIdx.x == 0) misc[(it + 1) & 1] = nxt;
    }
}

__global__ void __launch_bounds__(512, 2) fwd_megakernel(Params P) {
    extern __shared__ __attribute__((aligned(16))) unsigned char lds_raw[];
    LAS unsigned char* lds = (LAS unsigned char*)lds_raw;
    cg::grid_group grid = cg::this_grid();
    const int lo = P.ph_lo, hi = P.ph_hi, G = gridDim.x;
    int ph = 0;
    { volatile LAS unsigned* m = (volatile LAS unsigned*)(lds + MISC_OFF); if (threadIdx.x < 16) m[threadIdx.x] = 0u; }
    __syncthreads();
    XcdBarrier bar = xcd_barrier_post((unsigned*)(P.ws + WS_CTL) + CW_BAR, (volatile LAS unsigned*)(lds + MISC_OFF) + 8);
#define PHASE(...) do { if (ph >= lo && ph < hi) { __VA_ARGS__; if (ph + 1 < hi) { if (lo < 0) grid.sync(); else xcd_barrier(bar); } } ++ph; } while (0)
    bf16_t* H = (bf16_t*)(P.ws + WS_H);
#ifndef NO_PRO
    PHASE(prologue(P, lds));
#endif
    PHASE(prep_phase(P, lds));
#ifdef XSYNC
    if (hi > 1) { for (int i = 0; i < XSYNC; ++i) grid.sync(); }
#endif
    for (int l = 0; l < NL; ++l) {
        const float* mod = (const float*)(P.ws + WS_MOD) + (size_t)l * 5 * NMOD6;
        const pg8::EpiIn EI{(bf16_t*)(P.ws + WS_Q), (bf16_t*)(P.ws + WS_KB), (bf16_t*)(P.ws + WS_VB), (bf16_t*)(P.ws + WS_XR), ((bf16_t*)P.out), (bf16_t*)(P.ws + WS_G),
                         P.out + OUT_K, P.out + OUT_V, P.in[12] + l * 128, P.in[13] + l * 128, (const float*)(P.ws + WS_ROPE), (LAS float*)(lds + RED_OFF), l,
                         (const float*)(P.ws + WS_SSQ), (const float*)(P.ws + WS_SWIN) + (size_t)l * 5 * NINW};
        PHASE({ RS_RESET(); pg8::Gemm g{H, (const bf16_t*)(P.ws + WS_WIN) + (size_t)l * NINW * 1024, NTOK, NINW, 1024}; pg8::StaticOrder S; S.init(NTOK, 5120, G, opaque_bid());
            pg8::gemm_phase<pg8::EpiIn, pg8::StaticOrder, true, true>(lds, g, S, EI); });
        PHASE({ _Pragma("nounroll") for (int rep = 0; rep < XREP_MIX; ++rep) { mixer_phase(P, l, lds_raw, lds, rep, EI); if (rep + 1 < XREP_MIX) xcd_barrier(bar); } });
        PHASE({ pg8::Gemm g{(const bf16_t*)(P.ws + WS_ACAT), (const bf16_t*)(P.ws + WS_WCAT) + (size_t)l * 1024 * 2048, NTOK, 1024, 2048}; pg8::StaticOrder S; S.init(NTOK, 1024, G, opaque_bid());
            pg8::EpiMerge E{(const bf16_t*)(P.ws + WS_G), (bf16_t*)(P.ws + WS_MERGED)};

#ifndef NO_G2
 pg8::gemm_phase<pg8::EpiMerge, pg8::StaticOrder, true, true>(lds, g, S, E);
#endif
 });
        PHASE({ pg8::Gemm g{(const bf16_t*)(P.ws + WS_MERGED), (const bf16_t*)(P.ws + WS_WOUT) + (size_t)l * 1024 * 1024, NTOK, 1024, 1024}; pg8::StaticOrder S; S.init(NTOK, 1024, G, opaque_bid());
            pg8::EpiRes E{l == 0 ? P.in[0] : (const float*)nullptr, P.in[1] - (size_t)NCTX * 1024, (const bf16_t*)(P.ws + WS_X16), (bf16_t*)(P.ws + WS_X16), (float*)nullptr, mod + 2048, H, (const float*)(P.ws + WS_WMOD) + (size_t)(l * 2 + 1) * 5 * 1024, (float*)(P.ws + WS_SSQ)};

#ifndef NO_G3
 pg8::gemm_phase<pg8::EpiRes, pg8::StaticOrder, true, true>(lds, g, S, E);
#endif
 });
        PHASE({ RS_RESET(); pg8::Gemm g{H, (const bf16_t*)(P.ws + WS_W1) + (size_t)l * DFF * 1024, NTOK, DFF, 1024}; pg8::StaticOrder S; S.init(NTOK, DFF, G, opaque_bid());
            pg8::EpiUp E{(bf16_t*)(P.ws + WS_U), (const float*)(P.ws + WS_SSQ), (const float*)(P.ws + WS_SWUP) + (size_t)l * 5 * DFF, (LAS float*)(lds + RED_OFF) + 2048 + 64};

#ifndef NO_G4
 pg8::gemm_phase<pg8::EpiUp, pg8::StaticOrder, true, true>(lds, g, S, E);
#endif
 });
        PHASE({ pg8::Gemm g{(const bf16_t*)(P.ws + WS_U), (const bf16_t*)(P.ws + WS_W2) + (size_t)l * 1024 * DFF, NTOK, 1024, DFF}; pg8::StaticOrder S; S.init(NTOK, 1024, G, opaque_bid());
            pg8::EpiRes E{(const float*)nullptr, (const float*)nullptr, (const bf16_t*)(P.ws + WS_X16), (bf16_t*)(P.ws + WS_X16), l + 1 < NL ? (float*)nullptr : P.out, mod + 5 * 1024, l + 1 < NL ? H : (bf16_t*)nullptr, (const float*)(P.ws + WS_WMOD) + (size_t)((l + 1) * 2) * 5 * 1024, (float*)(P.ws + WS_SSQ)};

#ifndef NO_G3
 pg8::gemm_phase<pg8::EpiRes, pg8::StaticOrder, true, true>(lds, g, S, E);
#endif
 });
    }
#undef PHASE
#ifdef DUMP_PH
    grid.sync();
    { const v4u* src = (const v4u*)(P.ws + (size_t)DUMP_OFF * MiB); v4u* dst = (v4u*)P.out; const size_t n = (size_t)(33554432 + 262144) / 4;
      const size_t nl = (size_t)DUMP_LEN * MiB / 16; const v4u z = {0u, 0u, 0u, 0u};
      for (size_t i = (size_t)blockIdx.x * 512 + threadIdx.x; i < n; i += (size_t)gridDim.x * 512) dst[i] = i < nl ? src[i] : z; }
#endif
}

extern "C" void kernel_launch(void* const* d_in, const int* in_sizes, int n_in, void* d_out, int out_size, void* d_ws, size_t ws_size, hipStream_t stream) {
    static int grid = 0;
    if (grid == 0) {
        if (n_in != 27 || ws_size < WS_END) { fprintf(stderr, "kernel_launch: unexpected n_in %d / ws_size %zu (need %zu)\n", n_in, ws_size, (size_t)WS_END); grid = -1; return; }
        int dev = 0, cus = 0, per_cu = 0;
        (void)hipGetDevice(&dev); (void)hipDeviceGetAttribute(&cus, hipDeviceAttributeMultiprocessorCount, dev);
        if (hipFuncSetAttribute((const void*)fwd_megakernel, hipFuncAttributeMaxDynamicSharedMemorySize, LDS_BYTES) != hipSuccess) { fprintf(stderr, "kernel_launch: hipFuncSetAttribute failed\n"); grid = -1; return; }
        if (hipOccupancyMaxActiveBlocksPerMultiprocessor(&per_cu, (const void*)fwd_megakernel, 512, LDS_BYTES) != hipSuccess || per_cu < 1) { fprintf(stderr, "kernel_launch: occupancy query says %d\n", per_cu); per_cu = 1; }
        (void)hipGetLastError();
        grid = cus * 1;
        if (grid <= 0) grid = 256;
    }
    if (grid < 0) return;
    (void)hipMemsetAsync((char*)d_ws + WS_CTL, 0, 65536, stream);
    Params p{};
    for (int i = 0; i < 27; ++i) p.in[i] = (const float*)d_in[i];
    p.out = (float*)d_out; p.ws = (unsigned char*)d_ws;
#ifndef MK_SPLIT
#ifdef DUMP_PH
    p.ph_lo = 0; p.ph_hi = DUMP_PH;
#else
    p.ph_lo = 0; p.ph_hi = 1000;
#endif
    void* args[] = {&p};
    hipError_t e = hipLaunchCooperativeKernel((const void*)fwd_megakernel, dim3(grid), dim3(512), args, LDS_BYTES, stream);
    if (e != hipSuccess) fprintf(stderr, "cooperative launch failed: %s (grid %d)\n", hipGetErrorString(e), grid);
#else
    const int nph = 2 + NL * 6;
    for (int k = 0; k < nph; ++k) { p.ph_lo = k; p.ph_hi = k + 1; hipLaunchKernelGGL(fwd_megakernel, dim3(grid), dim3(512), LDS_BYTES, stream, p); }
#endif
}
```

```cpp
#include <hip/hip_runtime.h>
#include <hip/hip_cooperative_groups.h>
#include <hip/hip_bf16.h>
#include <cstdio>
#include <cstdint>
namespace cg = cooperative_groups;
namespace pg8 {
#define PG8_LAS __attribute__((address_space(3)))
typedef unsigned short bf16_t;
typedef short bf16x8 __attribute__((ext_vector_type(8)));
typedef float f32x4 __attribute__((ext_vector_type(4)));
typedef unsigned u32x4 __attribute__((ext_vector_type(4)));
constexpr int BM = 256, BK = 64, HALF = 128, HTB = HALF * BK * 2  , STAGE_BYTES = 8 * HTB, NXCD = 8, WGM = 8;

__host__ __device__ __forceinline__ int lds_byte(int r, int c) { const int st = (r >> 4) * 2 + (c >> 5), rr = r & 15, cc = c & 31, ob = rr * 64 + cc * 2; return st * 1024 + (ob ^ (((ob >> 9) & 1) << 5)); }
__host__ __device__ __forceinline__ void stage_rc(int b, int& R, int& C) { const int st = b / 1024, sb = b % 1024, swz = sb ^ (((sb >> 9) & 1) << 5); R = (st >> 1) * 16 + swz / 64; C = (st & 1) * 32 + (swz % 64) / 2; }
__host__ __device__ __forceinline__ int perm32(int rho) { const int n = rho >> 4, i = rho & 15; return 8 * (i >> 2) + 4 * n + (i & 3); }

struct Unit { int pm, pn; };
struct Gemm { const bf16_t* A; const bf16_t* Bt; int M, N, K; };

struct StaticOrder {
    int nM, nN, nwg, G, c;
    __host__ __device__ void init(int M, int N, int G_, int c_) { nM = M / BM; nN = N / BM; nwg = nM * nN; G = G_; c = c_; }
    __host__ __device__ bool next(int i, Unit& u) const {
        const long L = (long)i * G + c; if (L >= nwg) return false;
        int wgid = (int)L; { const int q = nwg / NXCD, r = nwg % NXCD, xcd = wgid % NXCD, off = wgid / NXCD; wgid = (xcd < r ? xcd * (q + 1) : r * (q + 1) + (xcd - r) * q) + off; }
        const int nig = WGM * nN, gid = wgid / nig, fm = gid * WGM, gsz = (nM - fm) < WGM ? (nM - fm) : WGM;
        u.pm = fm + ((wgid % nig) % gsz); u.pn = (wgid % nig) / gsz; return true;
    }
    __device__ __forceinline__ void a_ready(const Unit&) const {}
    __device__ __forceinline__ void done(const Unit&) const {}
};

typedef float f32x2c_t __attribute__((ext_vector_type(2))); typedef __bf16 bf16x2c_t __attribute__((ext_vector_type(2)));
__device__ __forceinline__ unsigned cvt_pk_bf16(float lo, float hi) { f32x2c_t v = {lo, hi}; bf16x2c_t b = __builtin_convertvector(v, bf16x2c_t); return __builtin_bit_cast(unsigned, b); }
typedef float f32x2 __attribute__((ext_vector_type(2)));
typedef unsigned u32x2 __attribute__((ext_vector_type(2)));
__device__ __forceinline__ float bf2f(unsigned short u) { return __uint_as_float(((unsigned)u) << 16); }
__device__ __forceinline__ float fsigmoid(float x) { return __builtin_amdgcn_rcpf(1.0f + __expf(-x)); }
__device__ __forceinline__ float gelu_tanh(float x) { const float u = 1.5957691216057308f * (x + 0.044715f * x * x * x); return x * __builtin_amdgcn_rcpf(1.0f + __expf(-u)); }
__device__ __forceinline__ u32x2 pack4(f32x4 v) { u32x2 w; w.x = cvt_pk_bf16(v[0], v[1]); w.y = cvt_pk_bf16(v[2], v[3]); return w; }
__host__ __device__ __forceinline__ int dim_of_pos(int p) { const int pi = p >> 1, wh = p & 1; return (pi >> 5) * 64 + wh * 32 + (pi & 31); }
__host__ __device__ __forceinline__ int pos_of_dim(int d) { const int ax = d >> 6, wh = (d >> 5) & 1, i = d & 31; return 2 * (ax * 32 + i) + wh; }

constexpr int NTOK = 16384, NCTX = 8192, DM = 1024;
constexpr float EPSN = 1e-6f;


template <bool PERMC>
__device__ __forceinline__ void prenorm_apply(f32x4 (&acc)[2][2][4][2], const Unit& u, int wr, int wc, int fr, int fq, const float* ssq, const float* sw, int ncols, PG8_LAS float* rs) {
    const int rowt = wr * 64 + fr, colw = u.pn * 256 + wc * 32 + (PERMC ? 8 : 4) * fq;
    const int cond = u.pm < 32 ? 0 : 1 + ((u.pm - 32) >> 3);
    const float* swp = sw + (size_t)cond * ncols + colw;
    const int t = (wr * 4 + wc) * 64 + fq * 16 + fr;
    const bool rebuild = ((const PG8_LAS int*)rs)[256] != u.pm;
    if (rebuild && t < 256) {
        const float* sp = ssq + (size_t)(u.pm * 256 + t) * 16;
        const f32x4 s0 = *(const f32x4*)sp, s1 = *(const f32x4*)(sp + 4), s2 = *(const f32x4*)(sp + 8), s3 = *(const f32x4*)(sp + 12);
        const f32x4 st = (s0 + s1) + (s2 + s3);
        rs[t] = __builtin_amdgcn_rsqf(((st[0] + st[1]) + (st[2] + st[3])) * (1.0f / 1024.0f) + EPSN);
    }
    f32x4 sv[2][2];
#pragma unroll
    for (int bj = 0; bj < 2; ++bj)
#pragma unroll
        for (int n = 0; n < 2; ++n) sv[bj][n] = *(const f32x4*)(swp + bj * 128 + (PERMC ? 4 : 16) * n);
    if (rebuild) {
        asm volatile("s_waitcnt lgkmcnt(0)" ::: "memory"); __builtin_amdgcn_s_barrier(); asm volatile("" ::: "memory");
        if (t == 0) ((PG8_LAS int*)rs)[256] = u.pm;
    }
#pragma unroll
    for (int ai = 0; ai < 2; ++ai)
#pragma unroll
        for (int m = 0; m < 4; ++m) {
            const float rstd = rs[ai * 128 + m * 16 + rowt];
#pragma unroll
            for (int bj = 0; bj < 2; ++bj)
#pragma unroll
                for (int n = 0; n < 2; ++n) acc[ai][bj][m][n] = acc[ai][bj][m][n] * rstd + sv[bj][n];
        }
}

struct EpiIn {
    static constexpr bool PERM = true, AFTER_DRAIN = false, HAS_MID = false;
    bf16_t *Q, *KB, *VB, *XR, *GXB, *G; float *outk, *outv; const float *qw, *kw, *rope; PG8_LAS float* red; int layer; const float *ssq, *sw;
    __device__ __forceinline__ void operator()(f32x4 (&acc)[2][2][4][2], const Unit& u, int wr, int wc, int fr, int fq) const {
        asm volatile("" : "+v"(fr), "+v"(fq));
        prenorm_apply<true>(acc, u, wr, wc, fr, fq, ssq, sw, 5632, red + 2048 + 64);
        const int pn = u.pn, pm = u.pm;
        const int rowt = wr * 64 + fr, colw = wc * 32 + 8 * fq;
        const bool latent = pm >= 32;
        if (pn < 5) {
#pragma unroll
            for (int ai = 0; ai < 2; ++ai)
#pragma unroll
                for (int m = 0; m < 4; ++m)
#pragma unroll
                    for (int bj = 0; bj < 2; ++bj) {
                        float s = 0.f;
#pragma unroll
                        for (int n = 0; n < 2; ++n) { const f32x4 x = acc[ai][bj][m][n]; s += (x[0] * x[0] + x[1] * x[1]) + (x[2] * x[2] + x[3] * x[3]); }
                        s += __shfl_xor(s, 16); s += __shfl_xor(s, 32);
                        if (fq == 0) red[((ai * 128 + m * 16 + rowt) * 2 + bj) * 4 + wc] = s;
                    }
            asm volatile("s_waitcnt lgkmcnt(0)" ::: "memory"); __builtin_amdgcn_s_barrier(); asm volatile("" ::: "memory");
            const float* nw = pn < 4 ? qw : kw;
            f32x4 wv[2];
#pragma unroll
            for (int n = 0; n < 2; ++n)
#pragma unroll
                for (int e = 0; e < 4; ++e) wv[n][e] = nw[dim_of_pos(colw + 4 * n + e)];
#pragma unroll
            for (int ai = 0; ai < 2; ++ai) {
                f32x4 csp[4][2];
                if (latent) {
#pragma unroll
                    for (int m = 0; m < 4; ++m)
#pragma unroll
                        for (int n = 0; n < 2; ++n) csp[m][n] = *(const f32x4*)(rope + ((size_t)((pm * 256 + ai * 128 + m * 16 + rowt - NCTX) & 2047) * 64 + ((colw + 4 * n) >> 1)) * 2);
                }
                asm volatile("" ::: "memory");
#pragma unroll
                for (int m = 0; m < 4; ++m) {
                    const int rl = ai * 128 + m * 16 + rowt, row = pm * 256 + rl;
#pragma unroll
                    for (int bj = 0; bj < 2; ++bj) {
                        const f32x4 pr = *(const PG8_LAS f32x4*)(red + (rl * 2 + bj) * 4);
                        const float rstd = __builtin_amdgcn_rsqf(((pr[0] + pr[1]) + (pr[2] + pr[3])) * (1.0f / 128.0f) + EPSN);
                        u32x2 pk[2]; float kx[2][2], ky[2][2];
#pragma unroll
                        for (int n = 0; n < 2; ++n) {
                            f32x4 v = acc[ai][bj][m][n] * rstd * wv[n];
                            const int p = colw + 4 * n;
                            if (!latent && pn == 4) { kx[n][0] = v[0]; kx[n][1] = v[2]; ky[n][0] = v[1]; ky[n][1] = v[3]; }
                            if (latent) {
                                const f32x4 cs = csp[m][n];
                                f32x4 o; o[0] = v[0] * cs[0] - v[1] * cs[1]; o[1] = v[1] * cs[0] + v[0] * cs[1]; o[2] = v[2] * cs[2] - v[3] * cs[3]; o[3] = v[3] * cs[2] + v[2] * cs[3];
                                v = o;
                            }
                            pk[n] = pack4(v);
                        }
                        if (!latent && pn == 4) {
                            float* o = outk + ((size_t)((pm * 4 + layer) * 256 + rl) * 2 + bj) * 128 + dim_of_pos(colw);
                            *(f32x4*)o = (f32x4){kx[0][0], kx[0][1], kx[1][0], kx[1][1]}; *(f32x4*)(o + 32) = (f32x4){ky[0][0], ky[0][1], ky[1][0], ky[1][1]};
                        }
                        bf16_t* dst = (pn < 4) ? Q + (size_t)row * 1024 + pn * 256 + bj * 128 + colw : KB + (size_t)row * 256 + bj * 128 + colw;
                        u32x4 w; w.x = pk[0].x; w.y = pk[0].y; w.z = pk[1].x; w.w = pk[1].y;
                        *(u32x4*)dst = w;
                    }
                }
            }
        } else {
#pragma unroll
            for (int ai = 0; ai < 2; ++ai)
#pragma unroll
                for (int m = 0; m < 4; ++m) {
                    const int rl = ai * 128 + m * 16 + rowt, row = pm * 256 + rl;
#pragma unroll
                    for (int bj = 0; bj < 2; ++bj) {
                        f32x4 v0 = acc[ai][bj][m][0], v1 = acc[ai][bj][m][1];
                        const int c = bj * 128 + colw;
                        bf16_t* dst;
                        if (pn == 5) {
                            if (!latent) { float* o = outv + ((size_t)((pm * 4 + layer) * 256 + rl)) * 256 + c; *(f32x4*)o = v0; *(f32x4*)(o + 4) = v1; }
                            dst = VB + (size_t)row * 256 + c;
                        } else if (pn < 10) {
                            dst = XR + (size_t)row * 1024 + (pn - 6) * 256 + c;
                        } else if (pn < 14) {
#pragma unroll
                            for (int e = 0; e < 4; ++e) { v0[e] = gelu_tanh(v0[e]); v1[e] = gelu_tanh(v1[e]); }
                            dst = GXB + (size_t)row * 1024 + (pn - 10) * 256 + c;
                        } else {
#pragma unroll
                            for (int e = 0; e < 4; ++e) { v0[e] = fsigmoid(v0[e]); v1[e] = fsigmoid(v1[e]); }
                            dst = G + (size_t)row * 2048 + (pn - 14) * 256 + c;
                        }
                        const u32x2 p0 = pack4(v0), p1 = pack4(v1);
                        u32x4 w; w.x = p0.x; w.y = p0.y; w.z = p1.x; w.w = p1.y;
                        *(u32x4*)dst = w;
                    }
                }
        }
    }
};

struct EpiMerge {
    static constexpr bool PERM = true, AFTER_DRAIN = false, HAS_MID = true;
    const bf16_t* G; bf16_t* O;
    __device__ __forceinline__ static f32x4 lo4(u32x4 g) { f32x4 r; r[0] = __uint_as_float(g.x << 16); r[1] = __uint_as_float(g.x & 0xffff0000u); r[2] = __uint_as_float(g.y << 16); r[3] = __uint_as_float(g.y & 0xffff0000u); return r; }
    __device__ __forceinline__ static f32x4 hi4(u32x4 g) { f32x4 r; r[0] = __uint_as_float(g.z << 16); r[1] = __uint_as_float(g.z & 0xffff0000u); r[2] = __uint_as_float(g.w << 16); r[3] = __uint_as_float(g.w & 0xffff0000u); return r; }
    __device__ __forceinline__ static f32x4 rcp4(f32x4 x) { f32x4 r; r[0] = __builtin_amdgcn_rcpf(fmaxf(x[0], 1e-20f)); r[1] = __builtin_amdgcn_rcpf(fmaxf(x[1], 1e-20f)); r[2] = __builtin_amdgcn_rcpf(fmaxf(x[2], 1e-20f)); r[3] = __builtin_amdgcn_rcpf(fmaxf(x[3], 1e-20f)); return r; }
    __device__ __forceinline__ void mid(f32x4 (&acc)[2][2][4][2], const Unit& u, int wr, int wc, int fr, int fq) const {
        asm volatile("" : "+v"(fr), "+v"(fq));
        const int rowt = wr * 64 + fr, colw = u.pn * 256 + wc * 32 + 8 * fq;
#pragma unroll
        for (int ai = 0; ai < 2; ++ai)
#pragma unroll
            for (int m = 0; m < 4; ++m) {
                const bf16_t* gr = G + (size_t)(u.pm * 256 + ai * 128 + m * 16 + rowt) * 2048 + colw;
#pragma unroll
                for (int bj = 0; bj < 2; ++bj) {
                    const u32x4 a = *(const u32x4*)(gr + bj * 128), l = *(const u32x4*)(gr + 1024 + bj * 128);
                    acc[ai][bj][m][0] *= lo4(a) * rcp4(lo4(l));
                    acc[ai][bj][m][1] *= hi4(a) * rcp4(hi4(l));
                }
            }
    }
    __device__ __forceinline__ void operator()(f32x4 (&acc)[2][2][4][2], const Unit& u, int wr, int wc, int fr, int fq) const {
        asm volatile("" : "+v"(fr), "+v"(fq));
        const int rowt = wr * 64 + fr, colw = u.pn * 256 + wc * 32 + 8 * fq;
#pragma unroll
        for (int ai = 0; ai < 2; ++ai) {
            u32x4 lpre[4][2];
#pragma unroll
            for (int m = 0; m < 4; ++m)
#pragma unroll
                for (int bj = 0; bj < 2; ++bj) lpre[m][bj] = *(const u32x4*)(G + (size_t)(u.pm * 256 + ai * 128 + m * 16 + rowt) * 2048 + 1024 + colw + bj * 128);
            asm volatile("" ::: "memory");
#pragma unroll
            for (int m = 0; m < 4; ++m) {
                const size_t row = (size_t)(u.pm * 256 + ai * 128 + m * 16 + rowt);
#pragma unroll
                for (int bj = 0; bj < 2; ++bj) {
                    const u32x4 l = lpre[m][bj];
                    const u32x2 p0 = pack4(acc[ai][bj][m][0] * lo4(l)), p1 = pack4(acc[ai][bj][m][1] * hi4(l));
                    u32x4 w; w.x = p0.x; w.y = p0.y; w.z = p1.x; w.w = p1.y;
                    *(u32x4*)(O + row * 1024 + colw + bj * 128) = w;
                }
            }
        }
    }
};

struct EpiRes {
    static constexpr bool PERM = true, AFTER_DRAIN = false, HAS_MID = false;
    const float* xin0; const float* xin1; const bf16_t* xs16; bf16_t* x16o; float* yout; const float* gate; bf16_t* Hn; const float* wmod; float* ssq;
    __device__ __forceinline__ void operator()(f32x4 (&acc)[2][2][4][2], const Unit& u, int wr, int wc, int fr, int fq) const {
        asm volatile("" : "+v"(fr), "+v"(fq));
        const int rowt = wr * 64 + fr, colw = u.pn * 256 + wc * 32 + 8 * fq;
        const int cond = u.pm < 32 ? 0 : 1 + ((u.pm - 32) >> 3);
        const float* xin = u.pm < 32 ? xin0 : xin1;
        f32x4 gv[2][2], wv[2][2];
#pragma unroll
        for (int bj = 0; bj < 2; ++bj)
#pragma unroll
            for (int n = 0; n < 2; ++n) { gv[bj][n] = *(const f32x4*)(gate + cond * 6144 + colw + bj * 128 + 4 * n);
                wv[bj][n] = Hn ? *(const f32x4*)(wmod + cond * 1024 + colw + bj * 128 + 4 * n) : (f32x4){0.f, 0.f, 0.f, 0.f}; }
#pragma unroll
        for (int ai = 0; ai < 2; ++ai) {
            u32x4 xpre[4][2];
            if (!xin0) {
#pragma unroll
                for (int m = 0; m < 4; ++m)
#pragma unroll
                    for (int bj = 0; bj < 2; ++bj) xpre[m][bj] = *(const u32x4*)(xs16 + (size_t)(u.pm * 256 + ai * 128 + m * 16 + rowt) * 1024 + colw + bj * 128);
            }
            asm volatile("" ::: "memory");
#pragma unroll
            for (int m = 0; m < 4; ++m) {
                const int row = u.pm * 256 + ai * 128 + m * 16 + rowt;
                const size_t off = (size_t)row * 1024 + colw;
                float sq = 0.f;
#pragma unroll
                for (int bj = 0; bj < 2; ++bj) {
                    f32x4 x0, x1;
                    if (xin0) { x0 = *(const f32x4*)(xin + off + bj * 128); x1 = *(const f32x4*)(xin + off + bj * 128 + 4); }
                    else { const u32x4 xb = xpre[m][bj];
                        x0[0] = __uint_as_float(xb.x << 16); x0[1] = __uint_as_float(xb.x & 0xffff0000u); x0[2] = __uint_as_float(xb.y << 16); x0[3] = __uint_as_float(xb.y & 0xffff0000u);
                        x1[0] = __uint_as_float(xb.z << 16); x1[1] = __uint_as_float(xb.z & 0xffff0000u); x1[2] = __uint_as_float(xb.w << 16); x1[3] = __uint_as_float(xb.w & 0xffff0000u); }
                    const f32x4 g0 = gv[bj][0], g1 = gv[bj][1];
                    const f32x4 xn0 = x0 + g0 * acc[ai][bj][m][0], xn1 = x1 + g1 * acc[ai][bj][m][1];
                    if (yout) { *(f32x4*)(yout + off + bj * 128) = xn0; *(f32x4*)(yout + off + bj * 128 + 4) = xn1; }
                    else { const u32x2 p0 = pack4(xn0), p1 = pack4(xn1); u32x4 w; w.x = p0.x; w.y = p0.y; w.z = p1.x; w.w = p1.y; *(u32x4*)(x16o + off + bj * 128) = w; }
                    if (Hn) { const f32x4 w0 = wv[bj][0], w1 = wv[bj][1];
                        const u32x2 p0 = pack4(xn0 * w0), p1 = pack4(xn1 * w1); u32x4 w; w.x = p0.x; w.y = p0.y; w.z = p1.x; w.w = p1.y; *(u32x4*)(Hn + off + bj * 128) = w;
                        sq += ((xn0[0] * xn0[0] + xn0[1] * xn0[1]) + (xn0[2] * xn0[2] + xn0[3] * xn0[3])) + ((xn1[0] * xn1[0] + xn1[1] * xn1[1]) + (xn1[2] * xn1[2] + xn1[3] * xn1[3])); }
                }
                if (Hn) { sq += __shfl_xor(sq, 16); sq += __shfl_xor(sq, 32); if (fq == 0) ssq[(size_t)row * 16 + u.pn * 4 + wc] = sq; }
            }
        }
    }
};

struct EpiUp {
    static constexpr bool PERM = true, AFTER_DRAIN = false, HAS_MID = false;
    bf16_t* U; const float *ssq, *sw; PG8_LAS float* rs;
    __device__ __forceinline__ void operator()(f32x4 (&acc)[2][2][4][2], const Unit& u, int wr, int wc, int fr, int fq) const {
        asm volatile("" : "+v"(fr), "+v"(fq));
        prenorm_apply<true>(acc, u, wr, wc, fr, fq, ssq, sw, 4096, rs);
        const int rowt = wr * 64 + fr, colw = u.pn * 256 + wc * 32 + 8 * fq;
#pragma unroll
        for (int ai = 0; ai < 2; ++ai)
#pragma unroll
            for (int m = 0; m < 4; ++m) {
                bf16_t* rp = U + (size_t)(u.pm * 256 + ai * 128 + m * 16 + rowt) * 4096 + colw;
#pragma unroll
                for (int bj = 0; bj < 2; ++bj) {
                    f32x4 v0 = acc[ai][bj][m][0], v1 = acc[ai][bj][m][1];
#pragma unroll
                    for (int e = 0; e < 4; ++e) { const float r0 = fmaxf(v0[e], 0.f), r1 = fmaxf(v1[e], 0.f); v0[e] = r0 * r0; v1[e] = r1 * r1; }
                    const u32x2 p0 = pack4(v0), p1 = pack4(v1);
                    u32x4 w; w.x = p0.x; w.y = p0.y; w.z = p1.x; w.w = p1.y;
                    *(u32x4*)(rp + bj * 128) = w;
                }
            }
    }
};
template <class Epi, class Sched, bool ALIGN_EPI = false, bool SP2 = false>
__device__ __forceinline__ void gemm_phase(PG8_LAS unsigned char* lds, const Gemm g, const Sched& S, const Epi& E) {
    int tid_l = threadIdx.x; asm volatile("" : "+v"(tid_l));
    const int tid = tid_l, wid = __builtin_amdgcn_readfirstlane(tid >> 6), lane = tid & 63, wr = wid >> 2, wc = wid & 3, fr = lane & 15, fq = lane >> 4;
    const int K = g.K, nt = K / BK;
    unsigned voffA[2], voffB[2];
#pragma unroll
    for (int i = 0; i < 2; ++i) { int R, C; stage_rc(tid * 16 + i * 8192, R, C); const int Rb = Epi::PERM ? ((R & ~31) + perm32(R & 31)) : R;
        voffA[i] = (unsigned)(R * K + C) * 2u; voffB[i] = (unsigned)(Rb * K + C) * 2u; }
    const size_t kstep = (size_t)(BK * 2);
    const size_t hstep = (size_t)HALF * K * 2;
    const size_t tstep = 2 * hstep;
    const unsigned ldsw = (unsigned)wid * 1024u;
    const int aoff = lds_byte(wr * 64 + fr, fq * 8), boff = lds_byte(wc * 32 + fr, fq * 8);
#define PG8_SA(b, h) (((b) * 2 + (h)) * HTB)
#define PG8_SB(b, h) ((4 + (b) * 2 + (h)) * HTB)
#define PG8_STAGE(bufoff, gbase, voff) do { _Pragma("unroll") for (int _i = 0; _i < 2; ++_i) \
        __builtin_amdgcn_global_load_lds((const unsigned*)((const char*)(gbase) + (voff)[_i]), (PG8_LAS unsigned*)(lds + (bufoff) + ldsw + _i * 8192), 16, 0, 0); } while (0)
#define PG8_LDA(dst, b, h) do { _Pragma("unroll") for (int m = 0; m < 4; ++m) _Pragma("unroll") for (int k = 0; k < 2; ++k) dst[m][k] = *(const PG8_LAS bf16x8*)(lds + PG8_SA(b, h) + aoff + m * 2048 + k * 1024); } while (0)
#define PG8_LDB(dst, b, h) do { _Pragma("unroll") for (int n = 0; n < 2; ++n) _Pragma("unroll") for (int k = 0; k < 2; ++k) dst[n][k] = *(const PG8_LAS bf16x8*)(lds + PG8_SB(b, h) + boff + n * 2048 + k * 1024); } while (0)
#define PG8_MMA(ai, bj, At, Bt) do { __builtin_amdgcn_s_setprio(1); _Pragma("unroll") for (int m = 0; m < 4; ++m) _Pragma("unroll") for (int n = 0; n < 2; ++n) _Pragma("unroll") for (int k = 0; k < 2; ++k) \
        acc[ai][bj][m][n] = __builtin_amdgcn_mfma_f32_16x16x32_bf16(Bt[n][k], At[m][k], acc[ai][bj][m][n], 0, 0, 0); __builtin_amdgcn_s_setprio(0); } while (0)
#define PG8_WAIT_V(n) asm volatile("s_waitcnt vmcnt(" #n ")" ::: "memory")
#define PG8_WAIT_L(n) asm volatile("s_waitcnt lgkmcnt(" #n ")" ::: "memory")
#define PG8_BAR __builtin_amdgcn_s_barrier()
#define PG8_SCHED __builtin_amdgcn_sched_barrier(0)
    Unit cur, nxt; int ui = 0;
    if (!S.next(0, cur)) return;
    f32x4 acc[2][2][4][2];
#pragma unroll
    for (int a = 0; a < 2; ++a)
#pragma unroll
        for (int b = 0; b < 2; ++b)
#pragma unroll
            for (int m = 0; m < 4; ++m)
#pragma unroll
                for (int n = 0; n < 2; ++n) acc[a][b][m][n] = (f32x4){0.f, 0.f, 0.f, 0.f};
    bf16x8 At[4][2], B0[2][2], B1[2][2];
    const char* cA = (const char*)g.A + (size_t)cur.pm * tstep; const char* cB = (const char*)g.Bt + (size_t)cur.pn * tstep;
    S.a_ready(cur);
    if constexpr (SP2) {
        PG8_STAGE(PG8_SB(0, 0), cB, voffB); PG8_STAGE(PG8_SB(0, 1), cB + hstep, voffB); PG8_STAGE(PG8_SA(0, 0), cA, voffA); PG8_STAGE(PG8_SA(0, 1), cA + hstep, voffA);
        if (wr == 1) PG8_BAR;
        PG8_WAIT_V(2); PG8_BAR;
        PG8_STAGE(PG8_SB(1, 0), cB + kstep, voffB); PG8_STAGE(PG8_SA(1, 0), cA + kstep, voffA); PG8_STAGE(PG8_SB(1, 1), cB + hstep + kstep, voffB);
        PG8_WAIT_V(6); PG8_BAR;
    } else {
        PG8_STAGE(PG8_SB(0, 0), cB, voffB); PG8_STAGE(PG8_SA(0, 0), cA, voffA); PG8_STAGE(PG8_SB(0, 1), cB + hstep, voffB); PG8_STAGE(PG8_SA(0, 1), cA + hstep, voffA);
        if (wr == 1) PG8_BAR;
        PG8_WAIT_V(4); PG8_BAR;
        PG8_STAGE(PG8_SB(1, 0), cB + kstep, voffB); PG8_STAGE(PG8_SA(1, 0), cA + kstep, voffA); PG8_STAGE(PG8_SB(1, 1), cB + hstep + kstep, voffB);
        PG8_WAIT_V(6); PG8_BAR;
    }
    for (;;) {
        const bool has_next = S.next(ui + 1, nxt);
        const char* nA = has_next ? (const char*)g.A + (size_t)nxt.pm * tstep : cA; const char* nB = has_next ? (const char*)g.Bt + (size_t)nxt.pn * tstep : cB;
        for (int t = 0; t < nt; t += 2) {
            if constexpr (Epi::HAS_MID) { if (t == (nt >> 1)) E.mid(acc, cur, wr, wc, fr, fq); }
            const bool last = (t == nt - 2);
            const char* a1 = cA + (size_t)(t + 1) * kstep;
            const char* a2 = last ? nA : cA + (size_t)(t + 2) * kstep; const char* b2 = last ? nB : cB + (size_t)(t + 2) * kstep;
            const char* a3 = a2 + kstep; const char* b3 = b2 + kstep;
            if (last && has_next) S.a_ready(nxt);
            if constexpr (SP2) {
            PG8_LDB(B0, 0, 0); PG8_LDB(B1, 0, 1); PG8_SCHED; PG8_LDA(At, 0, 0); PG8_STAGE(PG8_SA(1, 1), a1 + hstep, voffA);
            PG8_WAIT_V(8); PG8_WAIT_L(0); PG8_BAR; PG8_MMA(0, 0, At, B0); PG8_MMA(0, 1, At, B1); PG8_BAR; PG8_SCHED;
            PG8_LDA(At, 0, 1); PG8_STAGE(PG8_SB(0, 0), b2, voffB); PG8_STAGE(PG8_SB(0, 1), b2 + hstep, voffB); PG8_STAGE(PG8_SA(0, 0), a2, voffA);
            PG8_WAIT_V(8); PG8_WAIT_L(0); PG8_BAR; PG8_MMA(1, 0, At, B0); PG8_MMA(1, 1, At, B1); PG8_BAR; PG8_SCHED;
            PG8_LDB(B0, 1, 0); PG8_LDB(B1, 1, 1); PG8_SCHED; PG8_LDA(At, 1, 0); PG8_STAGE(PG8_SA(0, 1), a2 + hstep, voffA);
            PG8_WAIT_V(8); PG8_WAIT_L(0); PG8_BAR; PG8_MMA(0, 0, At, B0); PG8_MMA(0, 1, At, B1); PG8_BAR; PG8_SCHED;
            PG8_LDA(At, 1, 1); PG8_STAGE(PG8_SB(1, 0), b3, voffB); PG8_STAGE(PG8_SB(1, 1), b3 + hstep, voffB); PG8_STAGE(PG8_SA(1, 0), a3, voffA);
            PG8_WAIT_V(8); PG8_WAIT_L(0); PG8_BAR; PG8_MMA(1, 0, At, B0); PG8_MMA(1, 1, At, B1); PG8_BAR; PG8_SCHED;
            } else {
            PG8_LDB(B0, 0, 0); PG8_SCHED; PG8_LDA(At, 0, 0); PG8_STAGE(PG8_SA(1, 1), a1 + hstep, voffA);
            PG8_WAIT_L(8); PG8_BAR; PG8_WAIT_L(0); PG8_MMA(0, 0, At, B0); PG8_BAR; PG8_SCHED;
            PG8_LDB(B1, 0, 1); PG8_STAGE(PG8_SB(0, 0), b2, voffB);
            PG8_BAR; PG8_WAIT_L(0); PG8_MMA(0, 1, At, B1); PG8_BAR;
            PG8_LDA(At, 0, 1); PG8_STAGE(PG8_SA(0, 0), a2, voffA);
            PG8_BAR; PG8_WAIT_L(0); PG8_MMA(1, 0, At, B0); PG8_BAR; PG8_SCHED;
            PG8_STAGE(PG8_SB(0, 1), b2 + hstep, voffB);
            PG8_WAIT_V(6); PG8_BAR; PG8_MMA(1, 1, At, B1); PG8_BAR;
            PG8_LDB(B0, 1, 0); PG8_SCHED; PG8_LDA(At, 1, 0); PG8_STAGE(PG8_SA(0, 1), a2 + hstep, voffA);
            PG8_WAIT_L(8); PG8_BAR; PG8_WAIT_L(0); PG8_MMA(0, 0, At, B0); PG8_BAR; PG8_SCHED;
            PG8_LDB(B1, 1, 1); PG8_STAGE(PG8_SB(1, 0), b3, voffB);
            PG8_BAR; PG8_WAIT_L(0); PG8_MMA(0, 1, At, B1); PG8_BAR;
            PG8_LDA(At, 1, 1); PG8_STAGE(PG8_SA(1, 0), a3, voffA);
            PG8_BAR; PG8_WAIT_L(0); PG8_MMA(1, 0, At, B0); PG8_BAR; PG8_SCHED;
            PG8_STAGE(PG8_SB(1, 1), b3 + hstep, voffB);
            PG8_WAIT_V(6); PG8_BAR; PG8_MMA(1, 1, At, B1); PG8_BAR;
            }
        }
        if constexpr (ALIGN_EPI) { if (wr == 0) PG8_BAR; }
        if constexpr (!Epi::AFTER_DRAIN) { E(acc, cur, wr, wc, fr, fq); S.done(cur); }
        if (!has_next) break;
#pragma unroll
        for (int a = 0; a < 2; ++a)
#pragma unroll
            for (int b = 0; b < 2; ++b)
#pragma unroll
                for (int m = 0; m < 4; ++m)
#pragma unroll
                    for (int n = 0; n < 2; ++n) acc[a][b][m][n] = (f32x4){0.f, 0.f, 0.f, 0.f};
        cur = nxt; cA = nA; cB = nB; ++ui;
        if constexpr (ALIGN_EPI) { if (wr == 1) PG8_BAR; }
    }
    PG8_WAIT_V(0);
    if constexpr (!ALIGN_EPI) { if (wr == 0) PG8_BAR; }
    PG8_BAR;
    if constexpr (Epi::AFTER_DRAIN) { E.fused(acc, cur, wr, wc, fr, fq, lds, wid, lane); S.done(cur); }
#undef PG8_SA
#undef PG8_SB
#undef PG8_STAGE
#undef PG8_LDA
#undef PG8_LDB
#undef PG8_MMA
#undef PG8_WAIT_V
#undef PG8_WAIT_L
#undef PG8_BAR
#undef PG8_SCHED
}
}

namespace att {
using bf16 = unsigned short;
using bf16x8 = __attribute__((ext_vector_type(8))) short;
using s16x4  = __attribute__((ext_vector_type(4))) short;
using f32x16 = __attribute__((ext_vector_type(16))) float;
using u32x4  = __attribute__((ext_vector_type(4))) unsigned;
constexpr int D = 128, NW = 8, QBLK = 32, KVBLK = 64;
constexpr float SCALE = 0.088388347648318440f;
constexpr float THR = 8.f;
constexpr int LDQ = 1024, LDK = 256, LDO = 2048;
constexpr size_t SHM_V = KVBLK * D * 2, SHM_K = KVBLK * D * 2, SHM_ATTN = 2 * SHM_V + 2 * SHM_K + NW * 64 * 4;
#define KSWZ(row, colB) ((row) * 256 + ((colB) ^ (((row) & 7) << 4)))
#define SBAR() __builtin_amdgcn_sched_barrier(0)
__device__ __forceinline__ int crow(int r, int hi) { return (r & 3) + 8 * (r >> 2) + 4 * hi; }
typedef float f32x2a_t __attribute__((ext_vector_type(2))); typedef __bf16 bf16x2a_t __attribute__((ext_vector_type(2)));
__device__ __forceinline__ unsigned cvtpk(float lo, float hi) { f32x2a_t v = {lo, hi}; bf16x2a_t b = __builtin_convertvector(v, bf16x2a_t); return __builtin_bit_cast(unsigned, b); }
__device__ __forceinline__ void partialSM(f32x16& p0, f32x16& p1, float& m_reg, float& mn, float& alpha) {
  constexpr float C = SCALE * 1.4426950408889634f;
  float pmax = p0[0]; for (int r = 1; r < 16; ++r) pmax = fmaxf(pmax, p0[r]); for (int r = 0; r < 16; ++r) pmax = fmaxf(pmax, p1[r]);
  { auto rr = __builtin_amdgcn_permlane32_swap(__float_as_uint(pmax), __float_as_uint(pmax), false, false);
    pmax = fmaxf(__uint_as_float(rr[0]), __uint_as_float(rr[1])); }
  if (__builtin_expect(__all(pmax - m_reg <= THR / SCALE), 1)) { mn = m_reg; alpha = 1.f; }
  else { mn = fmaxf(m_reg, pmax); alpha = __builtin_amdgcn_exp2f((m_reg - mn) * C); m_reg = mn; }
  float mnC = -mn * C;
  for (int r = 0; r < 16; ++r) p0[r] = fmaf(p0[r], C, mnC); for (int r = 0; r < 16; ++r) p1[r] = fmaf(p1[r], C, mnC);
  for (int r = 0; r < 16; ++r) p0[r] = __builtin_amdgcn_exp2f(p0[r]);
}
__device__ __forceinline__ void finishSM(f32x16& p0, f32x16& p1, float alpha, float& l_reg, bf16x8& pa0, bf16x8& pa1, bf16x8& pa2, bf16x8& pa3) {
  for (int r = 0; r < 16; ++r) p1[r] = __builtin_amdgcn_exp2f(p1[r]);
  float ps = 0; for (int r = 0; r < 16; ++r) ps += p0[r]; for (int r = 0; r < 16; ++r) ps += p1[r];
  { auto rr = __builtin_amdgcn_permlane32_swap(__float_as_uint(ps), __float_as_uint(ps), false, false);
    ps = __uint_as_float(rr[0]) + __uint_as_float(rr[1]); }
  l_reg = l_reg * alpha + ps;
#define PK4(P, BASE, OUT) do { unsigned a0 = cvtpk(P[BASE + 0], P[BASE + 1]), a1 = cvtpk(P[BASE + 2], P[BASE + 3]);   \
    unsigned b0 = cvtpk(P[BASE + 4], P[BASE + 5]), b1 = cvtpk(P[BASE + 6], P[BASE + 7]);                              \
    auto r0 = __builtin_amdgcn_permlane32_swap(a0, b0, false, false); auto r1 = __builtin_amdgcn_permlane32_swap(a1, b1, false, false); \
    u32x4 w = {r0[0], r1[0], r0[1], r1[1]}; OUT = *reinterpret_cast<bf16x8*>(&w); } while (0)
  PK4(p0, 0, pa0); PK4(p0, 8, pa1); PK4(p1, 0, pa2); PK4(p1, 8, pa3);
#undef PK4
}
__device__ __forceinline__ void qkt(f32x16& p0, f32x16& p1, const bf16* Ks, const bf16x8* qr, int r32, int hi) {
  p0 = f32x16{}; p1 = f32x16{};
  for (int d0 = 0; d0 < 8; ++d0) { int cb = (d0 * 16 + hi * 8) * 2;
    bf16x8 b0 = *reinterpret_cast<const bf16x8*>((const char*)Ks + KSWZ(r32, cb));
    bf16x8 b1 = *reinterpret_cast<const bf16x8*>((const char*)Ks + KSWZ(32 + r32, cb));
    p0 = __builtin_amdgcn_mfma_f32_32x32x16_bf16(b0, qr[d0], p0, 0, 0, 0);
    p1 = __builtin_amdgcn_mfma_f32_32x32x16_bf16(b1, qr[d0], p1, 0, 0, 0); }
}
__device__ __forceinline__ void bandmask(f32x16& p0, f32x16& p1, int dk0, int hi) {
#pragma unroll
  for (int r = 0; r < 16; ++r) { const int dk = dk0 + crow(r, hi);
    if (dk < -128 || dk > 128) p0[r] = -1e30f;
    if (dk + 32 < -128 || dk + 32 > 128) p1[r] = -1e30f; }
}
__device__ __forceinline__ int v_st(int k, int c) { const int kk = (k & ~0xC) | ((k & 4) << 1) | ((k & 8) >> 1); return ((kk >> 3) * 4 + (c >> 5)) * 512 + ((kk & 7) * 32 + (c & 31)) * 2; }
__device__ __forceinline__ int v_rd_base(int lane) { return ((lane & 3) << 3) | (((lane >> 2) & 3) << 6) | (((lane >> 4) & 1) << 5) | (((lane >> 5) & 1) << 8); }
constexpr int v_rd_off(int d0, int ks, int half) { return d0 * 512 + ks * 4096 + half * 2048; }
template <int OFF> __device__ __forceinline__ s16x4 tr_read(int vb) {
  s16x4 r; asm volatile("ds_read_b64_tr_b16 %0, %1 offset:%2" : "=&v"(r) : "v"(vb), "i"(OFF) : "memory"); return r;
}
template <int D0> __device__ __forceinline__ void pv_one(f32x16& od, int vb, bf16x8 pa0, bf16x8 pa1, bf16x8 pa2, bf16x8 pa3) {
  const s16x4 l0 = tr_read<v_rd_off(D0, 0, 0)>(vb), h0 = tr_read<v_rd_off(D0, 0, 1)>(vb), l1 = tr_read<v_rd_off(D0, 1, 0)>(vb), h1 = tr_read<v_rd_off(D0, 1, 1)>(vb);
  const s16x4 l2 = tr_read<v_rd_off(D0, 2, 0)>(vb), h2 = tr_read<v_rd_off(D0, 2, 1)>(vb), l3 = tr_read<v_rd_off(D0, 3, 0)>(vb), h3 = tr_read<v_rd_off(D0, 3, 1)>(vb);
  asm volatile("s_waitcnt lgkmcnt(0)" ::: "memory"); SBAR();
#define PK(L, H) (bf16x8){L[0], L[1], L[2], L[3], H[0], H[1], H[2], H[3]}
  od = __builtin_amdgcn_mfma_f32_32x32x16_bf16(pa0, PK(l0, h0), od, 0, 0, 0);
  od = __builtin_amdgcn_mfma_f32_32x32x16_bf16(pa1, PK(l1, h1), od, 0, 0, 0);
  od = __builtin_amdgcn_mfma_f32_32x32x16_bf16(pa2, PK(l2, h2), od, 0, 0, 0);
  od = __builtin_amdgcn_mfma_f32_32x32x16_bf16(pa3, PK(l3, h3), od, 0, 0, 0);
#undef PK
}
__device__ __forceinline__ void pv_d0(f32x16* o, int vb, bf16x8 pa0, bf16x8 pa1, bf16x8 pa2, bf16x8 pa3) {
  pv_one<0>(o[0], vb, pa0, pa1, pa2, pa3); pv_one<1>(o[1], vb, pa0, pa1, pa2, pa3); pv_one<2>(o[2], vb, pa0, pa1, pa2, pa3); pv_one<3>(o[3], vb, pa0, pa1, pa2, pa3);
}

__device__ __forceinline__ void attn_unit(const bf16* __restrict__ Qb, const bf16* __restrict__ K0, const bf16* __restrict__ V0, int n0,
                                          const bf16* __restrict__ K1, const bf16* __restrict__ V1, int n1, int dq0, float sinkl2,
                                          bf16* __restrict__ Ob, char* lds) {
  int tid_l = threadIdx.x; asm volatile("" : "+v"(tid_l));
  const int tid = tid_l, wid = tid >> 6, lane = tid & 63, r32 = lane & 31, hi = lane >> 5;
  bf16* V_lds = (bf16*)lds; bf16* K_lds = (bf16*)(lds + 2 * SHM_V);
  float* ws = (float*)(lds + 2 * SHM_V + 2 * SHM_K) + wid * 64; float* li_l = ws; float* al_l = ws + 32;
  float m_reg = -1e30f, l_reg = 0; f32x16 o[4] = {}; bf16x8 qr[8];
  const bf16* Qw = Qb + (long)(wid * QBLK + r32) * LDQ + hi * 8;
#pragma unroll
  for (int d0 = 0; d0 < 8; ++d0) qr[d0] = *reinterpret_cast<const bf16x8*>(Qw + d0 * 16);
  const int sr = tid >> 4, sc = (tid & 15) * 8, vst0 = v_st(sr, sc), vst1 = v_st(32 + sr, sc);
  const int vb0 = (int)(uintptr_t)V_lds + v_rd_base(lane);
  const int dql = dq0 - (wid * QBLK + r32);
  struct { bf16x8 vs0, vs1, ks0, ks1; } sr_[2];
#define SLOAD(i, j) do { const int j_ = (j); const bf16* kt_ = j_ < n0 ? K0 + (long)j_ * (KVBLK * LDK) : K1 + (long)(j_ - n0) * (KVBLK * LDK); \
    const bf16* vt_ = j_ < n0 ? V0 + (long)j_ * (KVBLK * LDK) : V1 + (long)(j_ - n0) * (KVBLK * LDK); \
    sr_[i].vs0 = *reinterpret_cast<const bf16x8*>(&vt_[(long)sr * LDK + sc]); sr_[i].vs1 = *reinterpret_cast<const bf16x8*>(&vt_[(long)(32 + sr) * LDK + sc]); \
    sr_[i].ks0 = *reinterpret_cast<const bf16x8*>(&kt_[(long)sr * LDK + sc]); sr_[i].ks1 = *reinterpret_cast<const bf16x8*>(&kt_[(long)(32 + sr) * LDK + sc]); } while (0)
#define SWRITE(b, i) do { *(bf16x8*)((char*)V_lds + (b) * SHM_V + vst0) = sr_[i].vs0;          \
    *(bf16x8*)((char*)V_lds + (b) * SHM_V + vst1) = sr_[i].vs1; int kc = sc * 2;               \
    *(bf16x8*)((char*)K_lds + (b) * SHM_K + KSWZ(sr, kc)) = sr_[i].ks0;                       \
    *(bf16x8*)((char*)K_lds + (b) * SHM_K + KSWZ(32 + sr, kc)) = sr_[i].ks1; } while (0)
#define SWAIT() asm volatile("s_waitcnt vmcnt(4)" ::: "memory")
#define RESC(a) do { if (__any((a) < 1.f)) { if (hi == 0) al_l[r32] = (a); asm volatile("s_waitcnt lgkmcnt(0)" ::: "memory"); \
    for (int d = 0; d < 4; ++d) for (int r = 0; r < 16; ++r) o[d][r] *= al_l[crow(r, hi)]; } } while (0)
#define MASK(P0, P1, j) do { if ((j) >= n0) bandmask(P0, P1, dql + 64 * ((j) - n0), hi); } while (0)
  f32x16 pA0, pA1, pB0, pB1; float mnA, mnB, alA, alB; bf16x8 pa0, pa1, pa2, pa3; const int NT = n0 + n1;
  constexpr int SE = 0, SO = 1;
  SLOAD(SE, 0); SLOAD(SO, 1);
  asm volatile("s_waitcnt vmcnt(4)" ::: "memory"); SWRITE(0, SE); __syncthreads();
  qkt(pA0, pA1, K_lds, qr, r32, hi); partialSM(pA0, pA1, m_reg, mnA, alA);
  if (2 < NT) SLOAD(SE, 2);
  SWAIT(); SWRITE(1, SO); __syncthreads();
  for (int j = 1; j + 1 < NT; j += 2) {
    SBAR(); qkt(pB0, pB1, (bf16*)((char*)K_lds + SHM_K), qr, r32, hi); MASK(pB0, pB1, j);
    finishSM(pA0, pA1, alA, l_reg, pa0, pa1, pa2, pa3); SBAR();
    SLOAD(SO, j + 2); SBAR();
    pv_d0(o, vb0, pa0, pa1, pa2, pa3); partialSM(pB0, pB1, m_reg, mnB, alB);
    __syncthreads(); SWAIT(); SWRITE(0, SE);
    RESC(alB); __syncthreads();
    SBAR(); qkt(pA0, pA1, K_lds, qr, r32, hi); MASK(pA0, pA1, j + 1);
    finishSM(pB0, pB1, alB, l_reg, pa0, pa1, pa2, pa3); SBAR();
    if (j + 3 < NT) SLOAD(SE, j + 3); SBAR();
    pv_d0(o, vb0 + (int)SHM_V, pa0, pa1, pa2, pa3); partialSM(pA0, pA1, m_reg, mnA, alA);
    __syncthreads(); SWAIT(); SWRITE(1, SO);
    RESC(alA); __syncthreads();
  }
  SBAR(); qkt(pB0, pB1, (bf16*)((char*)K_lds + SHM_K), qr, r32, hi); MASK(pB0, pB1, NT - 1);
  finishSM(pA0, pA1, alA, l_reg, pa0, pa1, pa2, pa3); SBAR();
  pv_d0(o, vb0, pa0, pa1, pa2, pa3); partialSM(pB0, pB1, m_reg, mnB, alB);
  __syncthreads(); RESC(alB);
  finishSM(pB0, pB1, alB, l_reg, pa0, pa1, pa2, pa3); SBAR();
  pv_d0(o, vb0 + (int)SHM_V, pa0, pa1, pa2, pa3);
  l_reg += __builtin_amdgcn_exp2f(sinkl2 - m_reg * (SCALE * 1.4426950408889634f));
  if (hi == 0) li_l[r32] = l_reg; asm volatile("s_waitcnt lgkmcnt(0)" ::: "memory");
  float rli[16];
#pragma unroll
  for (int r = 0; r < 16; ++r) rli[r] = __builtin_amdgcn_rcpf(li_l[crow(r, hi)]);
  asm volatile("" ::: "memory");
  { char* stg = lds + 69632 + wid * 8192;
#pragma unroll
    for (int r = 0; r < 16; ++r) { const int orow = crow(r, hi);
#pragma unroll
      for (int d0 = 0; d0 < 4; ++d0) { const float v = o[d0][r] * rli[r]; *(bf16*)(stg + orow * 256 + (d0 * 32 + r32) * 2) = (bf16)cvtpk(v, v); } }
    asm volatile("s_waitcnt lgkmcnt(0)" ::: "memory");
    bf16* Ow = Ob + (long)(wid * QBLK) * LDO;
#pragma unroll
    for (int i = 0; i < 8; ++i) { const int row = i * 4 + (lane >> 4), ch = lane & 15; const u32x4 v = *(const u32x4*)(stg + row * 256 + ch * 16); *(u32x4*)(Ow + (long)row * LDO + ch * 8) = v; } }
  __syncthreads();
#undef SLOAD
#undef SWRITE
#undef SWAIT
#undef RESC
#undef MASK
}
#undef KSWZ
#undef SBAR
}

#define LAS __attribute__((address_space(3)))
typedef unsigned short bf16_t;
typedef unsigned v4u __attribute__((ext_vector_type(4)));
typedef float f32x4 __attribute__((ext_vector_type(4)));
typedef float f32x16 __attribute__((ext_vector_type(16)));
typedef short bf16x8 __attribute__((ext_vector_type(8)));
using pg8::bf2f; using pg8::dim_of_pos; using pg8::pos_of_dim;

constexpr int NL = 4, NINW = 5632, DFF = 4096, NMOD6 = 6144;
constexpr int NTOK = 16384, NCTX = 8192;
constexpr size_t MiB = 1u << 20;
constexpr size_t WS_CTL = 0, WS_MOD = 1 * MiB, WS_ROPE = 2 * MiB, WS_WIN = 3 * MiB, WS_WCAT = 47 * MiB, WS_WOUT = 63 * MiB, WS_W1 = 71 * MiB, WS_W2 = 103 * MiB,
                 WS_CK = 135 * MiB, WS_CV = 139 * MiB, WS_H = 143 * MiB, WS_Q = 175 * MiB, WS_KB = 207 * MiB, WS_VB = 215 * MiB, WS_XR = 223 * MiB, WS_G = 255 * MiB,
                 WS_ACAT = 319 * MiB, WS_PF = 383 * MiB, WS_PB = 399 * MiB, WS_SSQ = 415 * MiB, WS_SWIN = 416 * MiB, WS_SWUP = 416 * MiB + 512 * 1024, WS_WMOD = 417 * MiB, WS_X16 = 418 * MiB, WS_WFR = 450 * MiB, WS_END = 454 * MiB, WS_TOT = 512 * 1024, WS_U = WS_Q, WS_MERGED = WS_Q;
constexpr size_t OUT_K = 16777216, OUT_V = 25165824, OUT_S = 33554432;
constexpr int RING_BYTES = 131072, RED_OFF = 131072, MISC_OFF = RED_OFF + 8192, LDS_BYTES = 147456;
constexpr int CW_DONE = 1024;
constexpr int CW_QUEUE = 64;

#define XB_TMO      128
#define XB_XCNT(j)  (256  + 64 * (j))
#define XB_XSUB(j)  (1280 + 64 * (j))
#define XB_XGEN(j)  (2304 + 64 * (j))
#define XB_TOP      3328
#define XB_TOPGEN   3392
#define XCD_BAR_WORDS 3456
#define XB_SPIN_CAP (1u << 18)

__device__ __forceinline__ unsigned xb_ld(unsigned* p)              { return __hip_atomic_load(p, __ATOMIC_RELAXED, __HIP_MEMORY_SCOPE_AGENT); }
__device__ __forceinline__ unsigned xb_add(unsigned* p, unsigned v) { return __hip_atomic_fetch_add(p, v, __ATOMIC_RELAXED, __HIP_MEMORY_SCOPE_AGENT); }
__device__ __forceinline__ unsigned xb_xcc_id() { return (unsigned)__builtin_amdgcn_s_getreg((3 << 11) | 20) & 0xFu; }
#define XB_SPIN(cond, bar) do { unsigned _sp = 0; while (cond) { __builtin_amdgcn_s_sleep(1); \
    if ((++_sp & 255u) == 0u) { if (xb_ld(&(bar)[XB_TMO])) break; if (_sp > XB_SPIN_CAP) { atomicAdd(&(bar)[XB_TMO], 1u); break; } } } } while (0)

struct XcdBarrier {
    unsigned* bar; unsigned x;
    volatile LAS unsigned* st;
};

__device__ __forceinline__ XcdBarrier xcd_barrier_post(unsigned* bar, volatile LAS unsigned* st) {
    XcdBarrier b; b.bar = bar; b.x = xb_xcc_id(); b.st = st;
    if (threadIdx.x == 0) (void)xb_add(&bar[XB_XCNT(b.x)], 1u);
    return b;
}
__device__ __forceinline__ void xcd_barrier_complete(unsigned* bar, unsigned x, unsigned& nloc, unsigned& nx) {
    const unsigned G = gridDim.x * gridDim.y * gridDim.z;
    unsigned sum, cnt, mine, sp = 0u;
    for (;;) {
        sum = 0u; cnt = 0u; mine = 0u;
#pragma unroll
        for (unsigned j = 0; j < 16; ++j) { const unsigned c = xb_ld(&bar[XB_XCNT(j)]); sum += c; cnt += (c > 0u) ? 1u : 0u; mine = (j == x) ? c : mine; }
        if (sum == G) break;
        __builtin_amdgcn_s_sleep(1);
        if ((++sp & 255u) == 0u) { if (xb_ld(&bar[XB_TMO])) break; if (sp > XB_SPIN_CAP) { atomicAdd(&bar[XB_TMO], 1u); break; } }
    }
    nloc = mine > 0u ? mine : 1u; nx = cnt > 0u ? cnt : 1u;
}

__device__ __forceinline__ void xcd_barrier(const XcdBarrier& b) {
    asm volatile("s_waitcnt vmcnt(0)" ::: "memory");
    __syncthreads();
    if (threadIdx.x == 0) {
        unsigned* bar = b.bar;
        __builtin_amdgcn_s_waitcnt(0);
        unsigned nloc = b.st[0], nx = b.st[1];
        if (nloc == 0u) { xcd_barrier_complete(bar, b.x, nloc, nx); b.st[0] = nloc; b.st[1] = nx; }
        const unsigned old = xb_add(&bar[XB_XSUB(b.x)], 1u);
        const unsigned gen = old / nloc;
        if (old + 1u == (gen + 1u) * nloc) {
            __builtin_amdgcn_fence(__ATOMIC_RELEASE, "agent");
            asm volatile("s_waitcnt vmcnt(0)" ::: "memory");
            const unsigned og = xb_add(&bar[XB_TOP], 1u);
            const unsigned tg = og / nx;
            if (og + 1u == (tg + 1u) * nx) xb_add(&bar[XB_TOPGEN], 1u);
            else XB_SPIN(xb_ld(&bar[XB_TOPGEN]) == tg, bar);
            __builtin_amdgcn_fence(__ATOMIC_ACQUIRE, "agent");
            xb_add(&bar[XB_XGEN(b.x)], 1u);
            asm volatile("s_waitcnt vmcnt(0)" ::: "memory");
        } else {
            XB_SPIN(xb_ld(&bar[XB_XGEN(b.x)]) == gen, bar);
            __builtin_amdgcn_fence(__ATOMIC_ACQUIRE, "agent");
            asm volatile("s_waitcnt vmcnt(0)" ::: "memory");
        }
    }
    __syncthreads();
}

constexpr int CW_BAR = 4096;

__device__ __forceinline__ int opaque_bid() { int b = blockIdx.x; asm volatile("" : "+s"(b)); return b; }
#ifndef XREP_MIX
#define XREP_MIX 1
#endif
struct OneUnit { int pm, pn;
    __device__ __forceinline__ bool next(int i, pg8::Unit& u) const { if (i != 0) return false; u.pm = pm; u.pn = pn; return true; }
    __device__ __forceinline__ void a_ready(const pg8::Unit&) const {}
    __device__ __forceinline__ void done(const pg8::Unit&) const {} };
struct Params { const float* in[27]; float* out; unsigned char* ws; int ph_lo, ph_hi; };

__device__ __forceinline__ unsigned f2bf(float f) { unsigned u = __builtin_bit_cast(unsigned, f); return (u + 0x7fffu + ((u >> 16) & 1u)) >> 16; }
__device__ __forceinline__ unsigned pk2(float lo, float hi) { return att::cvtpk(lo, hi); }
__device__ __forceinline__ unsigned short f2bfh(float x) { return (unsigned short)att::cvtpk(x, x); }
__device__ __forceinline__ float wave_sum(float v) {
#pragma unroll
    for (int o = 1; o < 64; o <<= 1) v += __shfl_xor(v, o);
    return v;
}

template <bool PERMQK>
__device__ __forceinline__ void tr_item(const float* W, int K, int N, bf16_t* WT, int ldk, int koff, LAS float* scr, int item, int lane) {
    const int nblk = N / 32, kb = item / nblk, nb = item % nblk, k0 = 64 * kb, n0 = 32 * nb;
    float tv[32];
#pragma unroll
    for (int i = 0; i < 32; ++i) { const int kk = 2 * i + (lane >> 5); tv[i] = __builtin_nontemporal_load(&W[(size_t)(k0 + kk) * N + n0 + (lane & 31)]); }
#pragma unroll
    for (int i = 0; i < 32; ++i) { const int kk = 2 * i + (lane >> 5); scr[kk * 33 + (lane & 31)] = tv[i]; }
    asm volatile("s_waitcnt lgkmcnt(0)" ::: "memory");
    const int c = lane & 7;
#pragma unroll
    for (int j = 0; j < 4; ++j) { const int n = (lane >> 3) + 8 * j; const LAS float* s = scr + (8 * c) * 33 + n;
        v4u o; o.x = pk2(s[0 * 33], s[1 * 33]); o.y = pk2(s[2 * 33], s[3 * 33]); o.z = pk2(s[4 * 33], s[5 * 33]); o.w = pk2(s[6 * 33], s[7 * 33]);
        int nn = n0 + n; if (PERMQK && nn < 1280) nn = (nn & ~127) | pos_of_dim(nn & 127);
        *(v4u*)(WT + (size_t)nn * ldk + koff + k0 + 8 * c) = o; }
    asm volatile("s_waitcnt lgkmcnt(0)" ::: "memory");
}

__device__ __forceinline__ void norm_row(const float* xrow, const float* nw, const float* sh, const float* sc, bf16_t* orow, int lane) {
    const f32x4* xr = (const f32x4*)xrow + lane;
    f32x4 v[4]; float s = 0.f;
#pragma unroll
    for (int j = 0; j < 4; ++j) { v[j] = xr[64 * j]; s += (v[j][0] * v[j][0] + v[j][1] * v[j][1]) + (v[j][2] * v[j][2] + v[j][3] * v[j][3]); }
    const float rstd = __builtin_amdgcn_rsqf(wave_sum(s) * (1.f / 1024.f) + 1e-6f);
    unsigned long long* o8 = (unsigned long long*)orow + lane;
#pragma unroll
    for (int j = 0; j < 4; ++j) { const f32x4 w = ((const f32x4*)nw)[lane + 64 * j], a = ((const f32x4*)sc)[lane + 64 * j], b = ((const f32x4*)sh)[lane + 64 * j];
        const f32x4 y = v[j] * rstd * w * (1.0f + a) + b;
        o8[64 * j] = (unsigned long long)pk2(y[0], y[1]) | ((unsigned long long)pk2(y[2], y[3]) << 32); }
}
__device__ __forceinline__ void norm_phase(const Params& P, int layer, int which  , bool first) {
    int tid_l = threadIdx.x; asm volatile("" : "+v"(tid_l));
    const int lane = tid_l & 63, wave = tid_l >> 6, gw = blockIdx.x * 8 + wave, NGW = gridDim.x * 8;
    const float* mod = (const float*)(P.ws + WS_MOD) + (size_t)layer * 5 * NMOD6 + which * 3072;
    const float* nw = P.in[which ? 10 : 9] + layer * 1024;
#define RS_RESET() do { __syncthreads(); if (threadIdx.x == 0) ((LAS int*)(lds + RED_OFF))[2048 + 64 + 256] = -1; __syncthreads(); } while (0)
    bf16_t* H = (bf16_t*)(P.ws + WS_H);
    for (int row = gw; row < NTOK; row += NGW) {
        const int cond = row < NCTX ? 0 : 1 + ((row - NCTX) >> 11);
        const float* x = first ? (row < NCTX ? P.in[0] + (size_t)row * 1024 : P.in[1] + (size_t)(row - NCTX) * 1024) : P.out + (size_t)row * 1024;
        norm_row(x, nw, mod + cond * NMOD6, mod + cond * NMOD6 + 1024, H + (size_t)row * 1024, lane);
    }
}

__device__ __forceinline__ void prep_phase(const Params& P, LAS unsigned char* lds) {
    int tid_l = threadIdx.x; asm volatile("" : "+v"(tid_l));
    const int tid = tid_l, lane = tid & 63, wave = tid >> 6, G = gridDim.x, gw = blockIdx.x * 8 + wave, NGW = G * 8;
    const float* MOD = (const float*)(P.ws + WS_MOD);
    for (int i = blockIdx.x * 512 + tid; i < NL * 2 * 5 * 1024; i += G * 512) {
        const int c = i & 1023, cond = (i >> 10) % 5, w = ((i >> 10) / 5) & 1, l = (i >> 10) / 10;
        ((float*)(P.ws + WS_WMOD))[i] = P.in[w ? 10 : 9][l * 1024 + c] * (1.0f + MOD[(size_t)(l * 5 + cond) * NMOD6 + (w ? 4 : 1) * 1024 + c]);
    }
    {
        const int r32 = lane & 31, hi = lane >> 5;
        constexpr int T_IN = NINW / 32, T_UP = DFF / 32, T_L = T_IN + T_UP;
        for (int tix = gw; tix < NL * T_L; tix += NGW) {
            const int l = tix / T_L, r = tix % T_L, w = r >= T_IN, n0 = 32 * (w ? r - T_IN : r), N = w ? DFF : NINW;
            const bf16_t* Wt = (w ? (const bf16_t*)(P.ws + WS_W1) + (size_t)l * DFF * 1024 : (const bf16_t*)(P.ws + WS_WIN) + (size_t)l * NINW * 1024) + (size_t)(n0 + r32) * 1024 + 8 * hi;
            const float* shp = MOD + (size_t)(l * 5 + (r32 < 5 ? r32 : 0)) * NMOD6 + (w ? 3 : 0) * 1024 + 8 * hi;
            f32x16 acc = {};
#pragma unroll 8
            for (int ks = 0; ks < 64; ++ks) {
                const bf16x8 bfr = *(const bf16x8*)(Wt + 16 * ks);
                bf16x8 afr = {0, 0, 0, 0, 0, 0, 0, 0};
                if (r32 < 5) { const f32x4 s0 = *(const f32x4*)(shp + 16 * ks), s1 = *(const f32x4*)(shp + 16 * ks + 4);
                    v4u t; t.x = pk2(s0[0], s0[1]); t.y = pk2(s0[2], s0[3]); t.z = pk2(s1[0], s1[1]); t.w = pk2(s1[2], s1[3]); afr = __builtin_bit_cast(bf16x8, t); }
                acc = __builtin_amdgcn_mfma_f32_32x32x16_bf16(afr, bfr, acc, 0, 0, 0);
            }
            float* SW = w ? (float*)(P.ws + WS_SWUP) + (size_t)l * 5 * DFF : (float*)(P.ws + WS_SWIN) + (size_t)l * 5 * NINW;
            if (hi == 0) { SW[(size_t)0 * N + n0 + r32] = acc[0]; SW[(size_t)1 * N + n0 + r32] = acc[1]; SW[(size_t)2 * N + n0 + r32] = acc[2]; SW[(size_t)3 * N + n0 + r32] = acc[3]; }
            else SW[(size_t)4 * N + n0 + r32] = acc[0];
        }
    }
    bf16_t* H = (bf16_t*)(P.ws + WS_H); float* SSQ = (float*)(P.ws + WS_SSQ);
    for (int row = gw; row < NTOK; row += NGW) {
        const int cond = row < NCTX ? 0 : 1 + ((row - NCTX) >> 11);
        const float* x = row < NCTX ? P.in[0] + (size_t)row * 1024 : P.in[1] + (size_t)(row - NCTX) * 1024;
        const f32x4* xr = (const f32x4*)x + lane; const f32x4* nw = (const f32x4*)P.in[9] + lane; const f32x4* sc = (const f32x4*)(MOD + (size_t)cond * NMOD6 + 1024) + lane;
        unsigned long long* o8 = (unsigned long long*)(H + (size_t)row * 1024) + lane;
        float s = 0.f;
#pragma unroll
        for (int j = 0; j < 4; ++j) { const f32x4 v = xr[64 * j]; s += (v[0] * v[0] + v[1] * v[1]) + (v[2] * v[2] + v[3] * v[3]);
            const f32x4 y = v * nw[64 * j] * (1.0f + sc[64 * j]);
            o8[64 * j] = (unsigned long long)pk2(y[0], y[1]) | ((unsigned long long)pk2(y[2], y[3]) << 32); }
        s = wave_sum(s);
        if (lane < 16) SSQ[(size_t)row * 16 + lane] = lane == 0 ? s : 0.f;
    }
}

__device__ __forceinline__ void prologue(const Params& P, LAS unsigned char* lds) {
    int tid_l = threadIdx.x; asm volatile("" : "+v"(tid_l));
    const int tid = tid_l, lane = tid & 63, wave = tid >> 6, G = gridDim.x;
    const int gw = blockIdx.x * 8 + wave, NGW = G * 8;
    LAS float* scr = (LAS float*)(lds + wave * 16384);
    constexpr int I_IN = 16 * 176, I_O = 16 * 32, I_1 = 16 * 128, I_2 = 64 * 32, I_L = I_IN + 3 * I_O + I_1 + I_2;
    for (int it = gw; it < NL * I_L; it += NGW) {
        const int l = it / I_L; int r = it % I_L;
        if (r < I_IN) { tr_item<true>(P.in[11] + (size_t)l * 1024 * NINW, 1024, NINW, (bf16_t*)(P.ws + WS_WIN) + (size_t)l * NINW * 1024, 1024, 0, scr, r, lane); continue; } r -= I_IN;
        if (r < I_O) { tr_item<false>(P.in[22] + (size_t)l * 1024 * 1024, 1024, 1024, (bf16_t*)(P.ws + WS_WCAT) + (size_t)l * 1024 * 2048, 2048, 0, scr, r, lane); continue; } r -= I_O;
        if (r < I_O) { tr_item<false>(P.in[23] + (size_t)l * 1024 * 1024, 1024, 1024, (bf16_t*)(P.ws + WS_WCAT) + (size_t)l * 1024 * 2048, 2048, 1024, scr, r, lane); continue; } r -= I_O;
        if (r < I_O) { tr_item<false>(P.in[24] + (size_t)l * 1024 * 1024, 1024, 1024, (bf16_t*)(P.ws + WS_WOUT) + (size_t)l * 1024 * 1024, 1024, 0, scr, r, lane); continue; } r -= I_O;
        if (r < I_1) { tr_item<false>(P.in[25] + (size_t)l * 1024 * DFF, 1024, DFF, (bf16_t*)(P.ws + WS_W1) + (size_t)l * DFF * 1024, 1024, 0, scr, r, lane); continue; } r -= I_1;
        tr_item<false>(P.in[26] + (size_t)l * DFF * 1024, DFF, 1024, (bf16_t*)(P.ws + WS_W2) + (size_t)l * 1024 * DFF, DFF, 0, scr, r, lane);
    }
    __syncthreads();
    {
        LAS float* sv = (LAS float*)lds; LAS float* rb = (LAS float*)(lds + 20480);
        for (int i = tid; i < 5120; i += 512) { const int cond = i >> 10, k = i & 1023; const float x = cond == 0 ? P.in[6][k] : P.in[5][(cond - 1) * 1024 + k]; sv[i] = x * __builtin_amdgcn_rcpf(1.0f + __expf(-x)); }
        __syncthreads();
        for (int it = blockIdx.x; it < NL * 96; it += G) {
            const int l = it / 96, cg_ = it % 96;
            const float* W = P.in[7] + ((size_t)l * 1024 + wave * 128) * NMOD6 + cg_ * 64 + lane;
            float a0 = 0.f, a1 = 0.f, a2 = 0.f, a3 = 0.f, a4 = 0.f;
#pragma unroll 16
            for (int k = 0; k < 128; ++k) { const float w = __builtin_nontemporal_load(&W[(size_t)k * NMOD6]); const int kk = wave * 128 + k;
                a0 += sv[kk] * w; a1 += sv[1024 + kk] * w; a2 += sv[2048 + kk] * w; a3 += sv[3072 + kk] * w; a4 += sv[4096 + kk] * w; }
            rb[(wave * 5 + 0) * 64 + lane] = a0; rb[(wave * 5 + 1) * 64 + lane] = a1; rb[(wave * 5 + 2) * 64 + lane] = a2; rb[(wave * 5 + 3) * 64 + lane] = a3; rb[(wave * 5 + 4) * 64 + lane] = a4;
            __syncthreads();
            if (tid < 320) { const int cond = tid >> 6; float s = 0.f;
#pragma unroll
                for (int w = 0; w < 8; ++w) s += rb[(w * 5 + cond) * 64 + lane];
                s += P.in[8][l * NMOD6 + cg_ * 64 + lane];
                ((float*)(P.ws + WS_MOD))[(size_t)(l * 5 + cond) * NMOD6 + cg_ * 64 + lane] = s; }
            __syncthreads();
        }
    }
    const int gt = blockIdx.x * 512 + tid, NGT = G * 512;
#ifdef NANFILL
    { v4u nanv = {0x7FC07FC0u, 0x7FC07FC0u, 0x7FC07FC0u, 0x7FC07FC0u};
      v4u* a = (v4u*)(P.ws + WS_H); const size_t na = (WS_END - WS_H) / 16;
      for (size_t i = gt; i < na; i += NGT) a[i] = nanv;
      v4u* o = (v4u*)P.out; const size_t no = (size_t)(33554432 + 262144) / 4;
      for (size_t i = gt; i < no; i += NGT) o[i] = nanv; }
#endif
    for (int i = gt; i < 4 * 4 * 512 * 256 / 2; i += NGT) {
        const int e = 2 * i, p = e & 127, base = e & ~127;
        const float* ck = P.in[2] + base;
        ((unsigned*)(P.ws + WS_CK))[i] = pk2(ck[dim_of_pos(p)], ck[dim_of_pos(p + 1)]);
        ((unsigned*)(P.ws + WS_CV))[i] = pk2(P.in[3][e], P.in[3][e + 1]);
    }
    for (int i = gt; i < NL * 2 * 8 * 2 * 4 * 8 * 64; i += NGT) {
        const int ln = i & 63, ks = (i >> 6) & 7, w4 = (i >> 9) & 3, gate = (i >> 11) & 1, nb = (i >> 12) & 7, dr = (i >> 15) & 1, l = i >> 16;
        const float* W = (gate ? P.in[20] : P.in[18]) + ((size_t)((l * 2 + dr) * 8 + nb) * 128) * 128 + w4 * 32 + (ln & 31);
        float v[8];
#pragma unroll
        for (int j = 0; j < 8; ++j) v[j] = W[(16 * ks + 8 * (ln >> 5) + j) * 128];
        v4u o; o.x = pk2(v[0], v[1]); o.y = pk2(v[2], v[3]); o.z = pk2(v[4], v[5]); o.w = pk2(v[6], v[7]);
        ((v4u*)(P.ws + WS_WFR))[i] = o;
    }
    for (int i = gt; i < 2048 * 64; i += NGT) {
        const int t = i >> 6, pi = i & 63, ax = pi >> 5, fi = pi & 31;
        const float freq = powf(10000.0f, -(float)(2 * fi) / 64.0f);
        const float ang = (float)(ax == 0 ? (t >> 6) : (t & 63)) * freq;
        float* o = (float*)(P.ws + WS_ROPE) + (size_t)i * 2; o[0] = cosf(ang); o[1] = sinf(ang);
    }
}

__device__ __forceinline__ int crow16(int r, int hi) { return (r & 3) + 8 * (r >> 2) + 4 * hi; }
__device__ __forceinline__ float partner32(float x, int hi) { auto rr = __builtin_amdgcn_permlane32_swap(__float_as_uint(x), __float_as_uint(x), false, false); return __uint_as_float(hi ? rr[0] : rr[1]); }
__device__ __forceinline__ void lru_unit(const Params& P, int layer, int latent, int b, int seg, int nblk, LAS unsigned char* lds) {
    int tid_l = threadIdx.x; asm volatile("" : "+v"(tid_l));
    const int tid = tid_l, lane = tid & 63, r32 = lane & 31, hi = lane >> 5;
    const int wid = __builtin_amdgcn_readfirstlane(tid >> 6), dir = wid >> 2, w4 = wid & 3, gt = tid & 255;
    constexpr int nch = 8;
    const int Tseq = latent ? 2048 : 256, t0seg = seg * 256;
    const int rowseq = latent ? NCTX + b * 2048 : b * 256, rowbase = rowseq + t0seg;
    const int chl = w4 * 32 + r32, ch = nblk * 128 + chl;
    constexpr int TILEB = 32 * 272;
    LAS unsigned char* tiles = lds;
    LAS float* cw = (LAS float*)(lds + 8 * TILEB);
    const bf16_t* XR = (const bf16_t*)(P.ws + WS_XR);
    bf16_t* HT = ((bf16_t*)P.out + (size_t)16777216);
    bf16_t* ACAT = (bf16_t*)(P.ws + WS_ACAT);
    bf16_t* PD = (bf16_t*)(P.ws + (dir ? WS_PB : WS_PF));
    for (int i = tid; i < 640; i += 512) cw[i] = (i < 512) ? P.in[15][((size_t)layer * 4 + (i >> 7)) * 1024 + nblk * 128 + (i & 127)] : P.in[16][layer * 1024 + nblk * 128 + (i & 127)];
    bf16x8 bR[8], bI0;
    LAS unsigned char* wib = lds + 72704 + wid * 7168 + lane * 16;
    {
        const v4u* fr = (const v4u*)(P.ws + WS_WFR) + ((size_t)(((layer * 2 + dir) * 8 + nblk) * 2) * 4 + w4) * 512 + lane;
#pragma unroll
        for (int ks = 0; ks < 8; ++ks) { const v4u a = fr[ks * 64], g = fr[2048 + ks * 64];
            bR[ks] = __builtin_bit_cast(bf16x8, a); if (ks == 0) bI0 = __builtin_bit_cast(bf16x8, g); else *(LAS v4u*)(wib + (ks - 1) * 1024) = g; }
    }
    const float ba = P.in[19][(layer * 2 + dir) * 1024 + ch], bi = P.in[21][(layer * 2 + dir) * 1024 + ch];
    const float lam = P.in[17][(layer * 2 + dir) * 1024 + ch];
    const float clam = -8.0f * 1.4426950408889634f * log1pf(__expf(-lam));
    float h = 0.f, p = 1.f;
    const int st = 2 * (gt >> 4), c8 = (gt & 15) * 8;
    const int strow = 8 * ((st & 15) >> 2) + 4 * (st >> 4) + (st & 3);
    v4u pre[5];
#define LRU_LOAD(ck_) do { const int ck__ = (ck_); _Pragma("unroll") for (int i = 0; i < 5; ++i) { \
        const int tt = t0seg + ck__ * 32 + st + i - 2; \
        pre[i] = (tt >= 0 && tt < Tseq) ? *(const v4u*)(XR + (size_t)(rowseq + tt) * 1024 + nblk * 128 + c8) : (v4u){0u, 0u, 0u, 0u}; } } while (0)
#define LRU_CONV(buf_) do { float y0[8], y1[8]; { const f32x4 b0 = *(const LAS f32x4*)(cw + 512 + c8), b1 = *(const LAS f32x4*)(cw + 512 + c8 + 4); \
            _Pragma("unroll") for (int j = 0; j < 4; ++j) { y0[j] = b0[j]; y0[4 + j] = b1[j]; y1[j] = b0[j]; y1[4 + j] = b1[j]; } } \
        _Pragma("unroll") for (int k = 0; k < 4; ++k) { const f32x4 w0 = *(const LAS f32x4*)(cw + k * 128 + c8), w1 = *(const LAS f32x4*)(cw + k * 128 + c8 + 4); \
            const v4u xa = pre[k], xb = pre[k + 1]; \
            _Pragma("unroll") for (int q = 0; q < 4; ++q) { const float wlo = q < 2 ? w0[2 * q] : w1[2 * q - 4], whi = q < 2 ? w0[2 * q + 1] : w1[2 * q - 3]; \
                y0[2 * q] += wlo * __uint_as_float(xa[q] << 16); y0[2 * q + 1] += whi * __uint_as_float(xa[q] & 0xffff0000u); \
                y1[2 * q] += wlo * __uint_as_float(xb[q] << 16); y1[2 * q + 1] += whi * __uint_as_float(xb[q] & 0xffff0000u); } } \
        v4u o; o.x = pk2(y0[0], y0[1]); o.y = pk2(y0[2], y0[3]); o.z = pk2(y0[4], y0[5]); o.w = pk2(y0[6], y0[7]); \
        *(LAS v4u*)(tiles + (buf_) * TILEB + strow * 272 + c8 * 2) = o; \
        o.x = pk2(y1[0], y1[1]); o.y = pk2(y1[2], y1[3]); o.z = pk2(y1[4], y1[5]); o.w = pk2(y1[6], y1[7]); \
        *(LAS v4u*)(tiles + (buf_) * TILEB + (strow + 1) * 272 + c8 * 2) = o; } while (0)
    LRU_LOAD(dir ? nch - 1 : 0);
    __syncthreads();
    LRU_CONV(dir ? nch - 1 : 0);
    __syncthreads();
    for (int k = 0; k < nch; ++k) {
        const int ck = dir ? nch - 1 - k : k;
        const LAS unsigned char* tile = tiles + ck * TILEB;
        f32x16 aR = {}, aI = {};
#pragma unroll
        for (int ks = 0; ks < 8; ++ks) { const bf16x8 af = *(const LAS bf16x8*)(tile + r32 * 272 + (16 * ks + 8 * hi) * 2);
            aR = __builtin_amdgcn_mfma_f32_32x32x16_bf16(af, bR[ks], aR, 0, 0, 0);
            aI = __builtin_amdgcn_mfma_f32_32x32x16_bf16(af, ks == 0 ? bI0 : *(const LAS bf16x8*)(wib + (ks - 1) * 1024), aI, 0, 0, 0); }
        float av[16], bv[16];
#pragma unroll
        for (int r = 0; r < 16; ++r) { const int t = crow16(r, hi);
            const float x = bf2f(*(const LAS unsigned short*)(tile + t * 272 + chl * 2));
            const float eu = 1.0f + __builtin_amdgcn_exp2f(-1.4426950408889634f * (aR[r] + ba)), ev = 1.0f + __builtin_amdgcn_exp2f(-1.4426950408889634f * (aI[r] + bi));
            const float inv = __builtin_amdgcn_rcpf(eu * ev);
            const float rr = ev * inv, ii = eu * inv;
            const float a = __builtin_amdgcn_exp2f(clam * rr);
            av[r] = a; bv[r] = __builtin_amdgcn_sqrtf(fmaxf(fmaf(-a, a, 1.0f), 0.f)) * (ii * x); }
        if (k < 3) LRU_LOAD(dir ? nch - 2 - k : k + 1);
        if (dir == 0) {
#pragma unroll
            for (int r = 1; r < 16; ++r) { bv[r] = fmaf(av[r], bv[r - 1], bv[r]); av[r] *= av[r - 1]; }
            const float ho = fmaf(av[15], h, bv[15]), po = av[15] * p;
            const float nh = partner32(ho, hi), np = partner32(po, hi);
            const float hin = hi ? nh : h, pin = hi ? np : p;
#pragma unroll
            for (int r = 0; r < 16; ++r) { bv[r] = fmaf(av[r], hin, bv[r]); av[r] *= pin; }
            const float eh = partner32(bv[15], hi), ep = partner32(av[15], hi);
            h = hi ? bv[15] : eh; p = hi ? av[15] : ep;
        } else {
#pragma unroll
            for (int r = 14; r >= 0; --r) { bv[r] = fmaf(av[r], bv[r + 1], bv[r]); av[r] *= av[r + 1]; }
            const float ho = fmaf(av[0], h, bv[0]), po = av[0] * p;
            const float nh = partner32(ho, hi), np = partner32(po, hi);
            const float hin = hi ? h : nh, pin = hi ? p : np;
#pragma unroll
            for (int r = 0; r < 16; ++r) { bv[r] = fmaf(av[r], hin, bv[r]); av[r] *= pin; }
            const float eh = partner32(bv[0], hi), ep = partner32(av[0], hi);
            h = hi ? eh : bv[0]; p = hi ? ep : av[0];
        }
        {
            char* hb_ = dir ? (char*)ACAT + (size_t)(rowbase + ck * 32) * 4096 + 2048 : (char*)HT + (size_t)(rowbase + ck * 32) * 2048;
            const unsigned rs_ = dir ? 4096u : 2048u;
            const unsigned lo1 = (unsigned)(16 * hi) * rs_ + (unsigned)(ch * 2);
#pragma unroll
            for (int r = 0; r < 16; ++r) *(bf16_t*)(hb_ + (lo1 + (unsigned)r * rs_)) = f2bfh(bv[r]);
            if (latent) {
                char* pdb = (char*)PD + (size_t)(rowbase - NCTX + ck * 32) * 2048;
                const unsigned lo2 = (unsigned)((16 * hi) * 2048 + ch * 2);
#pragma unroll
                for (int r = 0; r < 16; ++r) *(bf16_t*)(pdb + (lo2 + (unsigned)(r * 2048))) = f2bfh(av[r]);
            }
        }
        if (k < 3) LRU_CONV(dir ? nch - 2 - k : k + 1);
        asm volatile("s_waitcnt lgkmcnt(0)\n\ts_barrier" ::: "memory");
    }
    if (hi == 0) {
        if (latent) { float* tot = (float*)(P.ws + WS_TOT) + ((size_t)(((b * 8 + nblk) * 8 + seg) * 2 + dir) * 2) * 128 + chl; tot[0] = p; tot[128] = h; }
        else P.out[OUT_S + ((size_t)(b * 4 + layer) * 2 + dir) * 1024 + ch] = h;
    }
    asm volatile("s_waitcnt vmcnt(0)" ::: "memory"); __syncthreads();
    if (!latent) {
        const bf16_t* GXB = ((const bf16_t*)P.out);
#pragma unroll
        for (int hb4 = 0; hb4 < 2; ++hb4) {
            v4u hf[4], hb[4], gx[4];
#pragma unroll
            for (int i = 0; i < 4; ++i) { const int it = tid + (hb4 * 4 + i) * 512; const size_t row = (size_t)rowbase + (it >> 4); const int col = nblk * 128 + (it & 15) * 8;
                hf[i] = *(const v4u*)(HT + row * 1024 + col); hb[i] = *(const v4u*)(ACAT + row * 2048 + 1024 + col); gx[i] = *(const v4u*)(GXB + row * 1024 + col); }
#pragma unroll
            for (int i = 0; i < 4; ++i) { const int it = tid + (hb4 * 4 + i) * 512; const size_t row = (size_t)rowbase + (it >> 4); const int col = nblk * 128 + (it & 15) * 8;
                v4u o;
#pragma unroll
                for (int q = 0; q < 4; ++q) {
                    const float ylo = (__uint_as_float(hf[i][q] << 16) + __uint_as_float(hb[i][q] << 16)) * __uint_as_float(gx[i][q] << 16);
                    const float yhi = (__uint_as_float(hf[i][q] & 0xffff0000u) + __uint_as_float(hb[i][q] & 0xffff0000u)) * __uint_as_float(gx[i][q] & 0xffff0000u);
                    o[q] = pk2(ylo, yhi); }
                *(v4u*)(ACAT + row * 2048 + 1024 + col) = o; }
        }
    }
    if (latent) {
        if (tid == 0) { __builtin_amdgcn_fence(__ATOMIC_RELEASE, "agent"); asm volatile("s_waitcnt vmcnt(0)" ::: "memory");
            __hip_atomic_fetch_add((unsigned*)(P.ws + WS_CTL) + CW_DONE + ((layer * 4 + b) * 8 + nblk) * 16, 1u, __ATOMIC_RELAXED, __HIP_MEMORY_SCOPE_AGENT); }
    }
#undef LRU_LOAD
#undef LRU_CONV
}

__device__ __forceinline__ void lru_fix_unit(const Params& P, int layer, int u, LAS unsigned char* lds) {
    int tid_l = threadIdx.x; asm volatile("" : "+v"(tid_l));
    const int tid = tid_l;
    LAS float* carr = (LAS float*)lds;
    const bf16_t* HT = ((const bf16_t*)P.out + (size_t)16777216); const bf16_t* PF = (const bf16_t*)(P.ws + WS_PF); const bf16_t* PB = (const bf16_t*)(P.ws + WS_PB);
    bf16_t* ACAT = (bf16_t*)(P.ws + WS_ACAT);
    {
        const int b = u >> 6, n = (u >> 3) & 7, seg = u & 7;
        if (tid == 0) {
            unsigned* dn = (unsigned*)(P.ws + WS_CTL) + CW_DONE + ((layer * 4 + b) * 8 + n) * 16; unsigned spins = 0;
            while (__hip_atomic_load(dn, __ATOMIC_RELAXED, __HIP_MEMORY_SCOPE_AGENT) < 8u && ++spins < (1u << 22)) __builtin_amdgcn_s_sleep(4);
            __builtin_amdgcn_fence(__ATOMIC_ACQUIRE, "agent"); asm volatile("s_waitcnt vmcnt(0)" ::: "memory");
        }
        __syncthreads();
        if (tid < 256) {
            const int dir = tid >> 7, c = tid & 127;
            float cy = P.in[4][((size_t)(b * 4 + layer) * 2 + dir) * 1024 + n * 128 + c];
            const float* tot = (const float*)(P.ws + WS_TOT) + ((size_t)((b * 8 + n) * 8) * 2 + dir) * 2 * 128 + c;
            float tp[8], th[8];
#pragma unroll
            for (int j = 0; j < 8; ++j) { tp[j] = tot[j * 512]; th[j] = tot[j * 512 + 128]; }
            if (dir == 0) {
#pragma unroll
                for (int j = 0; j < 7; ++j) if (j < seg) cy = fmaf(tp[j], cy, th[j]);
            } else {
#pragma unroll
                for (int j = 7; j > 0; --j) if (j > seg) cy = fmaf(tp[j], cy, th[j]);
            }
            carr[tid] = cy;
        }
        __syncthreads();
        const size_t row0 = (size_t)NCTX + b * 2048 + seg * 256;
#pragma unroll
        for (int hb4 = 0; hb4 < 2; ++hb4) {
            v4u s[4], s2[4], pf[4], pb[4], gx[4];
#pragma unroll
            for (int i = 0; i < 4; ++i) { const int it = tid + (hb4 * 4 + i) * 512; const size_t row = row0 + (it >> 4); const int col = n * 128 + (it & 15) * 8;
                s[i] = *(const v4u*)(HT + row * 1024 + col); s2[i] = *(const v4u*)(ACAT + row * 2048 + 1024 + col);
                pf[i] = *(const v4u*)(PF + (row - NCTX) * 1024 + col); pb[i] = *(const v4u*)(PB + (row - NCTX) * 1024 + col);
                gx[i] = *(const v4u*)((const bf16_t*)P.out + row * 1024 + col); }
#pragma unroll
            for (int i = 0; i < 4; ++i) { const int it = tid + (hb4 * 4 + i) * 512; const size_t row = row0 + (it >> 4); const int c8 = (it & 15) * 8, col = n * 128 + c8;
                const f32x4 cf0 = *(const LAS f32x4*)(carr + c8), cf1 = *(const LAS f32x4*)(carr + c8 + 4), cb0 = *(const LAS f32x4*)(carr + 128 + c8), cb1 = *(const LAS f32x4*)(carr + 128 + c8 + 4);
                v4u o;
#pragma unroll
                for (int q = 0; q < 4; ++q) { const float cfl = q < 2 ? cf0[2 * q] : cf1[2 * q - 4], cfh = q < 2 ? cf0[2 * q + 1] : cf1[2 * q - 3], cbl = q < 2 ? cb0[2 * q] : cb1[2 * q - 4], cbh = q < 2 ? cb0[2 * q + 1] : cb1[2 * q - 3];
                    const float ylo = (__uint_as_float(s[i][q] << 16) + __uint_as_float(s2[i][q] << 16) + __uint_as_float(pf[i][q] << 16) * cfl + __uint_as_float(pb[i][q] << 16) * cbl) * __uint_as_float(gx[i][q] << 16);
                    const float yhi = (__uint_as_float(s[i][q] & 0xffff0000u) + __uint_as_float(s2[i][q] & 0xffff0000u) + __uint_as_float(pf[i][q] & 0xffff0000u) * cfh + __uint_as_float(pb[i][q] & 0xffff0000u) * cbh) * __uint_as_float(gx[i][q] & 0xffff0000u);
                    o[q] = pk2(ylo, yhi); }
                *(v4u*)(ACAT + row * 2048 + 1024 + col) = o; }
        }
        __syncthreads();
    }
}

__device__ __forceinline__ void mixer_phase(const Params& P, int layer, unsigned char* lds_generic, LAS unsigned char* lds, int rep, const pg8::EpiIn& EI) {
    unsigned* ctr = (unsigned*)(P.ws + WS_CTL) + CW_QUEUE + 64 * (layer + 4 * rep);
    volatile LAS unsigned* misc = (volatile LAS unsigned*)(lds + MISC_OFF);
    const bf16_t* Q = (const bf16_t*)(P.ws + WS_Q); const bf16_t* KB = (const bf16_t*)(P.ws + WS_KB); const bf16_t* VB = (const bf16_t*)(P.ws + WS_VB);
    const bf16_t* CK = (const bf16_t*)(P.ws + WS_CK); const bf16_t* CV = (const bf16_t*)(P.ws + WS_CV);
    bf16_t* ACAT = (bf16_t*)(P.ws + WS_ACAT);
    if (threadIdx.x == 0) misc[0] = __hip_atomic_fetch_add(ctr, 1u, __ATOMIC_RELAXED, __HIP_MEMORY_SCOPE_AGENT);
    for (int it = 0;; ++it) {
        __syncthreads();
        unsigned nxt = 0u;
        if (threadIdx.x == 0) nxt = __hip_atomic_fetch_add(ctr, 1u, __ATOMIC_RELAXED, __HIP_MEMORY_SCOPE_AGENT);
        const int tk = __builtin_amdgcn_readfirstlane((int)misc[it & 1]);
        if (tk >= 1408) break;
        const int idx = tk < 768 ? tk : (tk < 896 ? tk - 896 : tk - 128);
        if (idx < 0) {
            const int u = idx + 128;
            pg8::Gemm g{(const bf16_t*)(P.ws + WS_H), (const bf16_t*)(P.ws + WS_WIN) + (size_t)layer * NINW * 1024, NTOK, NINW, 1024};
            if (threadIdx.x == 0) ((LAS int*)(lds + RED_OFF))[2048 + 64 + 256] = -1;
            __syncthreads();
            OneUnit S1{u & 63, 20 + (u >> 6)};
            pg8::gemm_phase<pg8::EpiIn, OneUnit, true, true>(lds, g, S1, EI);
        }
        else if (idx >= 1024) { lru_fix_unit(P, layer, idx - 1024, lds); }
        else if (idx >= 256 && idx < 768) {
#ifndef NO_LRU
            const int j = idx - 256, latent = j < 256, jj = j & 255;
            lru_unit(P, layer, latent, latent ? (jj >> 6) : (jj >> 3), latent ? ((jj >> 3) & 7) : 0, jj & 7, lds);
#endif
        } else {
#ifndef NO_ATT
            const bool latent = idx < 256;
            const int j = latent ? idx : idx - 768;
            const int b = latent ? (j >> 6) : (j >> 3), hh = latent ? ((j >> 3) & 7) : (j & 7), qb = latent ? (j & 7) : 0, kvh = hh >> 2;
            const int q0 = qb * 256, ks = q0 - 128 < 0 ? 0 : q0 - 128, ke = q0 + 384 > 2048 ? 2048 : q0 + 384;
            const size_t rq = latent ? (size_t)NCTX + b * 2048 + q0 : (size_t)b * 256;
            const size_t rk = (size_t)NCTX + b * 2048 + ks, ck0 = (size_t)(b * 4 + layer) * 512;
            const bf16_t* K0 = latent ? CK + ck0 * 256 + kvh * 128 : KB + rq * 256 + kvh * 128;
            const bf16_t* V0 = latent ? CV + ck0 * 256 + kvh * 128 : VB + rq * 256 + kvh * 128;
            att::attn_unit(Q + rq * 1024 + hh * 128, K0, V0, latent ? 8 : 4,
                           KB + rk * 256 + kvh * 128, VB + rk * 256 + kvh * 128, latent ? (ke - ks) / 64 : 0, ks - q0,
                           P.in[14][layer * 8 + hh] * 1.4426950408889634f, ACAT + rq * 2048 + hh * 128, (char*)lds_generic);
#endif
        }
        if (threadIdx.x == 0) misc[(it + 1) & 1] = nxt;
    }
}

__global__ void __launch_bounds__(512, 2) fwd_megakernel(Params P) {
    extern __shared__ __attribute__((aligned(16))) unsigned char lds_raw[];
    LAS unsigned char* lds = (LAS unsigned char*)lds_raw;
    cg::grid_group grid = cg::this_grid();
    const int lo = P.ph_lo, hi = P.ph_hi, G = gridDim.x;
    int ph = 0;
    { volatile LAS unsigned* m = (volatile LAS unsigned*)(lds + MISC_OFF); if (threadIdx.x < 16) m[threadIdx.x] = 0u; }
    __syncthreads();
    XcdBarrier bar = xcd_barrier_post((unsigned*)(P.ws + WS_CTL) + CW_BAR, (volatile LAS unsigned*)(lds + MISC_OFF) + 8);
#define PHASE(...) do { if (ph >= lo && ph < hi) { __VA_ARGS__; if (ph + 1 < hi) { if (lo < 0) grid.sync(); else xcd_barrier(bar); } } ++ph; } while (0)
    bf16_t* H = (bf16_t*)(P.ws + WS_H);
#ifndef NO_PRO
    PHASE(prologue(P, lds));
#endif
    PHASE(prep_phase(P, lds));
#ifdef XSYNC
    if (hi > 1) { for (int i = 0; i < XSYNC; ++i) grid.sync(); }
#endif
    for (int l = 0; l < NL; ++l) {
        const float* mod = (const float*)(P.ws + WS_MOD) + (size_t)l * 5 * NMOD6;
        const pg8::EpiIn EI{(bf16_t*)(P.ws + WS_Q), (bf16_t*)(P.ws + WS_KB), (bf16_t*)(P.ws + WS_VB), (bf16_t*)(P.ws + WS_XR), ((bf16_t*)P.out), (bf16_t*)(P.ws + WS_G),
                         P.out + OUT_K, P.out + OUT_V, P.in[12] + l * 128, P.in[13] + l * 128, (const float*)(P.ws + WS_ROPE), (LAS float*)(lds + RED_OFF), l,
                         (const float*)(P.ws + WS_SSQ), (const float*)(P.ws + WS_SWIN) + (size_t)l * 5 * NINW};
        PHASE({ RS_RESET(); pg8::Gemm g{H, (const bf16_t*)(P.ws + WS_WIN) + (size_t)l * NINW * 1024, NTOK, NINW, 1024}; pg8::StaticOrder S; S.init(NTOK, 5120, G, opaque_bid());
            pg8::gemm_phase<pg8::EpiIn, pg8::StaticOrder, true, true>(lds, g, S, EI); });
        PHASE({ _Pragma("nounroll") for (int rep = 0; rep < XREP_MIX; ++rep) { mixer_phase(P, l, lds_raw, lds, rep, EI); if (rep + 1 < XREP_MIX) xcd_barrier(bar); } });
        PHASE({ pg8::Gemm g{(const bf16_t*)(P.ws + WS_ACAT), (const bf16_t*)(P.ws + WS_WCAT) + (size_t)l * 1024 * 2048, NTOK, 1024, 2048}; pg8::StaticOrder S; S.init(NTOK, 1024, G, opaque_bid());
            pg8::EpiMerge E{(const bf16_t*)(P.ws + WS_G), (bf16_t*)(P.ws + WS_MERGED)};

#ifndef NO_G2
 pg8::gemm_phase<pg8::EpiMerge, pg8::StaticOrder, true, true>(lds, g, S, E);
#endif
 });
        PHASE({ pg8::Gemm g{(const bf16_t*)(P.ws + WS_MERGED), (const bf16_t*)(P.ws + WS_WOUT) + (size_t)l * 1024 * 1024, NTOK, 1024, 1024}; pg8::StaticOrder S; S.init(NTOK, 1024, G, opaque_bid());
            pg8::EpiRes E{l == 0 ? P.in[0] : (const float*)nullptr, P.in[1] - (size_t)NCTX * 1024, (const bf16_t*)(P.ws + WS_X16), (bf16_t*)(P.ws + WS_X16), (float*)nullptr, mod + 2048, H, (const float*)(P.ws + WS_WMOD) + (size_t)(l * 2 + 1) * 5 * 1024, (float*)(P.ws + WS_SSQ)};

#ifndef NO_G3
 pg8::gemm_phase<pg8::EpiRes, pg8::StaticOrder, true, true>(lds, g, S, E);
#endif
 });
        PHASE({ RS_RESET(); pg8::Gemm g{H, (const bf16_t*)(P.ws + WS_W1) + (size_t)l * DFF * 1024, NTOK, DFF, 1024}; pg8::StaticOrder S; S.init(NTOK, DFF, G, opaque_bid());
            pg8::EpiUp E{(bf16_t*)(P.ws + WS_U), (const float*)(P.ws + WS_SSQ), (const float*)(P.ws + WS_SWUP) + (size_t)l * 5 * DFF, (LAS float*)(lds + RED_OFF) + 2048 + 64};

#ifndef NO_G4
 pg8::gemm_phase<pg8::EpiUp, pg8::StaticOrder, true, true>(lds, g, S, E);
#endif
 });
        PHASE({ pg8::Gemm g{(const bf16_t*)(P.ws + WS_U), (const bf16_t*)(P.ws + WS_W2) + (size_t)l * 1024 * DFF, NTOK, 1024, DFF}; pg8::StaticOrder S; S.init(NTOK, 1024, G, opaque_bid());
            pg8::EpiRes E{(const float*)nullptr, (const float*)nullptr, (const bf16_t*)(P.ws + WS_X16), (bf16_t*)(P.ws + WS_X16), l + 1 < NL ? (float*)nullptr : P.out, mod + 5 * 1024, l + 1 < NL ? H : (bf16_t*)nullptr, (const float*)(P.ws + WS_WMOD) + (size_t)((l + 1) * 2) * 5 * 1024, (float*)(P.ws + WS_SSQ)};

#ifndef NO_G3
 pg8::gemm_phase<pg8::EpiRes, pg8::StaticOrder, true, true>(lds, g, S, E);
#endif
 });
    }
#undef PHASE
#ifdef DUMP_PH
    grid.sync();
    { const v4u* src = (const v4u*)(P.ws + (size_t)DUMP_OFF * MiB); v4u* dst = (v4u*)P.out; const size_t n = (size_t)(33554432 + 262144) / 4;
      const size_t nl = (size_t)DUMP_LEN * MiB / 16; const v4u z = {0u, 0u, 0u, 0u};
      for (size_t i = (size_t)blockIdx.x * 512 + threadIdx.x; i < n; i += (size_t)gridDim.x * 512) dst[i] = i < nl ? src[i] : z; }
#endif
}

extern "C" void kernel_launch(void* const* d_in, const int* in_sizes, int n_in, void* d_out, int out_size, void* d_ws, size_t ws_size, hipStream_t stream) {
    static int grid = 0;
    if (grid == 0) {
        if (n_in != 27 || ws_size < WS_END) { fprintf(stderr, "kernel_launch: unexpected n_in %d / ws_size %zu (need %zu)\n", n_in, ws_size, (size_t)WS_END); grid = -1; return; }
        int dev = 0, cus = 0, per_cu = 0;
        (void)hipGetDevice(&dev); (void)hipDeviceGetAttribute(&cus, hipDeviceAttributeMultiprocessorCount, dev);
        if (hipFuncSetAttribute((const void*)fwd_megakernel, hipFuncAttributeMaxDynamicSharedMemorySize, LDS_BYTES) != hipSuccess) { fprintf(stderr, "kernel_launch: hipFuncSetAttribute failed\n"); grid = -1; return; }
        if (hipOccupancyMaxActiveBlocksPerMultiprocessor(&per_cu, (const void*)fwd_megakernel, 512, LDS_BYTES) != hipSuccess || per_cu < 1) { fprintf(stderr, "kernel_launch: occupancy query says %d\n", per_cu); per_cu = 1; }
        (void)hipGetLastError();
        grid = cus * 1;
        if (grid <= 0) grid = 256;
    }
    if (grid < 0) return;
    (void)hipMemsetAsync((char*)d_ws + WS_CTL, 0, 65536, stream);
    Params p{};
    for (int i = 0; i < 27; ++i) p.in[i] = (const float*)d_in[i];
    p.out = (float*)d_out; p.ws = (unsigned char*)d_ws;
#ifndef MK_SPLIT
#ifdef DUMP_PH
    p.ph_lo = 0; p.ph_hi = DUMP_PH;
#else
    p.ph_lo = 0; p.ph_hi = 1000;
#endif
    void* args[] = {&p};
    hipError_t e = hipLaunchCooperativeKernel((const void*)fwd_megakernel, dim3(grid), dim3(512), args, LDS_BYTES, stream);
    if (e != hipSuccess) fprintf(stderr, "cooperative launch failed: %s (grid %d)\n", hipGetErrorString(e), grid);
#else
    const int nph = 2 + NL * 6;
    for (int k = 0; k < nph; ++k) { p.ph_lo = k; p.ph_hi = k + 1; hipLaunchKernelGGL(fwd_megakernel, dim3(grid), dim3(512), LDS_BYTES, stream, p); }
#endif
}
```
